# Optimizing an MI355X kernel written in HIP

```python
import math
import jax, jax.numpy as jnp
from jax import lax
import numpy as np

D_MODEL = 1024
BATCH = 8
SEQ = 2048
DEPTH = 2

D_MIX = D_MODEL
D_GROUP = D_MIX // 4
HEAD_DIM = 64
N_HEADS_GROUP = D_GROUP // HEAD_DIM

RWKV_DECAY_LORA = 32
RWKV_AAA_LORA = 32
RWKV_MV_LORA = 32
RWKV_GATE_LORA = 64
RWKV_GN_EPS = HEAD_DIM * 1e-5
RWKV_SIZES = (D_GROUP, D_GROUP, D_GROUP, RWKV_DECAY_LORA, RWKV_AAA_LORA, RWKV_GATE_LORA)
RWKV_COLS = sum(RWKV_SIZES)

DILATED_BRANCHES = ((128, 1), (512, 4), (2048, 16))
ALIBI_SLOPES = tuple(2.0 ** (-8.0 * (h + 1) / N_HEADS_GROUP) for h in range(N_HEADS_GROUP))
ATTN_COLS = 3 * D_GROUP

SSD_STATE = 128
SSD_GROUPS = 2
SSD_CONV = 4
SSD_CHUNK = 128
SSD_XBC = D_GROUP + 2 * SSD_GROUPS * SSD_STATE
SSD_COLS = D_GROUP + SSD_XBC + N_HEADS_GROUP

HGRN_CHUNK = 16
HGRN_COLS = 4 * D_GROUP

IN_COLS = RWKV_COLS + ATTN_COLS + SSD_COLS + HGRN_COLS

D_FF = 4 * D_MODEL
ALPHA = (2.0 * DEPTH) ** 0.25
BETA = (8.0 * DEPTH) ** -0.25
LN_EPS = 1e-5
RMS_EPS = 1e-5

kernel_name = "hymba_rwkv7_dilated_ssd_hgrn2_deepnorm"


def _split(t, sizes):
    out, o = [], 0
    for s in sizes:
        out.append(t[..., o:o + s])
        o += s
    return out


def _layer_norm(x, w, b):
    x32 = x.astype(jnp.float32)
    mu = jnp.mean(x32, -1, keepdims=True)
    var = jnp.mean(jnp.square(x32 - mu), -1, keepdims=True)
    return ((x32 - mu) * lax.rsqrt(var + LN_EPS) * w + b).astype(x.dtype)


def _rms(t):
    return t * lax.rsqrt(jnp.mean(jnp.square(t), -1, keepdims=True) + RMS_EPS)


def _token_shift_lerp(f, mu):
    prev = jnp.pad(f, ((0, 0), (1, 0), (0, 0)))[:, :-1]
    return f + (prev - f) * mu


def rwkv7_time_mix(feat, w0, w2, a0, a2, g2, k_k, k_a, r_k, lnx_w, lnx_b,
                   v_first, v_feat, v0, v2):
    bsz, slen, _ = feat.shape
    H, N = N_HEADS_GROUP, HEAD_DIM
    r, k, v, fw, fa, fg = _split(feat, RWKV_SIZES)
    w_log = -jax.nn.softplus(-(w0 + jnp.tanh(fw) @ w2)) - 0.5
    decay = jnp.exp(-jnp.exp(w_log))
    a = jax.nn.sigmoid(a0 + fa @ a2)
    g = jax.nn.sigmoid(fg) @ g2
    if v_first is None:
        v_first = v
    else:
        v = v + (v_first - v) * jax.nn.sigmoid(v0 + v_feat @ v2)

    def heads(t):
        return t.reshape(bsz, slen, H, N)

    kk = heads(k * k_k)
    kk = kk / jnp.maximum(jnp.sqrt(jnp.sum(jnp.square(kk), -1, keepdims=True)), 1e-12)
    k = k * (1.0 + (a - 1.0) * k_a)

    def step(state, inp):
        r_t, w_t, k_t, v_t, kk_t, a_t = inp
        sa = jnp.einsum('bhvk,bhk->bhv', state, -kk_t)
        state = (state * w_t[:, :, None, :]
                 + sa[..., None] * (kk_t * a_t)[:, :, None, :]
                 + v_t[..., None] * k_t[:, :, None, :])
        return state, jnp.einsum('bhvk,bhk->bhv', state, r_t)

    xs = tuple(jnp.swapaxes(heads(t), 0, 1) for t in (r, decay, k, v, kk, a))
    _, y = lax.scan(step, jnp.zeros((bsz, H, N, N), jnp.float32), xs)
    y = jnp.swapaxes(y, 0, 1)
    mu = jnp.mean(y, -1, keepdims=True)
    var = jnp.mean(jnp.square(y - mu), -1, keepdims=True)
    y = ((y - mu) * lax.rsqrt(var + RWKV_GN_EPS)).reshape(bsz, slen, D_GROUP) * lnx_w + lnx_b
    bonus = jnp.sum(heads(r) * heads(k) * r_k, -1, keepdims=True) * heads(v)
    return (y + bonus.reshape(bsz, slen, D_GROUP)) * g, v_first


def _dilated_branch(q, k, v, window, dilation):
    bsz, slen, H, Dh = q.shape
    L = slen // dilation
    blk = window // dilation
    nb = -(-L // blk)
    Lp = nb * blk

    def to_sub(t):
        t = t.reshape(bsz, L, dilation, H, Dh).transpose(0, 2, 1, 3, 4)
        t = t.reshape(bsz * dilation, L, H, Dh)
        return jnp.pad(t, ((0, 0), (0, Lp - L), (0, 0), (0, 0)))

    qs, ks, vs = to_sub(q), to_sub(k), to_sub(v)
    qb = qs.reshape(-1, nb, blk, H, Dh)

    def band(t):
        tp = jnp.pad(t, ((0, 0), (blk, 0), (0, 0), (0, 0))).reshape(-1, nb + 1, blk, H, Dh)
        return jnp.concatenate([tp[:, :-1], tp[:, 1:]], axis=2)

    kb, vb = band(ks), band(vs)
    i = jnp.arange(blk)[:, None]
    j = jnp.arange(2 * blk)[None, :]
    dist = blk + i - j
    n = jnp.arange(nb)[:, None, None]
    valid = (dist >= 0) & (dist <= blk) & ((n > 0) | (j >= blk))
    slopes = jnp.asarray(ALIBI_SLOPES, jnp.float32)
    bias = -slopes[:, None, None] * (dist * dilation).astype(jnp.float32)
    s = jnp.einsum('znqhd,znkhd->znhqk', qb, kb) * (Dh ** -0.5) + bias[None, None]
    s = jnp.where(valid[None, :, None], s, -jnp.inf)
    m = jnp.max(s, -1, keepdims=True)
    p = jnp.exp(s - m)
    l = jnp.sum(p, -1, keepdims=True)
    o = jnp.einsum('znhqk,znkhd->znqhd', p, vb) / jnp.transpose(l[..., 0], (0, 1, 3, 2))[..., None]
    lse = jnp.transpose((m + jnp.log(l))[..., 0], (0, 1, 3, 2))

    def from_sub(t):
        t = t.reshape(bsz * dilation, Lp, *t.shape[3:])[:, :L]
        t = t.reshape(bsz, dilation, L, *t.shape[2:])
        t = jnp.swapaxes(t, 1, 2)
        return t.reshape(bsz, slen, *t.shape[3:])

    return from_sub(o), from_sub(lse)


def dilated_attention(q, k, v):
    outs, lses = [], []
    for window, dilation in DILATED_BRANCHES:
        o, lse = _dilated_branch(q, k, v, window, dilation)
        outs.append(o)
        lses.append(lse)
    wts = jax.nn.softmax(jnp.stack(lses), axis=0)
    return jnp.sum(jnp.stack(outs) * wts[..., None], axis=0)


def _causal_depthwise_conv(x, w, b):
    y = lax.conv_general_dilated(x, w[:, None, :], window_strides=(1,),
                                 padding=[(w.shape[0] - 1, 0)],
                                 dimension_numbers=('NWC', 'WIO', 'NWC'),
                                 feature_group_count=x.shape[-1])
    return y + b


def _segsum_exp(a):
    cs = jnp.cumsum(a, -1)
    diff = cs[..., :, None] - cs[..., None, :]
    mask = jnp.tril(jnp.ones((a.shape[-1], a.shape[-1]), bool))
    return jnp.where(mask, jnp.exp(jnp.where(mask, diff, 0.0)), 0.0)


def ssd_mixer(feat, conv_w, conv_b, dt_bias, A_log, D, norm_w):
    bsz, slen, _ = feat.shape
    H, P, G, N = N_HEADS_GROUP, HEAD_DIM, SSD_GROUPS, SSD_STATE
    z, xbc, dt = _split(feat, (D_GROUP, SSD_XBC, H))
    xbc = jax.nn.silu(_causal_depthwise_conv(xbc, conv_w.astype(jnp.float32), conv_b))
    xs, Bm, Cm = _split(xbc, (D_GROUP, G * N, G * N))
    dt = jax.nn.softplus(dt + dt_bias)
    A = -jnp.exp(A_log.astype(jnp.float32))
    Lc = SSD_CHUNK
    nc = slen // Lc
    hpg = H // G
    x = xs.reshape(bsz, nc, Lc, H, P)
    Bh = jnp.repeat(Bm.reshape(bsz, nc, Lc, G, N), hpg, axis=3)
    Ch = jnp.repeat(Cm.reshape(bsz, nc, Lc, G, N), hpg, axis=3)
    dtc = dt.reshape(bsz, nc, Lc, H)
    dA = jnp.transpose(dtc * A, (0, 3, 1, 2))
    cs = jnp.cumsum(dA, -1)
    xdt = x * dtc[..., None]
    scores = jnp.einsum('bclhn,bcshn->bhcls', Ch, Bh) * _segsum_exp(dA)
    y_diag = jnp.einsum('bhcls,bcshp->bclhp', scores, xdt)
    decay_states = jnp.exp(cs[..., -1:] - cs)
    chunk_states = jnp.einsum('bclhn,bhcl,bclhp->cbhpn', Bh, decay_states, xdt)
    chunk_decay = jnp.transpose(jnp.exp(cs[..., -1]), (2, 0, 1))

    def step(s, inp):
        st, dec = inp
        return s * dec[..., None, None] + st, s

    _, prev = lax.scan(step, jnp.zeros((bsz, H, P, N), jnp.float32), (chunk_states, chunk_decay))
    y_off = jnp.einsum('bclhn,cbhpn,bhcl->bclhp', Ch, prev, jnp.exp(cs))
    y = (y_diag + y_off).reshape(bsz, slen, H, P) + x.reshape(bsz, slen, H, P) * D[:, None]
    y = y.reshape(bsz, slen, D_GROUP) * jax.nn.silu(z)
    y = _rms(y.reshape(bsz, slen, G, D_GROUP // G)).reshape(bsz, slen, D_GROUP)
    return y * norm_w


def hgrn2_mixer(feat, lower_bound, norm_w):
    bsz, slen, _ = feat.shape
    H, K, V = N_HEADS_GROUP, HEAD_DIM, HEAD_DIM
    q, f, i, g = _split(feat, (D_GROUP,) * 4)
    forget = lower_bound + (1.0 - lower_bound) * jax.nn.sigmoid(f)
    log_f = jnp.log(forget)
    k = 1.0 - forget
    q = jax.nn.silu(q)
    C = HGRN_CHUNK
    nc = slen // C
    q, k, log_f = (t.reshape(bsz, nc, C, H, K) for t in (q, k, log_f))
    v = i.reshape(bsz, nc, C, H, V)
    b = jnp.cumsum(log_f, axis=2)
    diff = b[:, :, :, None] - b[:, :, None, :]
    causal = jnp.tril(jnp.ones((C, C), bool))[None, None, :, :, None, None]
    dec = jnp.exp(jnp.where(causal, diff, -jnp.inf))
    att = jnp.einsum('bnthk,bnshk,bntshk->bnhts', q, k, dec)
    o_intra = jnp.einsum('bnhts,bnshv->bnthv', att, v)
    kdec = k * jnp.exp(b[:, :, -1:] - b)
    U = jnp.einsum('bnshk,bnshv->nbhkv', kdec, v)
    tot = jnp.transpose(jnp.exp(b[:, :, -1]), (1, 0, 2, 3))

    def step(s, inp):
        u, d = inp
        return s * d[..., None] + u, s

    _, prev = lax.scan(step, jnp.zeros((bsz, H, K, V), jnp.float32), (U, tot))
    o_inter = jnp.einsum('bnthk,nbhkv->bnthv', q * jnp.exp(b), prev)
    o = _rms((o_intra + o_inter).reshape(bsz, slen, H, V)).reshape(bsz, slen, D_GROUP)
    return o * norm_w * jax.nn.silu(g)


def setup_inputs(seed: int = 0) -> dict:
    key = jax.random.key(seed)
    ks = iter(jax.random.split(key, 40))
    nrm = lambda shape, scale: jax.random.normal(next(ks), shape, jnp.float32) * scale
    uni = lambda shape, lo, hi: jax.random.uniform(next(ks), shape, jnp.float32, lo, hi)
    L1 = DEPTH - 1
    H = N_HEADS_GROUP
    dt0 = jnp.exp(uni((DEPTH, H), math.log(1e-3), math.log(1e-1)))
    return {
        "x": nrm((BATCH, SEQ, D_MODEL), 1.0),
        "lower_bounds": nrm((DEPTH, D_GROUP), 0.5),
        "w_in": nrm((DEPTH, D_MODEL, IN_COLS), D_MODEL ** -0.5),
        "w_in_vres": nrm((L1, D_MODEL, RWKV_MV_LORA), D_MODEL ** -0.5),
        "mu_shift": uni((DEPTH, RWKV_COLS), 0.0, 1.0),
        "mu_vres": uni((L1, RWKV_MV_LORA), 0.0, 1.0),
        "rwkv_w0": uni((DEPTH, D_GROUP), -6.0, 1.0),
        "rwkv_w2": nrm((DEPTH, RWKV_DECAY_LORA, D_GROUP), RWKV_DECAY_LORA ** -0.5),
        "rwkv_a0": nrm((DEPTH, D_GROUP), 0.1),
        "rwkv_a2": nrm((DEPTH, RWKV_AAA_LORA, D_GROUP), RWKV_AAA_LORA ** -0.5),
        "rwkv_g2": nrm((DEPTH, RWKV_GATE_LORA, D_GROUP), RWKV_GATE_LORA ** -0.5),
        "rwkv_k_k": 0.85 + nrm((DEPTH, D_GROUP), 0.05),
        "rwkv_k_a": 1.0 + nrm((DEPTH, D_GROUP), 0.05),
        "rwkv_r_k": nrm((DEPTH, H, HEAD_DIM), 0.1),
        "rwkv_lnx_w": 1.0 + nrm((DEPTH, D_GROUP), 0.05),
        "rwkv_lnx_b": nrm((DEPTH, D_GROUP), 0.01),
        "rwkv_v0": nrm((L1, D_GROUP), 0.5),
        "rwkv_v2": nrm((L1, RWKV_MV_LORA, D_GROUP), RWKV_MV_LORA ** -0.5),
        "ssd_conv_w": nrm((DEPTH, SSD_CONV, SSD_XBC), SSD_CONV ** -0.5),
        "ssd_conv_b": nrm((DEPTH, SSD_XBC), 0.01),
        "ssd_dt_bias": dt0 + jnp.log(-jnp.expm1(-dt0)),
        "ssd_A_log": jnp.log(uni((DEPTH, H), 1.0, 16.0)),
        "ssd_D": 1.0 + nrm((DEPTH, H), 0.05),
        "ssd_norm_w": 1.0 + nrm((DEPTH, D_GROUP), 0.05),
        "hgrn_norm_w": 1.0 + nrm((DEPTH, D_GROUP), 0.05),
        "w_out": nrm((DEPTH, D_MIX, D_MODEL), BETA * D_MIX ** -0.5),
        "ln1_w": 1.0 + nrm((DEPTH, D_MODEL), 0.05),
        "ln1_b": nrm((DEPTH, D_MODEL), 0.01),
        "w_up": nrm((DEPTH, D_MODEL, D_FF), D_MODEL ** -0.5),
        "w_down": nrm((DEPTH, D_FF, D_MODEL), BETA * D_FF ** -0.5),
        "ln2_w": 1.0 + nrm((DEPTH, D_MODEL), 0.05),
        "ln2_b": nrm((DEPTH, D_MODEL), 0.01),
    }


def reference(x, lower_bounds, w_in, w_in_vres, mu_shift, mu_vres, rwkv_w0, rwkv_w2,
              rwkv_a0, rwkv_a2, rwkv_g2, rwkv_k_k, rwkv_k_a, rwkv_r_k, rwkv_lnx_w,
              rwkv_lnx_b, rwkv_v0, rwkv_v2, ssd_conv_w, ssd_conv_b, ssd_dt_bias, ssd_A_log,
              ssd_D, ssd_norm_w, hgrn_norm_w, w_out, ln1_w, ln1_b, w_up, w_down, ln2_w, ln2_b):
    bsz, slen, _ = x.shape
    lb = jax.nn.softmax(lower_bounds.astype(jnp.float32), axis=0)
    lb = jnp.cumsum(lb, axis=0) - lb[0]
    v_first = None
    for l in range(DEPTH):
        if l == 0:
            proj = x @ w_in[l]
        else:
            proj = x @ jnp.concatenate([w_in[l], w_in_vres[l - 1]], axis=1)
        proj = proj.astype(jnp.float32)
        parts = _split(proj, (RWKV_COLS, ATTN_COLS, SSD_COLS, HGRN_COLS))
        f_rwkv, f_attn, f_ssd, f_hgrn = parts
        f_rwkv = _token_shift_lerp(f_rwkv, mu_shift[l])
        if l == 0:
            y_a, v_first = rwkv7_time_mix(f_rwkv, rwkv_w0[l], rwkv_w2[l], rwkv_a0[l], rwkv_a2[l],
                                          rwkv_g2[l], rwkv_k_k[l], rwkv_k_a[l], rwkv_r_k[l],
                                          rwkv_lnx_w[l], rwkv_lnx_b[l], None, None, None, None)
        else:
            f_vres = _token_shift_lerp(proj[..., IN_COLS:], mu_vres[l - 1])
            y_a, v_first = rwkv7_time_mix(f_rwkv, rwkv_w0[l], rwkv_w2[l], rwkv_a0[l], rwkv_a2[l],
                                          rwkv_g2[l], rwkv_k_k[l], rwkv_k_a[l], rwkv_r_k[l],
                                          rwkv_lnx_w[l], rwkv_lnx_b[l], v_first, f_vres,
                                          rwkv_v0[l - 1], rwkv_v2[l - 1])
        q, k, v = (t.reshape(bsz, slen, N_HEADS_GROUP, HEAD_DIM)
                   for t in _split(f_attn, (D_GROUP,) * 3))
        y_b = dilated_attention(q, k, v).reshape(bsz, slen, D_GROUP)
        y_c = ssd_mixer(f_ssd, ssd_conv_w[l], ssd_conv_b[l], ssd_dt_bias[l], ssd_A_log[l],
                        ssd_D[l], ssd_norm_w[l])
        y_d = hgrn2_mixer(f_hgrn, lb[l], hgrn_norm_w[l])
        mix = jnp.concatenate([y_a, y_b, y_c, y_d], axis=-1).astype(x.dtype) @ w_out[l]
        x = _layer_norm(ALPHA * x + mix, ln1_w[l], ln1_b[l])
        h = jnp.square(jax.nn.relu(x @ w_up[l]))
        x = _layer_norm(ALPHA * x + h @ w_down[l], ln2_w[l], ln2_b[l])
    return x
```

```cpp
#include <hip/hip_runtime.h>
#include <hip/hip_cooperative_groups.h>
#include <cstdio>
namespace cg = cooperative_groups;

#ifndef COOP
#define COOP 1
#endif

#define LAS __attribute__((address_space(3)))
typedef _Float16 h16;
typedef _Float16 h16x4 __attribute__((ext_vector_type(4)));
typedef _Float16 h16x8 __attribute__((ext_vector_type(8)));
typedef float f32x2 __attribute__((ext_vector_type(2)));
typedef float f32x4 __attribute__((ext_vector_type(4)));

constexpr int T_ = 16384, SEQ_ = 2048, DM = 1024, NP = 3840, DFF = 4096, INC = 3716;
constexpr int C_R = 0, C_K = 256, C_V = 512, C_FW = 768, C_VR = 896, C_AQ = 928, C_AK = 1184, C_AV = 1440;
constexpr int C_SZ = 1696, C_SX = 1952, C_SDT = 2720, C_HQ = 2728, C_HF = 2984, C_HI = 3240, C_HG = 3496;
constexpr float ALPHA_ = 1.41421356237f;
constexpr size_t OFF_WIN = 0, OFF_WOUT = 7864320, OFF_WUP = OFF_WOUT + 2097152, OFF_WDN = OFF_WUP + 8388608;
constexpr size_t OFF_X16 = 26738688, OFF_MIX = OFF_X16 + 33554432, OFF_BIG = OFF_MIX + 33554432;
constexpr size_t OFF_VF = OFF_BIG + 134217728, OFF_O2 = OFF_VF + 8388608, OFF_O3 = OFF_O2 + 8388608, OFF_LSE = OFF_O3 + 8388608;
constexpr size_t OFF_MISC = OFF_LSE + 786432;
constexpr int LDS_BYTES = 131072;

struct Params { const float* in[32]; float* out; unsigned char* ws; };

enum { I_X = 0, I_LB, I_WIN, I_WINV, I_MU, I_MUV, I_W0, I_W2, I_A0, I_A2, I_G2, I_KK, I_KA, I_RK, I_LNW, I_LNB, I_V0, I_V2,
       I_CW, I_CB, I_DTB, I_ALOG, I_SD, I_SNW, I_HNW, I_WOUT, I_LN1W, I_LN1B, I_WUP, I_WDN, I_LN2W, I_LN2B };

template <int CTRL> __device__ __forceinline__ float dpp_f(float x) {
    return __builtin_bit_cast(float, __builtin_amdgcn_update_dpp(0, __builtin_bit_cast(int, x), CTRL, 0xF, 0xF, true));
}
__device__ __forceinline__ float sum16(float x) {
    x += dpp_f<0xB1>(x);
    x += dpp_f<0x4E>(x);
    x += dpp_f<0x141>(x);
    x += dpp_f<0x140>(x);
    return x;
}
__device__ __forceinline__ float sum64(float x) { x = sum16(x); x += __shfl_xor(x, 16); x += __shfl_xor(x, 32); return x; }
__device__ __forceinline__ float sigmoidf_(float x) { return 1.0f / (1.0f + __expf(-x)); }
__device__ __forceinline__ float siluf_(float x) { return x / (1.0f + __expf(-x)); }
__device__ __forceinline__ float softplusf_(float x) { return fmaxf(x, 0.f) + log1pf(__expf(-fabsf(x))); }
__device__ __forceinline__ f32x4 h4f(h16x4 v) { return (f32x4){(float)v[0], (float)v[1], (float)v[2], (float)v[3]}; }
__device__ __forceinline__ h16x4 f4h(f32x4 v) { return (h16x4){(h16)v[0], (h16)v[1], (h16)v[2], (h16)v[3]}; }

namespace pg8 {
constexpr int BM = 256, BK = 64, HALF = 128, HTB = HALF * BK * 2, STAGE_BYTES = 8 * HTB, NXCD = 8, WGM = 8;
__host__ __device__ __forceinline__ int lds_byte(int r, int c) { const int st = (r >> 4) * 2 + (c >> 5), rr = r & 15, cc = c & 31, ob = rr * 64 + cc * 2; return st * 1024 + (ob ^ (((ob >> 9) & 1) << 5)); }
__host__ __device__ __forceinline__ void stage_rc(int b, int& R, int& C) { const int st = b / 1024, sb = b % 1024, swz = sb ^ (((sb >> 9) & 1) << 5); R = (st >> 1) * 16 + swz / 64; C = (st & 1) * 32 + (swz % 64) / 2; }
__host__ __device__ __forceinline__ int perm32(int rho) { const int n = rho >> 4, i = rho & 15; return 8 * (i >> 2) + 4 * n + (i & 3); }
struct Unit { int pm, pn; };
struct Gemm { const h16* A; const h16* Bt; int M, N, K; };
struct StaticOrder {
    int nM, nN, nwg, G, c;
    __device__ void init(int M, int N, int G_, int c_) { nM = M / BM; nN = N / BM; nwg = nM * nN; G = G_; c = c_; }
    __device__ bool next(int i, Unit& u) const {
        const long L = (long)i * G + c; if (L >= nwg) return false;
        int wgid = (int)L; { const int q = nwg / NXCD, r = nwg % NXCD, xcd = wgid % NXCD, off = wgid / NXCD; wgid = (xcd < r ? xcd * (q + 1) : r * (q + 1) + (xcd - r) * q) + off; }
        const int nig = WGM * nN, gid = wgid / nig, fm = gid * WGM, gsz = (nM - fm) < WGM ? (nM - fm) : WGM;
        u.pm = fm + ((wgid % nig) % gsz); u.pn = (wgid % nig) / gsz; return true;
    }
};
struct EpiH {
    h16* O; int ldc; int MODE;
    __device__ __forceinline__ void operator()(const f32x4 (&acc)[2][2][4][2], const Unit& u, int wr, int wc, int fr, int fq) const {
        const int row0 = u.pm * BM + wr * 64 + fr, col0 = u.pn * BM + wc * 32 + 8 * fq;
#pragma unroll
        for (int ai = 0; ai < 2; ++ai)
#pragma unroll
            for (int m = 0; m < 4; ++m) { h16* rowp = O + (size_t)(row0 + ai * HALF + m * 16) * ldc + col0;
#pragma unroll
                for (int bj = 0; bj < 2; ++bj) { f32x4 v0 = acc[ai][bj][m][0], v1 = acc[ai][bj][m][1];
                    if (MODE == 1) {
#pragma unroll
                        for (int j = 0; j < 4; ++j) { float a = fmaxf(v0[j], 0.f), b = fmaxf(v1[j], 0.f); v0[j] = a * a; v1[j] = b * b; } }
                    if (MODE == 2) { const h16x8 x = *(const h16x8*)(rowp + bj * HALF);
#pragma unroll
                        for (int j = 0; j < 4; ++j) { v0[j] += ALPHA_ * (float)x[j]; v1[j] += ALPHA_ * (float)x[4 + j]; } }
                    h16x8 w;
#pragma unroll
                    for (int j = 0; j < 4; ++j) { w[j] = (h16)v0[j]; w[4 + j] = (h16)v1[j]; }
                    *(h16x8*)(rowp + bj * HALF) = w; } }
    }
};

template <class Epi>
__device__ __forceinline__ void gemm_phase(LAS unsigned char* lds, const Gemm g, const StaticOrder& S, const Epi& E, const int tidx) {
    const int tid = tidx, wid = __builtin_amdgcn_readfirstlane(tid >> 6), lane = tid & 63, wr = wid >> 2, wc = wid & 3, fr = lane & 15, fq = lane >> 4;
    const int K = g.K, nt = K / BK;
    unsigned voffA[2], voffB[2];
#pragma unroll
    for (int i = 0; i < 2; ++i) { int R, C; stage_rc(tid * 16 + i * 8192, R, C); const int Rb = (R & ~31) + perm32(R & 31);
        voffA[i] = (unsigned)(R * K + C) * 2u; voffB[i] = (unsigned)(Rb * K + C) * 2u; }
    const size_t kstep = (size_t)(BK * 2);
    const size_t hstep = (size_t)HALF * K * 2;
    const size_t tstep = 2 * hstep;
    const unsigned ldsw = (unsigned)wid * 1024u;
    const int aoff = lds_byte(wr * 64 + fr, fq * 8), boff = lds_byte(wc * 32 + fr, fq * 8);
#define PG8_SA(b, h) (((b) * 2 + (h)) * HTB)
#define PG8_SB(b, h) ((4 + (b) * 2 + (h)) * HTB)
#define PG8_STAGE(bufoff, gbase, voff) do { _Pragma("unroll") for (int _i = 0; _i < 2; ++_i) \
        __builtin_amdgcn_global_load_lds((const unsigned*)((const char*)(gbase) + (voff)[_i]), (LAS unsigned*)(lds + (bufoff) + ldsw + _i * 8192), 16, 0, 0); } while (0)
#define PG8_LDA(dst, b, h) do { _Pragma("unroll") for (int m = 0; m < 4; ++m) _Pragma("unroll") for (int k = 0; k < 2; ++k) dst[m][k] = *(const LAS h16x8*)(lds + PG8_SA(b, h) + aoff + m * 2048 + k * 1024); } while (0)
#define PG8_LDB(dst, b, h) do { _Pragma("unroll") for (int n = 0; n < 2; ++n) _Pragma("unroll") for (int k = 0; k < 2; ++k) dst[n][k] = *(const LAS h16x8*)(lds + PG8_SB(b, h) + boff + n * 2048 + k * 1024); } while (0)
#define PG8_MMA(ai, bj, At, Bt) do { __builtin_amdgcn_s_setprio(1); _Pragma("unroll") for (int m = 0; m < 4; ++m) _Pragma("unroll") for (int n = 0; n < 2; ++n) _Pragma("unroll") for (int k = 0; k < 2; ++k) \
        acc[ai][bj][m][n] = __builtin_amdgcn_mfma_f32_16x16x32_f16(Bt[n][k], At[m][k], acc[ai][bj][m][n], 0, 0, 0); __builtin_amdgcn_s_setprio(0); } while (0)
#define PG8_WAIT_V(n) asm volatile("s_waitcnt vmcnt(" #n ")" ::: "memory")
#define PG8_WAIT_L(n) asm volatile("s_waitcnt lgkmcnt(" #n ")" ::: "memory")
#define PG8_BAR __builtin_amdgcn_s_barrier()
#define PG8_SCHED __builtin_amdgcn_sched_barrier(0)
    Unit cur, nxt; int ui = 0;
    if (!S.next(0, cur)) return;
    f32x4 acc[2][2][4][2];
#pragma unroll
    for (int a = 0; a < 2; ++a)
#pragma unroll
        for (int b = 0; b < 2; ++b)
#pragma unroll
            for (int m = 0; m < 4; ++m)
#pragma unroll
                for (int n = 0; n < 2; ++n) acc[a][b][m][n] = (f32x4){0.f, 0.f, 0.f, 0.f};
    h16x8 At[4][2], B0[2][2], B1[2][2];
    const char* cA = (const char*)g.A + (size_t)cur.pm * tstep; const char* cB = (const char*)g.Bt + (size_t)cur.pn * tstep;
    PG8_STAGE(PG8_SB(0, 0), cB, voffB); PG8_STAGE(PG8_SA(0, 0), cA, voffA); PG8_STAGE(PG8_SB(0, 1), cB + hstep, voffB); PG8_STAGE(PG8_SA(0, 1), cA + hstep, voffA);
    if (wr == 1) PG8_BAR;
    PG8_WAIT_V(4); PG8_BAR;
    PG8_STAGE(PG8_SB(1, 0), cB + kstep, voffB); PG8_STAGE(PG8_SA(1, 0), cA + kstep, voffA); PG8_STAGE(PG8_SB(1, 1), cB + hstep + kstep, voffB);
    PG8_WAIT_V(6); PG8_BAR;
    for (;;) {
        const bool has_next = S.next(ui + 1, nxt);
        const char* nA = has_next ? (const char*)g.A + (size_t)nxt.pm * tstep : cA; const char* nB = has_next ? (const char*)g.Bt + (size_t)nxt.pn * tstep : cB;
        for (int t = 0; t < nt; t += 2) {
            const bool last = (t == nt - 2);
            const char* a1 = cA + (size_t)(t + 1) * kstep;
            const char* a2 = last ? nA : cA + (size_t)(t + 2) * kstep; const char* b2 = last ? nB : cB + (size_t)(t + 2) * kstep;
            const char* a3 = a2 + kstep; const char* b3 = b2 + kstep;
            PG8_LDB(B0, 0, 0); PG8_SCHED; PG8_LDA(At, 0, 0); PG8_STAGE(PG8_SA(1, 1), a1 + hstep, voffA);
            PG8_WAIT_L(8); PG8_BAR; PG8_WAIT_L(0); PG8_MMA(0, 0, At, B0); PG8_BAR; PG8_SCHED;
            PG8_LDB(B1, 0, 1); PG8_STAGE(PG8_SB(0, 0), b2, voffB);
            PG8_BAR; PG8_WAIT_L(0); PG8_MMA(0, 1, At, B1); PG8_BAR;
            PG8_LDA(At, 0, 1); PG8_STAGE(PG8_SA(0, 0), a2, voffA);
            PG8_BAR; PG8_WAIT_L(0); PG8_MMA(1, 0, At, B0); PG8_BAR; PG8_SCHED;
            PG8_STAGE(PG8_SB(0, 1), b2 + hstep, voffB);
            PG8_WAIT_V(6); PG8_BAR; PG8_MMA(1, 1, At, B1); PG8_BAR;
            PG8_LDB(B0, 1, 0); PG8_SCHED; PG8_LDA(At, 1, 0); PG8_STAGE(PG8_SA(0, 1), a2 + hstep, voffA);
            PG8_WAIT_L(8); PG8_BAR; PG8_WAIT_L(0); PG8_MMA(0, 0, At, B0); PG8_BAR; PG8_SCHED;
            PG8_LDB(B1, 1, 1); PG8_STAGE(PG8_SB(1, 0), b3, voffB);
            PG8_BAR; PG8_WAIT_L(0); PG8_MMA(0, 1, At, B1); PG8_BAR;
            PG8_LDA(At, 1, 1); PG8_STAGE(PG8_SA(1, 0), a3, voffA);
            PG8_BAR; PG8_WAIT_L(0); PG8_MMA(1, 0, At, B0); PG8_BAR; PG8_SCHED;
            PG8_STAGE(PG8_SB(1, 1), b3 + hstep, voffB);
            PG8_WAIT_V(6); PG8_BAR; PG8_MMA(1, 1, At, B1); PG8_BAR;
        }
        E(acc, cur, wr, wc, fr, fq);
        if (!has_next) break;
#pragma unroll
        for (int a = 0; a < 2; ++a)
#pragma unroll
            for (int b = 0; b < 2; ++b)
#pragma unroll
                for (int m = 0; m < 4; ++m)
#pragma unroll
                    for (int n = 0; n < 2; ++n) acc[a][b][m][n] = (f32x4){0.f, 0.f, 0.f, 0.f};
        cur = nxt; cA = nA; cB = nB; ++ui;
    }
    PG8_WAIT_V(0);
    if (wr == 0) PG8_BAR;
    PG8_BAR;
#undef PG8_SA
#undef PG8_SB
#undef PG8_STAGE
#undef PG8_LDA
#undef PG8_LDB
#undef PG8_MMA
#undef PG8_WAIT_V
#undef PG8_WAIT_L
#undef PG8_BAR
#undef PG8_SCHED
}
}

__device__ __forceinline__ void run_gemm(LAS unsigned char* lds, const h16* A, const h16* Bt, int N, int K, h16* O, int ldc, int mode, const int tidx) {
    pg8::Gemm g; g.A = A; g.Bt = Bt; g.M = T_; g.N = N; g.K = K;
    pg8::StaticOrder S; S.init(T_, N, (int)gridDim.x, (int)blockIdx.x);
    pg8::EpiH E; E.O = O; E.ldc = ldc; E.MODE = mode;
    pg8::gemm_phase(lds, g, S, E, tidx);
}

__device__ __forceinline__ void conv_weights(const Params& p, int l, LAS unsigned char* lds, const int tidx) {
    LAS float* tile = (LAS float*)lds;
    const int tid = tidx;
    for (int id = blockIdx.x; id < 3264; id += gridDim.x) {
        int mat, tl;
        if (id < 960) { mat = 0; tl = id; } else if (id < 1216) { mat = 1; tl = id - 960; } else if (id < 2240) { mat = 2; tl = id - 1216; } else { mat = 3; tl = id - 2240; }
        const int K = (mat == 3) ? 4096 : 1024;
        const int nkt = K / 64;
        const int n0 = (tl / nkt) * 64, k0 = (tl % nkt) * 64;
        h16* dst = (h16*)(p.ws + (mat == 0 ? OFF_WIN : mat == 1 ? OFF_WOUT : mat == 2 ? OFF_WUP : OFF_WDN));
        __syncthreads();
        {
            const int nj = tid & 63, n = n0 + nj;
            const float* src = nullptr; int sstride = 0;
            if (mat == 0) {
                if (n < 896) { src = p.in[I_WIN] + (size_t)l * DM * INC + n; sstride = INC; }
                else if (n < 928) { if (l > 0) { src = p.in[I_WINV] + (size_t)(l - 1) * DM * 32 + (n - 896); sstride = 32; } }
                else if (n < 2724) { src = p.in[I_WIN] + (size_t)l * DM * INC + (n - 32); sstride = INC; }
                else if (n < 2728) { }
                else if (n < 3752) { src = p.in[I_WIN] + (size_t)l * DM * INC + (n - 36); sstride = INC; }
            } else if (mat == 1) { src = p.in[I_WOUT] + (size_t)l * 1024 * 1024 + n; sstride = 1024; }
            else if (mat == 2) { src = p.in[I_WUP] + (size_t)l * 1024 * 4096 + n; sstride = 4096; }
            else { src = p.in[I_WDN] + (size_t)l * 4096 * 1024 + n; sstride = 1024; }
#pragma unroll
            for (int i = 0; i < 8; ++i) { const int ki = (tid >> 6) + 8 * i; tile[ki * 65 + nj] = src ? src[(size_t)(k0 + ki) * sstride] : 0.f; }
        }
        __syncthreads();
        {
            const int ki = tid & 63;
#pragma unroll
            for (int i = 0; i < 8; ++i) { const int nj = (tid >> 6) + 8 * i; dst[(size_t)(n0 + nj) * K + k0 + ki] = (h16)tile[ki * 65 + nj]; }
        }
    }
    __syncthreads();
}

__device__ __forceinline__ void conv_x(const Params& p, const int tidx) {
    const f32x4* src = (const f32x4*)p.in[I_X]; h16x4* dst = (h16x4*)(p.ws + OFF_X16);
    for (size_t i = (size_t)blockIdx.x * 512 + tidx; i < (size_t)T_ * DM / 4; i += (size_t)gridDim.x * 512) dst[i] = f4h(src[i]);
}

__device__ __forceinline__ void pre_phase(const Params& p, int l, LAS unsigned char* lds, const int tidx) {
    LAS float* act = (LAS float*)lds;
    const h16* proj = (const h16*)(p.ws + OFF_BIG);
    h16* prep = (h16*)p.out;
    h16* vfirst = (h16*)(p.ws + OFF_VF);
    const int tid = tidx;
    const int c = tid & 255, hf = tid >> 8, hh = c >> 6;
    const int nact = (l == 0) ? 128 : 160;
    const float mu_r = p.in[I_MU][l * 896 + c], mu_k = p.in[I_MU][l * 896 + 256 + c], mu_v = p.in[I_MU][l * 896 + 512 + c];
    const float w0 = p.in[I_W0][l * 256 + c], a0 = p.in[I_A0][l * 256 + c], k_k = p.in[I_KK][l * 256 + c], k_a = p.in[I_KA][l * 256 + c];
    const float r_k = p.in[I_RK][l * 256 + c], lnw = p.in[I_LNW][l * 256 + c], lnb = p.in[I_LNB][l * 256 + c];
    const float v0 = (l > 0) ? p.in[I_V0][(l - 1) * 256 + c] : 0.f;
    const float* w2 = p.in[I_W2] + (size_t)l * 32 * 256 + c;
    const float* a2 = p.in[I_A2] + (size_t)l * 32 * 256 + c;
    const float* g2 = p.in[I_G2] + (size_t)l * 64 * 256 + c;
    const float* v2 = p.in[I_V2] + (size_t)(l > 0 ? l - 1 : 0) * 32 * 256 + c;
    for (int tt = blockIdx.x; tt < T_ / 64; tt += gridDim.x) {
        const int t0 = tt * 64;
        __syncthreads();
        for (int e = tid; e < 64 * 160; e += 512) {
            const int tok = e / 160, i = e - tok * 160;
            if (i < nact) {
                const int t = t0 + tok;
                const float cur = (float)proj[(size_t)t * NP + C_FW + i];
                const float prv = (t & (SEQ_ - 1)) ? (float)proj[(size_t)(t - 1) * NP + C_FW + i] : 0.f;
                const float mu = (i < 128) ? p.in[I_MU][l * 896 + 768 + i] : p.in[I_MUV][(l - 1) * 32 + (i - 128)];
                const float f = cur + (prv - cur) * mu;
                float a = f;
                if (i < 32) a = tanhf(f); else if (i >= 64 && i < 128) a = sigmoidf_(f);
                act[i * 64 + tok] = a;
            }
        }
        __syncthreads();
#pragma unroll 1
        for (int grp = 0; grp < 2; ++grp) {
            const int tb = hf * 32 + grp * 16;
            float aw[16], aa[16], ag[16], av[16];
#pragma unroll
            for (int j = 0; j < 16; ++j) { aw[j] = 0.f; aa[j] = 0.f; ag[j] = 0.f; av[j] = 0.f; }
#pragma unroll 2
            for (int i = 0; i < 32; ++i) {
                const float ww = w2[i * 256], wa = a2[i * 256];
                const LAS f32x4* r1 = (const LAS f32x4*)(act + i * 64 + tb);
                const LAS f32x4* r2 = (const LAS f32x4*)(act + (32 + i) * 64 + tb);
#pragma unroll
                for (int q = 0; q < 4; ++q) { const f32x4 x = r1[q], y = r2[q];
#pragma unroll
                    for (int j = 0; j < 4; ++j) { aw[4 * q + j] += x[j] * ww; aa[4 * q + j] += y[j] * wa; } }
            }
#pragma unroll 2
            for (int i = 0; i < 64; ++i) {
                const float wg = g2[i * 256];
                const LAS f32x4* r1 = (const LAS f32x4*)(act + (64 + i) * 64 + tb);
#pragma unroll
                for (int q = 0; q < 4; ++q) { const f32x4 x = r1[q];
#pragma unroll
                    for (int j = 0; j < 4; ++j) ag[4 * q + j] += x[j] * wg; }
            }
            if (l > 0) {
#pragma unroll 2
                for (int i = 0; i < 32; ++i) {
                    const float wv = v2[i * 256];
                    const LAS f32x4* r1 = (const LAS f32x4*)(act + (128 + i) * 64 + tb);
#pragma unroll
                    for (int q = 0; q < 4; ++q) { const f32x4 x = r1[q];
#pragma unroll
                        for (int j = 0; j < 4; ++j) av[4 * q + j] += x[j] * wv; }
                }
            }
#pragma unroll
            for (int j = 0; j < 16; ++j) {
                const int t = t0 + tb + j;
                const h16* row = proj + (size_t)t * NP;
                float r = (float)row[C_R + c], k = (float)row[C_K + c], v = (float)row[C_V + c];
                float pr = 0.f, pk = 0.f, pv = 0.f;
                if (t & (SEQ_ - 1)) { pr = (float)row[C_R + c - NP]; pk = (float)row[C_K + c - NP]; pv = (float)row[C_V + c - NP]; }
                r += (pr - r) * mu_r; k += (pk - k) * mu_k; v += (pv - v) * mu_v;
                const float wl = w0 + aw[j];
                const float wlog = -softplusf_(-wl) - 0.5f;
                const float ee = __expf(wlog);
                const float a = sigmoidf_(a0 + aa[j]);
                if (l == 0) vfirst[(size_t)t * 256 + c] = (h16)v;
                else { const float vf = (float)vfirst[(size_t)t * 256 + c]; v += (vf - v) * sigmoidf_(v0 + av[j]); }
                const float kkr = k * k_k;
                const float nrm = sqrtf(sum64(kkr * kkr));
                const float kk = kkr / fmaxf(nrm, 1e-12f);
                const float kp = k * (1.0f + (a - 1.0f) * k_a);
                const float bb = kk * a;
                const float bonus = sum64(r * kp * r_k);
                const float g = ag[j];
                h16* o = prep + (size_t)t * 2048 + c;
                o[0] = (h16)r; o[256] = (h16)ee; o[512] = (h16)kp; o[768] = (h16)kk; o[1024] = (h16)bb; o[1280] = (h16)v;
                o[1536] = (h16)(lnw * g); o[1792] = (h16)((lnb + bonus * v) * g);
            }
        }
    }
    __syncthreads();
    (void)hh;
}

constexpr int CH = 32;

constexpr int RW_SH = 0, RW_VB = CH * 16 * 20 * 4, RW_YB = RW_VB + CH * 16 * 4, RW_STRIDE = RW_YB + CH * 16 * 4;
__device__ __forceinline__ void rwkv_load(const h16* prep, int t0, int h, int rowbase, LAS unsigned char* buf, int lt) {
    LAS float* sh = (LAS float*)(buf + RW_SH);
#pragma unroll
    for (int i = 0; i < 10; ++i) {
        const int e = i * 256 + lt, tok = e / 80, rem = e - tok * 80, vec = rem >> 4, sub = rem & 15;
        const int pv = (vec == 0) ? 3 : (vec == 1) ? 1 : (vec == 2) ? 4 : (vec == 3) ? 2 : 0;
        f32x4 f = h4f(*(const h16x4*)(prep + (size_t)(t0 + tok) * 2048 + pv * 256 + h * 64 + sub * 4));
        if (vec == 1) { f[0] = __expf(-f[0]); f[1] = __expf(-f[1]); f[2] = __expf(-f[2]); f[3] = __expf(-f[3]); }
        *(LAS f32x4*)(sh + ((tok * 16 + sub) * 5 + vec) * 4) = f;
    }
    if (lt < 128) { const int tok = lt >> 2, r4 = lt & 3;
        *(LAS f32x4*)(buf + RW_VB + (tok * 16 + r4 * 4) * 4) = h4f(*(const h16x4*)(prep + (size_t)(t0 + tok) * 2048 + 5 * 256 + rowbase + r4 * 4)); }
}
__device__ __forceinline__ void plain_write_y(h16* mix, int t0, int col, LAS unsigned char* ybuf, int lt) {
    if (lt < 128) { const int tok = lt >> 2, r4 = lt & 3;
        const f32x4 y = *(const LAS f32x4*)(ybuf + (tok * 16 + r4 * 4) * 4);
        *(h16x4*)(mix + (size_t)(t0 + tok) * DM + col + r4 * 4) = f4h(y); }
}
__device__ __forceinline__ void rwkv_scan(const Params& p, int item, LAS unsigned char* lds, const int tidx) {
    const int b = item >> 4, h = (item >> 2) & 3, q4 = item & 3;
    const int tid = tidx, wid = tid >> 6, lane = tid & 63, lt = tid - 256;
    const h16* prep = (const h16*)p.out;
    h16* mix = (h16*)(p.ws + OFF_MIX);
    const int rowbase = h * 64 + q4 * 16, tb = b * SEQ_;
    const bool loader = wid >= 4;
    const int rowl = (wid & 3) * 4 + (lane >> 4), sub = lane & 15;
    f32x4 S = {0.f, 0.f, 0.f, 0.f};
    __syncthreads();
    if (loader) rwkv_load(prep, tb, h, rowbase, lds, lt);
    __syncthreads();
#pragma unroll 1
    for (int c = 0; c < SEQ_ / CH; ++c) {
        LAS unsigned char* buf = lds + (c & 1) * RW_STRIDE;
        if (loader) {
            if (c + 1 < SEQ_ / CH) rwkv_load(prep, tb + (c + 1) * CH, h, rowbase, lds + ((c + 1) & 1) * RW_STRIDE, lt);
            if (c > 0) plain_write_y(mix, tb + (c - 1) * CH, rowbase, lds + ((c - 1) & 1) * RW_STRIDE + RW_YB, lt);
        } else {
            const LAS float* sh = (const LAS float*)(buf + RW_SH);
            const LAS float* vb = (const LAS float*)(buf + RW_VB);
            LAS float* yb = (LAS float*)(buf + RW_YB);
#pragma unroll 4
            for (int s = 0; s < CH; ++s) {
                const LAS f32x4* q = (const LAS f32x4*)(sh + (s * 16 + sub) * 20);
                const f32x4 kk = q[0], w = q[1], bb = q[2], k = q[3], r = q[4];
                const float v = vb[s * 16 + rowl];
                float d = S[0] * kk[0] + S[1] * kk[1] + S[2] * kk[2] + S[3] * kk[3];
                d = sum16(d);
                const float sa = -d;
                S = S * w + (bb * sa + k * v);
                float y = S[0] * r[0] + S[1] * r[1] + S[2] * r[2] + S[3] * r[3];
                y = sum16(y);
                if (sub == 0) yb[s * 16 + rowl] = y;
            }
        }
        __syncthreads();
    }
    if (loader) plain_write_y(mix, tb + (SEQ_ / CH - 1) * CH, rowbase, lds + ((SEQ_ / CH - 1) & 1) * RW_STRIDE + RW_YB, lt);
}

constexpr int HG_SH = 0, HG_VB = CH * 16 * 12 * 4, HG_YB = HG_VB + CH * 16 * 4, HG_STRIDE = HG_YB + CH * 16 * 4;
__device__ __forceinline__ void hgrn_load(const h16* proj, int t0, int h, int rowbase, f32x4 lb, LAS unsigned char* buf, int lt) {
    LAS float* sh = (LAS float*)(buf + HG_SH);
#pragma unroll
    for (int i = 0; i < 2; ++i) {
        const int e = i * 256 + lt, tok = e >> 4, sub = e & 15;
        const h16* row = proj + (size_t)(t0 + tok) * NP + h * 64 + sub * 4;
        const f32x4 qv = h4f(*(const h16x4*)(row + C_HQ)), fv = h4f(*(const h16x4*)(row + C_HF));
        f32x4 fo, ko, qo;
#pragma unroll
        for (int j = 0; j < 4; ++j) { const float fg = lb[j] + (1.0f - lb[j]) * sigmoidf_(fv[j]); fo[j] = fg; ko[j] = 1.0f - fg; qo[j] = siluf_(qv[j]); }
        LAS f32x4* d = (LAS f32x4*)(sh + (tok * 16 + sub) * 12);
        d[0] = fo; d[1] = ko; d[2] = qo;
    }
    if (lt < 128) { const int tok = lt >> 2, r4 = lt & 3;
        *(LAS f32x4*)(buf + HG_VB + (tok * 16 + r4 * 4) * 4) = h4f(*(const h16x4*)(proj + (size_t)(t0 + tok) * NP + C_HI + rowbase + r4 * 4)); }
}
__device__ __forceinline__ void hgrn_scan(const Params& p, int l, int item, LAS unsigned char* lds, const int tidx) {
    const int b = item >> 4, h = (item >> 2) & 3, q4 = item & 3;
    const int tid = tidx, wid = tid >> 6, lane = tid & 63, lt = tid - 256;
    const h16* proj = (const h16*)(p.ws + OFF_BIG);
    h16* mix = (h16*)(p.ws + OFF_MIX);
    const int rowbase = h * 64 + q4 * 16, tb = b * SEQ_;
    const bool loader = wid >= 4;
    const int rowl = (wid & 3) * 4 + (lane >> 4), sub = lane & 15;
    f32x4 lb = {0.f, 0.f, 0.f, 0.f};
    if (l > 0) {
#pragma unroll
        for (int j = 0; j < 4; ++j) { const int ch = h * 64 + (lt & 15) * 4 + j; lb[j] = sigmoidf_(p.in[I_LB][256 + ch] - p.in[I_LB][ch]); }
    }
    f32x4 S = {0.f, 0.f, 0.f, 0.f};
    __syncthreads();
    if (loader) hgrn_load(proj, tb, h, rowbase, lb, lds, lt);
    __syncthreads();
#pragma unroll 1
    for (int c = 0; c < SEQ_ / CH; ++c) {
        LAS unsigned char* buf = lds + (c & 1) * HG_STRIDE;
        if (loader) {
            if (c + 1 < SEQ_ / CH) hgrn_load(proj, tb + (c + 1) * CH, h, rowbase, lb, lds + ((c + 1) & 1) * HG_STRIDE, lt);
            if (c > 0) plain_write_y(mix, tb + (c - 1) * CH, 768 + rowbase, lds + ((c - 1) & 1) * HG_STRIDE + HG_YB, lt);
        } else {
            const LAS float* sh = (const LAS float*)(buf + HG_SH);
            const LAS float* vb = (const LAS float*)(buf + HG_VB);
            LAS float* yb = (LAS float*)(buf + HG_YB);
#pragma unroll 4
            for (int s = 0; s < CH; ++s) {
                const LAS f32x4* q = (const LAS f32x4*)(sh + (s * 16 + sub) * 12);
                const f32x4 f = q[0], k = q[1], qq = q[2];
                const float v = vb[s * 16 + rowl];
                S = S * f + k * v;
                float y = S[0] * qq[0] + S[1] * qq[1] + S[2] * qq[2] + S[3] * qq[3];
                y = sum16(y);
                if (sub == 0) yb[s * 16 + rowl] = y;
            }
        }
        __syncthreads();
    }
    if (loader) plain_write_y(mix, tb + (SEQ_ / CH - 1) * CH, 768 + rowbase, lds + ((SEQ_ / CH - 1) & 1) * HG_STRIDE + HG_YB, lt);
}

constexpr int SD_SH = 0, SD_XDT = CH * 16 * 16 * 4, SD_XS = SD_XDT + CH * 16 * 4, SD_AB = SD_XS + CH * 16 * 4, SD_YB = SD_AB + CH * 4, SD_STRIDE = SD_YB + CH * 16 * 4;
__device__ __forceinline__ f32x4 ssd_conv4(const Params& p, int l, const h16* proj, int t, int ch) {
    const float* cw = p.in[I_CW] + (size_t)l * 4 * 768 + ch;
    f32x4 acc = *(const f32x4*)(p.in[I_CB] + l * 768 + ch);
    const int pos = t & (SEQ_ - 1);
#pragma unroll
    for (int j = 0; j < 4; ++j) {
        if (pos - 3 + j >= 0) {
            const f32x4 x = h4f(*(const h16x4*)(proj + (size_t)(t - 3 + j) * NP + C_SX + ch));
            const f32x4 w = *(const f32x4*)(cw + j * 768);
            acc += x * w;
        }
    }
    f32x4 o; o[0] = siluf_(acc[0]); o[1] = siluf_(acc[1]); o[2] = siluf_(acc[2]); o[3] = siluf_(acc[3]);
    return o;
}
__device__ __forceinline__ void ssd_load(const Params& p, int l, const h16* proj, int t0, int h, int q4, float dtb, float Ah, LAS unsigned char* buf, int lt) {
    LAS float* sh = (LAS float*)(buf + SD_SH);
    const int g = h >> 1;
#pragma unroll 1
    for (int e = lt; e < CH * 68; e += 256) {
        const int tok = e / 68, gi = e - tok * 68, t = t0 + tok;
        if (gi < 64) {
            const int vec = gi >> 5, gj = gi & 31;
            const f32x4 v = ssd_conv4(p, l, proj, t, 256 + vec * 256 + g * 128 + gj * 4);
            *(LAS f32x4*)(sh + (tok * 16 + (gj >> 1)) * 16 + vec * 8 + (gj & 1) * 4) = v;
        } else {
            const int r4 = gi - 64;
            const f32x4 xs = ssd_conv4(p, l, proj, t, h * 64 + q4 * 16 + r4 * 4);
            const float dt = softplusf_((float)proj[(size_t)t * NP + C_SDT + h] + dtb);
            *(LAS f32x4*)(buf + SD_XS + (tok * 16 + r4 * 4) * 4) = xs;
            *(LAS f32x4*)(buf + SD_XDT + (tok * 16 + r4 * 4) * 4) = xs * dt;
            if (r4 == 0) *(LAS float*)(buf + SD_AB + tok * 4) = __expf(dt * Ah);
        }
    }
}
__device__ __forceinline__ void ssd_write_y(const h16* proj, h16* mix, int t0, int h, int q4, LAS unsigned char* ybuf, int lt) {
    if (lt < 128) { const int tok = lt >> 2, r4 = lt & 3, cc = h * 64 + q4 * 16 + r4 * 4;
        const f32x4 y = *(const LAS f32x4*)(ybuf + (tok * 16 + r4 * 4) * 4);
        const f32x4 z = h4f(*(const h16x4*)(proj + (size_t)(t0 + tok) * NP + C_SZ + cc));
        f32x4 o; o[0] = y[0] * siluf_(z[0]); o[1] = y[1] * siluf_(z[1]); o[2] = y[2] * siluf_(z[2]); o[3] = y[3] * siluf_(z[3]);
        *(h16x4*)(mix + (size_t)(t0 + tok) * DM + 512 + cc) = f4h(o); }
}
__device__ __forceinline__ void ssd_scan(const Params& p, int l, int item, LAS unsigned char* lds, const int tidx) {
    const int b = item >> 4, h = (item >> 2) & 3, q4 = item & 3;
    const int tid = tidx, wid = tid >> 6, lane = tid & 63, lt = tid - 256;
    const h16* proj = (const h16*)(p.ws + OFF_BIG);
    h16* mix = (h16*)(p.ws + OFF_MIX);
    const int tb = b * SEQ_;
    const bool loader = wid >= 4;
    const int rowl = (wid & 3) * 4 + (lane >> 4), sub = lane & 15;
    const float dtb = p.in[I_DTB][l * 4 + h], Ah = -__expf(p.in[I_ALOG][l * 4 + h]), Dh = p.in[I_SD][l * 4 + h];
    f32x4 S0 = {0.f, 0.f, 0.f, 0.f}, S1 = {0.f, 0.f, 0.f, 0.f};
    __syncthreads();
    if (loader) ssd_load(p, l, proj, tb, h, q4, dtb, Ah, lds, lt);
    __syncthreads();
#pragma unroll 1
    for (int c = 0; c < SEQ_ / CH; ++c) {
        LAS unsigned char* buf = lds + (c & 1) * SD_STRIDE;
        if (loader) {
            if (c + 1 < SEQ_ / CH) ssd_load(p, l, proj, tb + (c + 1) * CH, h, q4, dtb, Ah, lds + ((c + 1) & 1) * SD_STRIDE, lt);
            if (c > 0) ssd_write_y(proj, mix, tb + (c - 1) * CH, h, q4, lds + ((c - 1) & 1) * SD_STRIDE + SD_YB, lt);
        } else {
            const LAS float* sh = (const LAS float*)(buf + SD_SH);
            const LAS float* xdt = (const LAS float*)(buf + SD_XDT);
            const LAS float* xsb = (const LAS float*)(buf + SD_XS);
            const LAS float* ab = (const LAS float*)(buf + SD_AB);
            LAS float* yb = (LAS float*)(buf + SD_YB);
#pragma unroll 4
            for (int s = 0; s < CH; ++s) {
                const LAS f32x4* q = (const LAS f32x4*)(sh + (s * 16 + sub) * 16);
                const f32x4 B0 = q[0], B1 = q[1], C0 = q[2], C1 = q[3];
                const float a = ab[s], xd = xdt[s * 16 + rowl], xs = xsb[s * 16 + rowl];
                S0 = S0 * a + B0 * xd; S1 = S1 * a + B1 * xd;
                float y = S0[0] * C0[0] + S0[1] * C0[1] + S0[2] * C0[2] + S0[3] * C0[3] + S1[0] * C1[0] + S1[1] * C1[1] + S1[2] * C1[2] + S1[3] * C1[3];
                y = sum16(y) + Dh * xs;
                if (sub == 0) yb[s * 16 + rowl] = y;
            }
        }
        __syncthreads();
    }
    if (loader) ssd_write_y(proj, mix, tb + (SEQ_ / CH - 1) * CH, h, q4, lds + ((SEQ_ / CH - 1) & 1) * SD_STRIDE + SD_YB, lt);
}

__device__ __forceinline__ void attn_item(const Params& p, int item, const int tidx) {
    const int b = item / 192, rem = item - b * 192, h = rem / 48, s = rem - h * 48;
    int br, dil, r, n;
    if (s < 16) { br = 0; dil = 1; r = 0; n = s; } else if (s < 32) { br = 1; dil = 4; r = (s - 16) >> 2; n = (s - 16) & 3; } else { br = 2; dil = 16; r = s - 32; n = 0; }
    const int tid = tidx, wid = tid >> 6, lane = tid & 63, c16 = lane & 15, g = lane >> 4;
    const h16* base = (const h16*)(p.ws + OFF_BIG) + (size_t)b * SEQ_ * NP;
    const int tq = (n * 128 + 16 * wid + c16) * dil + r;
    h16x8 qf0 = *(const h16x8*)(base + (size_t)tq * NP + C_AQ + h * 64 + g * 8);
    h16x8 qf1 = *(const h16x8*)(base + (size_t)tq * NP + C_AQ + h * 64 + 32 + g * 8);
    f32x4 sc[9];
#pragma unroll
    for (int kt = 0; kt < 9; ++kt) {
        int kp = (n - 1) * 128 + 16 * wid + 16 * kt + c16; kp = kp < 0 ? 0 : kp;
        const h16* kr = base + (size_t)(kp * dil + r) * NP + C_AK + h * 64 + g * 8;
        const h16x8 k0 = *(const h16x8*)kr, k1 = *(const h16x8*)(kr + 32);
        f32x4 a = {0.f, 0.f, 0.f, 0.f};
        a = __builtin_amdgcn_mfma_f32_16x16x32_f16(k0, qf0, a, 0, 0, 0);
        a = __builtin_amdgcn_mfma_f32_16x16x32_f16(k1, qf1, a, 0, 0, 0);
        sc[kt] = a;
    }
    const float slope = exp2f(-2.0f * (float)(h + 1)) * (float)dil;
    float m = -INFINITY;
#pragma unroll
    for (int kt = 0; kt < 9; ++kt)
#pragma unroll
        for (int rg = 0; rg < 4; ++rg) {
            const int jj = 16 * kt + 4 * g + rg, dist = 128 + c16 - jj;
            const bool valid = (dist >= 0) && (dist <= 128) && (n > 0 || (16 * wid + jj) >= 128);
            const float v = valid ? (sc[kt][rg] * 0.125f - slope * (float)dist) : -INFINITY;
            sc[kt][rg] = v; m = fmaxf(m, v);
        }
    m = fmaxf(m, __shfl_xor(m, 16)); m = fmaxf(m, __shfl_xor(m, 32));
    float lsum = 0.f;
#pragma unroll
    for (int kt = 0; kt < 9; ++kt)
#pragma unroll
        for (int rg = 0; rg < 4; ++rg) { const float e = __expf(sc[kt][rg] - m); sc[kt][rg] = e; lsum += e; }
    lsum += __shfl_xor(lsum, 16); lsum += __shfl_xor(lsum, 32);
    f32x4 o[4];
#pragma unroll
    for (int d = 0; d < 4; ++d) o[d] = (f32x4){0.f, 0.f, 0.f, 0.f};
#pragma unroll
    for (int kt = 0; kt < 9; ++kt)
#pragma unroll
        for (int rg = 0; rg < 4; ++rg) {
            int kp = (n - 1) * 128 + 16 * wid + 16 * kt + 4 * g + rg; kp = kp < 0 ? 0 : kp;
            const f32x4 v = h4f(*(const h16x4*)(base + (size_t)(kp * dil + r) * NP + C_AV + h * 64 + 4 * c16));
#pragma unroll
            for (int d = 0; d < 4; ++d) o[d] = __builtin_amdgcn_mfma_f32_16x16x4f32(sc[kt][rg], v[d], o[d], 0, 0, 0);
        }
    h16* dst; int ld, co;
    if (br == 0) { dst = (h16*)(p.ws + OFF_MIX); ld = DM; co = 256; } else { dst = (h16*)(p.ws + (br == 1 ? OFF_O2 : OFF_O3)); ld = 256; co = 0; }
    float* lse = (float*)(p.ws + OFF_LSE) + (size_t)br * T_ * 4;
#pragma unroll
    for (int rg = 0; rg < 4; ++rg) {
        const int q = 4 * g + rg;
        const float inv = 1.0f / __shfl(lsum, q);
        const int t = b * SEQ_ + (n * 128 + 16 * wid + q) * dil + r;
        h16x4 ov; ov[0] = (h16)(o[0][rg] * inv); ov[1] = (h16)(o[1][rg] * inv); ov[2] = (h16)(o[2][rg] * inv); ov[3] = (h16)(o[3][rg] * inv);
        *(h16x4*)(dst + (size_t)t * ld + co + h * 64 + 4 * c16) = ov;
    }
    if (g == 0) lse[(size_t)(b * SEQ_ + tq) * 4 + h] = m + __logf(lsum);
}

__device__ __forceinline__ void mix_phase(const Params& p, int l, LAS unsigned char* lds, const int tidx) {
    unsigned* ctr = (unsigned*)(p.ws + OFF_MISC) + l;
    LAS unsigned* slot = (LAS unsigned*)(lds + LDS_BYTES - 16);
    for (;;) {
        __syncthreads();
        if (tidx == 0) *slot = atomicAdd(ctr, 1u);
        __syncthreads();
        const int it = (int)*slot;
        if (it >= 128 * 3 + 1536) break;
        if (it < 128) rwkv_scan(p, it, lds, tidx);
        else if (it < 256) ssd_scan(p, l, it - 128, lds, tidx);
        else if (it < 384) hgrn_scan(p, l, it - 256, lds, tidx);
        else attn_item(p, it - 384, tidx);
    }
}

__device__ __forceinline__ void post_phase(const Params& p, int l, const int tidx) {
    const int wid = tidx >> 6, lane = tidx & 63;
    h16* mix = (h16*)(p.ws + OFF_MIX);
    const h16* prep = (const h16*)p.out;
    const h16* proj = (const h16*)(p.ws + OFF_BIG);
    const h16* o2 = (const h16*)(p.ws + OFF_O2);
    const h16* o3 = (const h16*)(p.ws + OFF_O3);
    const float* lse = (const float*)(p.ws + OFF_LSE);
    const f32x4 snw = *(const f32x4*)(p.in[I_SNW] + l * 256 + 4 * lane);
    const f32x4 hnw = *(const f32x4*)(p.in[I_HNW] + l * 256 + 4 * lane);
    const int hd = lane >> 4;
    for (int t = blockIdx.x * 8 + wid; t < T_; t += gridDim.x * 8) {
        h16* mr = mix + (size_t)t * DM + 4 * lane;
        {
            const f32x4 y = h4f(*(const h16x4*)mr);
            const float mu = sum16(y[0] + y[1] + y[2] + y[3]) * (1.0f / 64.0f);
            const f32x4 d = y - mu;
            const float var = sum16(d[0] * d[0] + d[1] * d[1] + d[2] * d[2] + d[3] * d[3]) * (1.0f / 64.0f);
            const float rstd = rsqrtf(var + 64e-5f);
            const f32x4 A = h4f(*(const h16x4*)(prep + (size_t)t * 2048 + 1536 + 4 * lane));
            const f32x4 Bc = h4f(*(const h16x4*)(prep + (size_t)t * 2048 + 1792 + 4 * lane));
            *(h16x4*)mr = f4h(d * rstd * A + Bc);
        }
        {
            const f32x4 a1 = h4f(*(const h16x4*)(mr + 256));
            const f32x4 a2 = h4f(*(const h16x4*)(o2 + (size_t)t * 256 + 4 * lane));
            const f32x4 a3 = h4f(*(const h16x4*)(o3 + (size_t)t * 256 + 4 * lane));
            const float l1 = lse[(size_t)t * 4 + hd], l2 = lse[(size_t)(T_ + t) * 4 + hd], l3 = lse[(size_t)(2 * T_ + t) * 4 + hd];
            const float mx = fmaxf(l1, fmaxf(l2, l3));
            const float w1 = __expf(l1 - mx), w2 = __expf(l2 - mx), w3 = __expf(l3 - mx);
            const float inv = 1.0f / (w1 + w2 + w3);
            *(h16x4*)(mr + 256) = f4h((a1 * w1 + a2 * w2 + a3 * w3) * inv);
        }
        {
            const f32x4 u = h4f(*(const h16x4*)(mr + 512));
            float ss = sum16(u[0] * u[0] + u[1] * u[1] + u[2] * u[2] + u[3] * u[3]);
            ss += __shfl_xor(ss, 16);
            const float rstd = rsqrtf(ss * (1.0f / 128.0f) + 1e-5f);
            *(h16x4*)(mr + 512) = f4h(u * rstd * snw);
        }
        {
            const f32x4 u = h4f(*(const h16x4*)(mr + 768));
            const float ss = sum16(u[0] * u[0] + u[1] * u[1] + u[2] * u[2] + u[3] * u[3]);
            const float rstd = rsqrtf(ss * (1.0f / 64.0f) + 1e-5f);
            const f32x4 gz = h4f(*(const h16x4*)(proj + (size_t)t * NP + C_HG + 4 * lane));
            f32x4 gt; gt[0] = siluf_(gz[0]); gt[1] = siluf_(gz[1]); gt[2] = siluf_(gz[2]); gt[3] = siluf_(gz[3]);
            *(h16x4*)(mr + 768) = f4h(u * rstd * hnw * gt);
        }
    }
}

__device__ __forceinline__ void ln_phase(const Params& p, const float* w, const float* bvec, bool final_out, const int tidx) {
    const int wid = tidx >> 6, lane = tidx & 63;
    h16* x16 = (h16*)(p.ws + OFF_X16);
    f32x4 wv[4], bv[4];
#pragma unroll
    for (int q = 0; q < 4; ++q) { wv[q] = *(const f32x4*)(w + lane * 16 + 4 * q); bv[q] = *(const f32x4*)(bvec + lane * 16 + 4 * q); }
    for (int t = blockIdx.x * 8 + wid; t < T_; t += gridDim.x * 8) {
        h16* row = x16 + (size_t)t * DM + lane * 16;
        const h16x8 v0 = *(const h16x8*)row, v1 = *(const h16x8*)(row + 8);
        float x[16];
#pragma unroll
        for (int j = 0; j < 8; ++j) { x[j] = (float)v0[j]; x[8 + j] = (float)v1[j]; }
        float s = 0.f;
#pragma unroll
        for (int j = 0; j < 16; ++j) s += x[j];
        const float mu = sum64(s) * (1.0f / 1024.0f);
        float q2 = 0.f;
#pragma unroll
        for (int j = 0; j < 16; ++j) { x[j] -= mu; q2 += x[j] * x[j]; }
        const float rstd = rsqrtf(sum64(q2) * (1.0f / 1024.0f) + 1e-5f);
#pragma unroll
        for (int j = 0; j < 16; ++j) x[j] = x[j] * rstd * wv[j >> 2][j & 3] + bv[j >> 2][j & 3];
        if (final_out) {
            float* orow = p.out + (size_t)t * DM + lane * 16;
#pragma unroll
            for (int q = 0; q < 4; ++q) *(f32x4*)(orow + 4 * q) = (f32x4){x[4 * q], x[4 * q + 1], x[4 * q + 2], x[4 * q + 3]};
        } else {
            h16x8 o0, o1;
#pragma unroll
            for (int j = 0; j < 8; ++j) { o0[j] = (h16)x[j]; o1[j] = (h16)x[8 + j]; }
            *(h16x8*)row = o0; *(h16x8*)(row + 8) = o1;
        }
    }
}

constexpr int NPHASE = 19;
__device__ __forceinline__ void run_phase(const Params& p, int ph, LAS unsigned char* lds, const int tidx) {
    const int l = (ph == 0) ? 0 : (ph - 1) / 9, s = (ph == 0) ? -1 : (ph - 1) % 9;
    h16* x16 = (h16*)(p.ws + OFF_X16);
    h16* mix = (h16*)(p.ws + OFF_MIX);
    h16* big = (h16*)(p.ws + OFF_BIG);
    if (ph == 0) {
        if (blockIdx.x == 0 && tidx < 8) ((unsigned*)(p.ws + OFF_MISC))[tidx] = 0u;
        conv_x(p, tidx);
    }
    if (s == 0 || s == 4 || s == 6 || s == 7) {
        const h16* A = (s == 0 || s == 6) ? x16 : (s == 4 ? mix : big);
        const h16* Bt = (const h16*)(p.ws + (s == 0 ? OFF_WIN : s == 4 ? OFF_WOUT : s == 6 ? OFF_WUP : OFF_WDN));
        const int N = (s == 0) ? NP : (s == 6 ? DFF : DM), K = (s == 7) ? DFF : DM;
        h16* O = (s == 0 || s == 6) ? big : x16;
        run_gemm(lds, A, Bt, N, K, O, N, (s == 0) ? 0 : (s == 6 ? 1 : 2), tidx);
    }
    if (s == 1) pre_phase(p, l, lds, tidx);
    if (s == 2) mix_phase(p, l, lds, tidx);
    if (s == 3) post_phase(p, l, tidx);
    if (s == 5 || s == 8) ln_phase(p, p.in[s == 5 ? I_LN1W : I_LN2W] + l * DM, p.in[s == 5 ? I_LN1B : I_LN2B] + l * DM, s == 8 && l == 1, tidx);
    if (ph == 0 || (s == 8 && l == 0)) conv_weights(p, ph == 0 ? 0 : 1, lds, tidx);
}

__global__ void __launch_bounds__(512, 2) k_phase(Params p, int ph) {
    extern __shared__ __attribute__((aligned(16))) unsigned char shm[];
    const int tidx = threadIdx.x;
    run_phase(p, ph, (LAS unsigned char*)shm, tidx);
}

#if COOP
__global__ void __launch_bounds__(512, 2) k_mega(Params p) {
    extern __shared__ __attribute__((aligned(16))) unsigned char shm[];
    cg::grid_group grid = cg::this_grid();
#pragma unroll 1
    for (int ph = 0; ph < NPHASE; ++ph) {
        int tidx = threadIdx.x; asm volatile("" : "+v"(tidx));
        run_phase(p, ph, (LAS unsigned char*)shm, tidx);
        if (ph + 1 < NPHASE) grid.sync();
    }
}
#endif

extern "C" void kernel_launch(void* const* d_in, const int* in_sizes, int n_in, void* d_out, int out_size, void* d_ws, size_t ws_size, hipStream_t stream) {
    static int grid_blocks = 0;
    if (!grid_blocks) {
        int dev = 0, cus = 0, per_cu = 0;
        hipGetDevice(&dev);
        hipDeviceGetAttribute(&cus, hipDeviceAttributeMultiprocessorCount, dev);
        hipFuncSetAttribute((const void*)k_phase, hipFuncAttributeMaxDynamicSharedMemorySize, LDS_BYTES);
#if COOP
        hipFuncSetAttribute((const void*)k_mega, hipFuncAttributeMaxDynamicSharedMemorySize, LDS_BYTES);
        hipOccupancyMaxActiveBlocksPerMultiprocessor(&per_cu, (const void*)k_mega, 512, LDS_BYTES);
#endif
        if (per_cu < 1) per_cu = 1;
        grid_blocks = cus * 1;
        (void)hipGetLastError();
    }
    Params p{};
    for (int i = 0; i < 32; ++i) p.in[i] = (const float*)d_in[i];
    p.out = (float*)d_out; p.ws = (unsigned char*)d_ws;
#if COOP
    void* args[] = {&p};
    hipError_t e = hipLaunchCooperativeKernel((const void*)k_mega, dim3(grid_blocks), dim3(512), args, LDS_BYTES, stream);
    if (e != hipSuccess) fprintf(stderr, "cooperative launch failed: %s (grid %d)\n", hipGetErrorString(e), grid_blocks);
#else
    for (int ph = 0; ph < NPHASE; ++ph) k_phase<<<dim3(grid_blocks), dim3(512), LDS_BYTES, stream>>>(p, ph);
#endif
}
```

```cpp
#include <hip/hip_runtime.h>
#include <hip/hip_cooperative_groups.h>
#include <cstdio>
namespace cg = cooperative_groups;

#ifndef COOP
#define COOP 1
#endif

#define LAS __attribute__((address_space(3)))
typedef _Float16 h16;
typedef _Float16 h16x4 __attribute__((ext_vector_type(4)));
typedef _Float16 h16x8 __attribute__((ext_vector_type(8)));
typedef float f32x2 __attribute__((ext_vector_type(2)));
typedef float f32x4 __attribute__((ext_vector_type(4)));

constexpr int T_ = 16384, SEQ_ = 2048, DM = 1024, NP = 3840, DFF = 4096, INC = 3716;
constexpr int C_R = 0, C_K = 256, C_V = 512, C_FW = 768, C_VR = 896, C_AQ = 928, C_AK = 1184, C_AV = 1440;
constexpr int C_SZ = 1696, C_SX = 1952, C_SDT = 2720, C_HQ = 2728, C_HF = 2984, C_HI = 3240, C_HG = 3496;
constexpr float ALPHA_ = 1.41421356237f;
constexpr size_t OFF_WIN = 0, OFF_WOUT = 7864320, OFF_WUP = OFF_WOUT + 2097152, OFF_WDN = OFF_WUP + 8388608;
constexpr size_t OFF_X16 = 26738688, OFF_MIX = OFF_X16 + 33554432, OFF_BIG = OFF_MIX + 33554432;
constexpr size_t OFF_VF = OFF_BIG + 134217728, OFF_O2 = OFF_VF + 8388608, OFF_O3 = OFF_O2 + 8388608, OFF_LSE = OFF_O3 + 8388608;
constexpr size_t OFF_MISC = OFF_LSE + 786432;
constexpr int LDS_BYTES = 131072;

struct Params { const float* in[32]; float* out; unsigned char* ws; };

enum { I_X = 0, I_LB, I_WIN, I_WINV, I_MU, I_MUV, I_W0, I_W2, I_A0, I_A2, I_G2, I_KK, I_KA, I_RK, I_LNW, I_LNB, I_V0, I_V2,
       I_CW, I_CB, I_DTB, I_ALOG, I_SD, I_SNW, I_HNW, I_WOUT, I_LN1W, I_LN1B, I_WUP, I_WDN, I_LN2W, I_LN2B };

template <int CTRL> __device__ __forceinline__ float dpp_f(float x) {
    return __builtin_bit_cast(float, __builtin_amdgcn_update_dpp(0, __builtin_bit_cast(int, x), CTRL, 0xF, 0xF, true));
}
__device__ __forceinline__ float sum16(float x) {
    x += dpp_f<0xB1>(x);
    x += dpp_f<0x4E>(x);
    x += dpp_f<0x141>(x);
    x += dpp_f<0x140>(x);
    return x;
}
__device__ __forceinline__ float sum64(float x) { x = sum16(x); x += __shfl_xor(x, 16); x += __shfl_xor(x, 32); return x; }
__device__ __forceinline__ float sigmoidf_(float x) { return 1.0f / (1.0f + __expf(-x)); }
__device__ __forceinline__ float siluf_(float x) { return x / (1.0f + __expf(-x)); }
__device__ __forceinline__ float softplusf_(float x) { return fmaxf(x, 0.f) + log1pf(__expf(-fabsf(x))); }
__device__ __forceinline__ f32x4 h4f(h16x4 v) { return (f32x4){(float)v[0], (float)v[1], (float)v[2], (float)v[3]}; }
__device__ __forceinline__ h16x4 f4h(f32x4 v) { return (h16x4){(h16)v[0], (h16)v[1], (h16)v[2], (h16)v[3]}; }

namespace pg8 {
constexpr int BM = 256, BK = 64, HALF = 128, HTB = HALF * BK * 2, STAGE_BYTES = 8 * HTB, NXCD = 8, WGM = 8;
__host__ __device__ __forceinline__ int lds_byte(int r, int c) { const int st = (r >> 4) * 2 + (c >> 5), rr = r & 15, cc = c & 31, ob = rr * 64 + cc * 2; return st * 1024 + (ob ^ (((ob >> 9) & 1) << 5)); }
__host__ __device__ __forceinline__ void stage_rc(int b, int& R, int& C) { const int st = b / 1024, sb = b % 1024, swz = sb ^ (((sb >> 9) & 1) << 5); R = (st >> 1) * 16 + swz / 64; C = (st & 1) * 32 + (swz % 64) / 2; }
__host__ __device__ __forceinline__ int perm32(int rho) { const int n = rho >> 4, i = rho & 15; return 8 * (i >> 2) + 4 * n + (i & 3); }
struct Unit { int pm, pn; };
struct Gemm { const h16* A; const h16* Bt; int M, N, K; };
struct StaticOrder {
    int nM, nN, nwg, G, c;
    __device__ void init(int M, int N, int G_, int c_) { nM = M / BM; nN = N / BM; nwg = nM * nN; G = G_; c = c_; }
    __device__ bool next(int i, Unit& u) const {
        const long L = (long)i * G + c; if (L >= nwg) return false;
        int wgid = (int)L; { const int q = nwg / NXCD, r = nwg % NXCD, xcd = wgid % NXCD, off = wgid / NXCD; wgid = (xcd < r ? xcd * (q + 1) : r * (q + 1) + (xcd - r) * q) + off; }
        const int nig = WGM * nN, gid = wgid / nig, fm = gid * WGM, gsz = (nM - fm) < WGM ? (nM - fm) : WGM;
        u.pm = fm + ((wgid % nig) % gsz); u.pn = (wgid % nig) / gsz; return true;
    }
};
struct EpiH {
    h16* O; int ldc; int MODE;
    __device__ __forceinline__ void operator()(const f32x4 (&acc)[2][2][4][2], const Unit& u, int wr, int wc, int fr, int fq) const {
        const int row0 = u.pm * BM + wr * 64 + fr, col0 = u.pn * BM + wc * 32 + 8 * fq;
#pragma unroll
        for (int ai = 0; ai < 2; ++ai)
#pragma unroll
            for (int m = 0; m < 4; ++m) { h16* rowp = O + (size_t)(row0 + ai * HALF + m * 16) * ldc + col0;
#pragma unroll
                for (int bj = 0; bj < 2; ++bj) { f32x4 v0 = acc[ai][bj][m][0], v1 = acc[ai][bj][m][1];
                    if (MODE == 1) {
#pragma unroll
                        for (int j = 0; j < 4; ++j) { float a = fmaxf(v0[j], 0.f), b = fmaxf(v1[j], 0.f); v0[j] = a * a; v1[j] = b * b; } }
                    if (MODE == 2) { const h16x8 x = *(const h16x8*)(rowp + bj * HALF);
#pragma unroll
                        for (int j = 0; j < 4; ++j) { v0[j] += ALPHA_ * (float)x[j]; v1[j] += ALPHA_ * (float)x[4 + j]; } }
                    h16x8 w;
#pragma unroll
                    for (int j = 0; j < 4; ++j) { w[j] = (h16)v0[j]; w[4 + j] = (h16)v1[j]; }
                    *(h16x8*)(rowp + bj * HALF) = w; } }
    }
};

template <class Epi>
__device__ __forceinline__ void gemm_phase(LAS unsigned char* lds, const Gemm g, const StaticOrder& S, const Epi& E, const int tidx) {
    const int tid = tidx, wid = __builtin_amdgcn_readfirstlane(tid >> 6), lane = tid & 63, wr = wid >> 2, wc = wid & 3, fr = lane & 15, fq = lane >> 4;
    const int K = g.K, nt = K / BK;
    unsigned voffA[2], voffB[2];
#pragma unroll
    for (int i = 0; i < 2; ++i) { int R, C; stage_rc(tid * 16 + i * 8192, R, C); const int Rb = (R & ~31) + perm32(R & 31);
        voffA[i] = (unsigned)(R * K + C) * 2u; voffB[i] = (unsigned)(Rb * K + C) * 2u; }
    const size_t kstep = (size_t)(BK * 2);
    const size_t hstep = (size_t)HALF * K * 2;
    const size_t tstep = 2 * hstep;
    const unsigned ldsw = (unsigned)wid * 1024u;
    const int aoff = lds_byte(wr * 64 + fr, fq * 8), boff = lds_byte(wc * 32 + fr, fq * 8);
#define PG8_SA(b, h) (((b) * 2 + (h)) * HTB)
#define PG8_SB(b, h) ((4 + (b) * 2 + (h)) * HTB)
#define PG8_STAGE(bufoff, gbase, voff) do { _Pragma("unroll") for (int _i = 0; _i < 2; ++_i) \
        __builtin_amdgcn_global_load_lds((const unsigned*)((const char*)(gbase) + (voff)[_i]), (LAS unsigned*)(lds + (bufoff) + ldsw + _i * 8192), 16, 0, 0); } while (0)
#define PG8_LDA(dst, b, h) do { _Pragma("unroll") for (int m = 0; m < 4; ++m) _Pragma("unroll") for (int k = 0; k < 2; ++k) dst[m][k] = *(const LAS h16x8*)(lds + PG8_SA(b, h) + aoff + m * 2048 + k * 1024); } while (0)
#define PG8_LDB(dst, b, h) do { _Pragma("unroll") for (int n = 0; n < 2; ++n) _Pragma("unroll") for (int k = 0; k < 2; ++k) dst[n][k] = *(const LAS h16x8*)(lds + PG8_SB(b, h) + boff + n * 2048 + k * 1024); } while (0)
#define PG8_MMA(ai, bj, At, Bt) do { __builtin_amdgcn_s_setprio(1); _Pragma("unroll") for (int m = 0; m < 4; ++m) _Pragma("unroll") for (int n = 0; n < 2; ++n) _Pragma("unroll") for (int k = 0; k < 2; ++k) \
        acc[ai][bj][m][n] = __builtin_amdgcn_mfma_f32_16x16x32_f16(Bt[n][k], At[m][k], acc[ai][bj][m][n], 0, 0, 0); __builtin_amdgcn_s_setprio(0); } while (0)
#define PG8_WAIT_V(n) asm volatile("s_waitcnt vmcnt(" #n ")" ::: "memory")
#define PG8_WAIT_L(n) asm volatile("s_waitcnt lgkmcnt(" #n ")" ::: "memory")
#define PG8_BAR __builtin_amdgcn_s_barrier()
#define PG8_SCHED __builtin_amdgcn_sched_barrier(0)
    Unit cur, nxt; int ui = 0;
    if (!S.next(0, cur)) return;
    f32x4 acc[2][2][4][2];
#pragma unroll
    for (int a = 0; a < 2; ++a)
#pragma unroll
        for (int b = 0; b < 2; ++b)
#pragma unroll
            for (int m = 0; m < 4; ++m)
#pragma unroll
                for (int n = 0; n < 2; ++n) acc[a][b][m][n] = (f32x4){0.f, 0.f, 0.f, 0.f};
    h16x8 At[4][2], B0[2][2], B1[2][2];
    const char* cA = (const char*)g.A + (size_t)cur.pm * tstep; const char* cB = (const char*)g.Bt + (size_t)cur.pn * tstep;
    PG8_STAGE(PG8_SB(0, 0), cB, voffB); PG8_STAGE(PG8_SA(0, 0), cA, voffA); PG8_STAGE(PG8_SB(0, 1), cB + hstep, voffB); PG8_STAGE(PG8_SA(0, 1), cA + hstep, voffA);
    if (wr == 1) PG8_BAR;
    PG8_WAIT_V(4); PG8_BAR;
    PG8_STAGE(PG8_SB(1, 0), cB + kstep, voffB); PG8_STAGE(PG8_SA(1, 0), cA + kstep, voffA); PG8_STAGE(PG8_SB(1, 1), cB + hstep + kstep, voffB);
    PG8_WAIT_V(6); PG8_BAR;
    for (;;) {
        const bool has_next = S.next(ui + 1, nxt);
        const char* nA = has_next ? (const char*)g.A + (size_t)nxt.pm * tstep : cA; const char* nB = has_next ? (const char*)g.Bt + (size_t)nxt.pn * tstep : cB;
        for (int t = 0; t < nt; t += 2) {
            const bool last = (t == nt - 2);
            const char* a1 = cA + (size_t)(t + 1) * kstep;
            const char* a2 = last ? nA : cA + (size_t)(t + 2) * kstep; const char* b2 = last ? nB : cB + (size_t)(t + 2) * kstep;
            const char* a3 = a2 + kstep; const char* b3 = b2 + kstep;
            PG8_LDB(B0, 0, 0); PG8_SCHED; PG8_LDA(At, 0, 0); PG8_STAGE(PG8_SA(1, 1), a1 + hstep, voffA);
            PG8_WAIT_L(8); PG8_BAR; PG8_WAIT_L(0); PG8_MMA(0, 0, At, B0); PG8_BAR; PG8_SCHED;
            PG8_LDB(B1, 0, 1); PG8_STAGE(PG8_SB(0, 0), b2, voffB);
            PG8_BAR; PG8_WAIT_L(0); PG8_MMA(0, 1, At, B1); PG8_BAR;
            PG8_LDA(At, 0, 1); PG8_STAGE(PG8_SA(0, 0), a2, voffA);
            PG8_BAR; PG8_WAIT_L(0); PG8_MMA(1, 0, At, B0); PG8_BAR; PG8_SCHED;
            PG8_STAGE(PG8_SB(0, 1), b2 + hstep, voffB);
            PG8_WAIT_V(6); PG8_BAR; PG8_MMA(1, 1, At, B1); PG8_BAR;
            PG8_LDB(B0, 1, 0); PG8_SCHED; PG8_LDA(At, 1, 0); PG8_STAGE(PG8_SA(0, 1), a2 + hstep, voffA);
            PG8_WAIT_L(8); PG8_BAR; PG8_WAIT_L(0); PG8_MMA(0, 0, At, B0); PG8_BAR; PG8_SCHED;
            PG8_LDB(B1, 1, 1); PG8_STAGE(PG8_SB(1, 0), b3, voffB);
            PG8_BAR; PG8_WAIT_L(0); PG8_MMA(0, 1, At, B1); PG8_BAR;
            PG8_LDA(At, 1, 1); PG8_STAGE(PG8_SA(1, 0), a3, voffA);
            PG8_BAR; PG8_WAIT_L(0); PG8_MMA(1, 0, At, B0); PG8_BAR; PG8_SCHED;
            PG8_STAGE(PG8_SB(1, 1), b3 + hstep, voffB);
            PG8_WAIT_V(6); PG8_BAR; PG8_MMA(1, 1, At, B1); PG8_BAR;
        }
        E(acc, cur, wr, wc, fr, fq);
        if (!has_next) break;
#pragma unroll
        for (int a = 0; a < 2; ++a)
#pragma unroll
            for (int b = 0; b < 2; ++b)
#pragma unroll
                for (int m = 0; m < 4; ++m)
#pragma unroll
                    for (int n = 0; n < 2; ++n) acc[a][b][m][n] = (f32x4){0.f, 0.f, 0.f, 0.f};
        cur = nxt; cA = nA; cB = nB; ++ui;
    }
    PG8_WAIT_V(0);
    if (wr == 0) PG8_BAR;
    PG8_BAR;
#undef PG8_SA
#undef PG8_SB
#undef PG8_STAGE
#undef PG8_LDA
#undef PG8_LDB
#undef PG8_MMA
#undef PG8_WAIT_V
#undef PG8_WAIT_L
#undef PG8_BAR
#undef PG8_SCHED
}
}

__device__ __forceinline__ void run_gemm(LAS unsigned char* lds, const h16* A, const h16* Bt, int N, int K, h16* O, int ldc, int mode, const int tidx) {
    pg8::Gemm g; g.A = A; g.Bt = Bt; g.M = T_; g.N = N; g.K = K;
    pg8::StaticOrder S; S.init(T_, N, (int)gridDim.x, (int)blockIdx.x);
    pg8::EpiH E; E.O = O; E.ldc = ldc; E.MODE = mode;
    pg8::gemm_phase(lds, g, S, E, tidx);
}

__device__ __forceinline__ void conv_weights(const Params& p, int l, LAS unsigned char* lds, const int tidx) {
    LAS float* tile = (LAS float*)lds;
    const int tid = tidx;
    for (int id = blockIdx.x; id < 3264; id += gridDim.x) {
        int mat, tl;
        if (id < 960) { mat = 0; tl = id; } else if (id < 1216) { mat = 1; tl = id - 960; } else if (id < 2240) { mat = 2; tl = id - 1216; } else { mat = 3; tl = id - 2240; }
        const int K = (mat == 3) ? 4096 : 1024;
        const int nkt = K / 64;
        const int n0 = (tl / nkt) * 64, k0 = (tl % nkt) * 64;
        h16* dst = (h16*)(p.ws + (mat == 0 ? OFF_WIN : mat == 1 ? OFF_WOUT : mat == 2 ? OFF_WUP : OFF_WDN));
        __syncthreads();
        {
            const int nj = tid & 63, n = n0 + nj;
            const float* src = nullptr; int sstride = 0;
            if (mat == 0) {
                if (n < 896) { src = p.in[I_WIN] + (size_t)l * DM * INC + n; sstride = INC; }
                else if (n < 928) { if (l > 0) { src = p.in[I_WINV] + (size_t)(l - 1) * DM * 32 + (n - 896); sstride = 32; } }
                else if (n < 2724) { src = p.in[I_WIN] + (size_t)l * DM * INC + (n - 32); sstride = INC; }
                else if (n < 2728) { }
                else if (n < 3752) { src = p.in[I_WIN] + (size_t)l * DM * INC + (n - 36); sstride = INC; }
            } else if (mat == 1) { src = p.in[I_WOUT] + (size_t)l * 1024 * 1024 + n; sstride = 1024; }
            else if (mat == 2) { src = p.in[I_WUP] + (size_t)l * 1024 * 4096 + n; sstride = 4096; }
            else { src = p.in[I_WDN] + (size_t)l * 4096 * 1024 + n; sstride = 1024; }
#pragma unroll
            for (int i = 0; i < 8; ++i) { const int ki = (tid >> 6) + 8 * i; tile[ki * 65 + nj] = src ? src[(size_t)(k0 + ki) * sstride] : 0.f; }
        }
        __syncthreads();
        {
            const int ki = tid & 63;
#pragma unroll
            for (int i = 0; i < 8; ++i) { const int nj = (tid >> 6) + 8 * i; dst[(size_t)(n0 + nj) * K + k0 + ki] = (h16)tile[ki * 65 + nj]; }
        }
    }
    __syncthreads();
}

__device__ __forceinline__ void conv_x(const Params& p, const int tidx) {
    const f32x4* src = (const f32x4*)p.in[I_X]; h16x4* dst = (h16x4*)(p.ws + OFF_X16);
    for (size_t i = (size_t)blockIdx.x * 512 + tidx; i < (size_t)T_ * DM / 4; i += (size_t)gridDim.x * 512) dst[i] = f4h(src[i]);
}

__device__ __forceinline__ void pre_phase(const Params& p, int l, LAS unsigned char* lds, const int tidx) {
    LAS float* act = (LAS float*)lds;
    const h16* proj = (const h16*)(p.ws + OFF_BIG);
    h16* prep = (h16*)p.out;
    h16* vfirst = (h16*)(p.ws + OFF_VF);
    const int tid = tidx;
    const int c = tid & 255, hf = tid >> 8, hh = c >> 6;
    const int nact = (l == 0) ? 128 : 160;
    const float mu_r = p.in[I_MU][l * 896 + c], mu_k = p.in[I_MU][l * 896 + 256 + c], mu_v = p.in[I_MU][l * 896 + 512 + c];
    const float w0 = p.in[I_W0][l * 256 + c], a0 = p.in[I_A0][l * 256 + c], k_k = p.in[I_KK][l * 256 + c], k_a = p.in[I_KA][l * 256 + c];
    const float r_k = p.in[I_RK][l * 256 + c], lnw = p.in[I_LNW][l * 256 + c], lnb = p.in[I_LNB][l * 256 + c];
    const float v0 = (l > 0) ? p.in[I_V0][(l - 1) * 256 + c] : 0.f;
    const float* w2 = p.in[I_W2] + (size_t)l * 32 * 256 + c;
    const float* a2 = p.in[I_A2] + (size_t)l * 32 * 256 + c;
    const float* g2 = p.in[I_G2] + (size_t)l * 64 * 256 + c;
    const float* v2 = p.in[I_V2] + (size_t)(l > 0 ? l - 1 : 0) * 32 * 256 + c;
    for (int tt = blockIdx.x; tt < T_ / 64; tt += gridDim.x) {
        const int t0 = tt * 64;
        __syncthreads();
        for (int e = tid; e < 64 * 160; e += 512) {
            const int tok = e / 160, i = e - tok * 160;
            if (i < nact) {
                const int t = t0 + tok;
                const float cur = (float)proj[(size_t)t * NP + C_FW + i];
                const float prv = (t & (SEQ_ - 1)) ? (float)proj[(size_t)(t - 1) * NP + C_FW + i] : 0.f;
                const float mu = (i < 128) ? p.in[I_MU][l * 896 + 768 + i] : p.in[I_MUV][(l - 1) * 32 + (i - 128)];
                const float f = cur + (prv - cur) * mu;
                float a = f;
                if (i < 32) a = tanhf(f); else if (i >= 64 && i < 128) a = sigmoidf_(f);
                act[i * 64 + tok] = a;
            }
        }
        __syncthreads();
#pragma unroll 1
        for (int grp = 0; grp < 2; ++grp) {
            const int tb = hf * 32 + grp * 16;
            float aw[16], aa[16], ag[16], av[16];
#pragma unroll
            for (int j = 0; j < 16; ++j) { aw[j] = 0.f; aa[j] = 0.f; ag[j] = 0.f; av[j] = 0.f; }
#pragma unroll 2
            for (int i = 0; i < 32; ++i) {
                const float ww = w2[i * 256], wa = a2[i * 256];
                const LAS f32x4* r1 = (const LAS f32x4*)(act + i * 64 + tb);
                const LAS f32x4* r2 = (const LAS f32x4*)(act + (32 + i) * 64 + tb);
#pragma unroll
                for (int q = 0; q < 4; ++q) { const f32x4 x = r1[q], y = r2[q];
#pragma unroll
                    for (int j = 0; j < 4; ++j) { aw[4 * q + j] += x[j] * ww; aa[4 * q + j] += y[j] * wa; } }
            }
#pragma unroll 2
            for (int i = 0; i < 64; ++i) {
                const float wg = g2[i * 256];
                const LAS f32x4* r1 = (const LAS f32x4*)(act + (64 + i) * 64 + tb);
#pragma unroll
                for (int q = 0; q < 4; ++q) { const f32x4 x = r1[q];
#pragma unroll
                    for (int j = 0; j < 4; ++j) ag[4 * q + j] += x[j] * wg; }
            }
            if (l > 0) {
#pragma unroll 2
                for (int i = 0; i < 32; ++i) {
                    const float wv = v2[i * 256];
                    const LAS f32x4* r1 = (const LAS f32x4*)(act + (128 + i) * 64 + tb);
#pragma unroll
                    for (int q = 0; q < 4; ++q) { const f32x4 x = r1[q];
#pragma unroll
                        for (int j = 0; j < 4; ++j) av[4 * q + j] += x[j] * wv; }
                }
            }
#pragma unroll
            for (int j = 0; j < 16; ++j) {
                const int t = t0 + tb + j;
                const h16* row = proj + (size_t)t * NP;
                float r = (float)row[C_R + c], k = (float)row[C_K + c], v = (float)row[C_V + c];
                float pr = 0.f, pk = 0.f, pv = 0.f;
                if (t & (SEQ_ - 1)) { pr = (float)row[C_R + c - NP]; pk = (float)row[C_K + c - NP]; pv = (float)row[C_V + c - NP]; }
                r += (pr - r) * mu_r; k += (pk - k) * mu_k; v += (pv - v) * mu_v;
                const float wl = w0 + aw[j];
                const float wlog = -softplusf_(-wl) - 0.5f;
                const float ee = __expf(wlog);
                const float a = sigmoidf_(a0 + aa[j]);
                if (l == 0) vfirst[(size_t)t * 256 + c] = (h16)v;
                else { const float vf = (float)vfirst[(size_t)t * 256 + c]; v += (vf - v) * sigmoidf_(v0 + av[j]); }
                const float kkr = k * k_k;
                const float nrm = sqrtf(sum64(kkr * kkr));
                const float kk = kkr / fmaxf(nrm, 1e-12f);
                const float kp = k * (1.0f + (a - 1.0f) * k_a);
                const float bb = kk * a;
                const float bonus = sum64(r * kp * r_k);
                const float g = ag[j];
                h16* o = prep + (size_t)t * 2048 + c;
                o[0] = (h16)r; o[256] = (h16)ee; o[512] = (h16)kp; o[768] = (h16)kk; o[1024] = (h16)bb; o[1280] = (h16)v;
                o[1536] = (h16)(lnw * g); o[1792] = (h16)((lnb + bonus * v) * g);
            }
        }
    }
    __syncthreads();
    (void)hh;
}

constexpr int CH = 32;

__device__ __forceinline__ float dot4(f32x4 a, f32x4 b) { return (a[0] * b[0] + a[1] * b[1]) + (a[2] * b[2] + a[3] * b[3]); }
__device__ __forceinline__ void plain_write_y(h16* mix, int t0, int col, LAS unsigned char* ybuf, int lt) {
    const int tok = lt >> 3, r8 = lt & 7;
    const f32x4 y = *(const LAS f32x4*)(ybuf + (tok * 32 + r8 * 4) * 4);
    *(h16x4*)(mix + (size_t)(t0 + tok) * DM + col + r8 * 4) = f4h(y);
}

constexpr int RW_SH = 0, RW_VB = CH * 16 * 20 * 4, RW_YB = RW_VB + CH * 32 * 4, RW_STRIDE = RW_YB + CH * 32 * 4;
__device__ __forceinline__ void rwkv_load(const h16* prep, int t0, int h, int rowbase, LAS unsigned char* buf, int lt) {
    LAS float* sh = (LAS float*)(buf + RW_SH);
    h16x4 raw[10];
#pragma unroll
    for (int i = 0; i < 10; ++i) {
        const int e = i * 256 + lt, tok = e / 80, rem = e - tok * 80, vec = rem >> 4, sub = rem & 15;
        const int pv = (vec == 0) ? 3 : (vec == 1) ? 1 : (vec == 2) ? 4 : (vec == 3) ? 2 : 0;
        raw[i] = *(const h16x4*)(prep + (size_t)(t0 + tok) * 2048 + pv * 256 + h * 64 + sub * 4);
    }
    const int tokv = lt >> 3, r8 = lt & 7;
    const h16x4 rv = *(const h16x4*)(prep + (size_t)(t0 + tokv) * 2048 + 5 * 256 + rowbase + r8 * 4);
#pragma unroll
    for (int i = 0; i < 10; ++i) {
        const int e = i * 256 + lt, tok = e / 80, rem = e - tok * 80, vec = rem >> 4, sub = rem & 15;
        f32x4 f = h4f(raw[i]);
        if (vec == 1) { f[0] = __expf(-f[0]); f[1] = __expf(-f[1]); f[2] = __expf(-f[2]); f[3] = __expf(-f[3]); }
        *(LAS f32x4*)(sh + ((tok * 16 + sub) * 5 + vec) * 4) = f;
    }
    *(LAS f32x4*)(buf + RW_VB + (tokv * 32 + r8 * 4) * 4) = h4f(rv);
}
__device__ __forceinline__ void rwkv_scan(const Params& p, int item, LAS unsigned char* lds, const int tidx) {
    const int b = item >> 3, h = (item >> 1) & 3, q2 = item & 1;
    const int tid = tidx, wid = tid >> 6, lane = tid & 63, lt = tid - 256;
    const h16* prep = (const h16*)p.out;
    h16* mix = (h16*)(p.ws + OFF_MIX);
    const int rowbase = h * 64 + q2 * 32, tb = b * SEQ_;
    const bool loader = wid >= 4;
    const int rowl = (wid & 3) * 4 + (lane >> 4), sub = lane & 15;
    f32x4 Sa = {0.f, 0.f, 0.f, 0.f}, Sb = {0.f, 0.f, 0.f, 0.f};
    __syncthreads();
    if (loader) rwkv_load(prep, tb, h, rowbase, lds, lt);
    __syncthreads();
#pragma unroll 1
    for (int c = 0; c < SEQ_ / CH; ++c) {
        LAS unsigned char* buf = lds + (c & 1) * RW_STRIDE;
        if (loader) {
            if (c + 1 < SEQ_ / CH) rwkv_load(prep, tb + (c + 1) * CH, h, rowbase, lds + ((c + 1) & 1) * RW_STRIDE, lt);
            if (c > 0) plain_write_y(mix, tb + (c - 1) * CH, rowbase, lds + ((c - 1) & 1) * RW_STRIDE + RW_YB, lt);
        } else {
            const LAS float* sh = (const LAS float*)(buf + RW_SH);
            const LAS float* vb = (const LAS float*)(buf + RW_VB);
            LAS float* yb = (LAS float*)(buf + RW_YB);
#pragma unroll 4
            for (int s = 0; s < CH; ++s) {
                const LAS f32x4* q = (const LAS f32x4*)(sh + (s * 16 + sub) * 20);
                const f32x4 kk = q[0], w = q[1], bb = q[2], k = q[3], r = q[4];
                const float va = vb[s * 32 + rowl], vbb = vb[s * 32 + rowl + 16];
                const float da = sum16(dot4(Sa, kk)), db = sum16(dot4(Sb, kk));
                Sa = Sa * w + (k * va - bb * da);
                Sb = Sb * w + (k * vbb - bb * db);
                const float ya = sum16(dot4(Sa, r)), yb2 = sum16(dot4(Sb, r));
                if (sub == 0) { yb[s * 32 + rowl] = ya; yb[s * 32 + rowl + 16] = yb2; }
            }
        }
        __syncthreads();
    }
    if (loader) plain_write_y(mix, tb + (SEQ_ / CH - 1) * CH, rowbase, lds + ((SEQ_ / CH - 1) & 1) * RW_STRIDE + RW_YB, lt);
}

constexpr int HG_SH = 0, HG_VB = CH * 16 * 12 * 4, HG_YB = HG_VB + CH * 32 * 4, HG_STRIDE = HG_YB + CH * 32 * 4;
__device__ __forceinline__ void hgrn_load(const h16* proj, int t0, int h, int rowbase, f32x4 lb, LAS unsigned char* buf, int lt) {
    LAS float* sh = (LAS float*)(buf + HG_SH);
    h16x4 rq[2], rf[2];
#pragma unroll
    for (int i = 0; i < 2; ++i) {
        const int e = i * 256 + lt, tok = e >> 4, sub = e & 15;
        const h16* row = proj + (size_t)(t0 + tok) * NP + h * 64 + sub * 4;
        rq[i] = *(const h16x4*)(row + C_HQ); rf[i] = *(const h16x4*)(row + C_HF);
    }
    const int tokv = lt >> 3, r8 = lt & 7;
    const h16x4 rv = *(const h16x4*)(proj + (size_t)(t0 + tokv) * NP + C_HI + rowbase + r8 * 4);
#pragma unroll
    for (int i = 0; i < 2; ++i) {
        const int e = i * 256 + lt, tok = e >> 4, sub = e & 15;
        const f32x4 qv = h4f(rq[i]), fv = h4f(rf[i]);
        f32x4 fo, ko, qo;
#pragma unroll
        for (int j = 0; j < 4; ++j) { const float fg = lb[j] + (1.0f - lb[j]) * sigmoidf_(fv[j]); fo[j] = fg; ko[j] = 1.0f - fg; qo[j] = siluf_(qv[j]); }
        LAS f32x4* d = (LAS f32x4*)(sh + (tok * 16 + sub) * 12);
        d[0] = fo; d[1] = ko; d[2] = qo;
    }
    *(LAS f32x4*)(buf + HG_VB + (tokv * 32 + r8 * 4) * 4) = h4f(rv);
}
__device__ __forceinline__ void hgrn_scan(const Params& p, int l, int item, LAS unsigned char* lds, const int tidx) {
    const int b = item >> 3, h = (item >> 1) & 3, q2 = item & 1;
    const int tid = tidx, wid = tid >> 6, lane = tid & 63, lt = tid - 256;
    const h16* proj = (const h16*)(p.ws + OFF_BIG);
    h16* mix = (h16*)(p.ws + OFF_MIX);
    const int rowbase = h * 64 + q2 * 32, tb = b * SEQ_;
    const bool loader = wid >= 4;
    const int rowl = (wid & 3) * 4 + (lane >> 4), sub = lane & 15;
    f32x4 lb = {0.f, 0.f, 0.f, 0.f};
    if (l > 0) {
#pragma unroll
        for (int j = 0; j < 4; ++j) { const int ch = h * 64 + (lt & 15) * 4 + j; lb[j] = sigmoidf_(p.in[I_LB][256 + ch] - p.in[I_LB][ch]); }
    }
    f32x4 Sa = {0.f, 0.f, 0.f, 0.f}, Sb = {0.f, 0.f, 0.f, 0.f};
    __syncthreads();
    if (loader) hgrn_load(proj, tb, h, rowbase, lb, lds, lt);
    __syncthreads();
#pragma unroll 1
    for (int c = 0; c < SEQ_ / CH; ++c) {
        LAS unsigned char* buf = lds + (c & 1) * HG_STRIDE;
        if (loader) {
            if (c + 1 < SEQ_ / CH) hgrn_load(proj, tb + (c + 1) * CH, h, rowbase, lb, lds + ((c + 1) & 1) * HG_STRIDE, lt);
            if (c > 0) plain_write_y(mix, tb + (c - 1) * CH, 768 + rowbase, lds + ((c - 1) & 1) * HG_STRIDE + HG_YB, lt);
        } else {
            const LAS float* sh = (const LAS float*)(buf + HG_SH);
            const LAS float* vb = (const LAS float*)(buf + HG_VB);
            LAS float* yb = (LAS float*)(buf + HG_YB);
#pragma unroll 4
            for (int s = 0; s < CH; ++s) {
                const LAS f32x4* q = (const LAS f32x4*)(sh + (s * 16 + sub) * 12);
                const f32x4 f = q[0], k = q[1], qq = q[2];
                const float va = vb[s * 32 + rowl], vbb = vb[s * 32 + rowl + 16];
                Sa = Sa * f + k * va; Sb = Sb * f + k * vbb;
                const float ya = sum16(dot4(Sa, qq)), yb2 = sum16(dot4(Sb, qq));
                if (sub == 0) { yb[s * 32 + rowl] = ya; yb[s * 32 + rowl + 16] = yb2; }
            }
        }
        __syncthreads();
    }
    if (loader) plain_write_y(mix, tb + (SEQ_ / CH - 1) * CH, 768 + rowbase, lds + ((SEQ_ / CH - 1) & 1) * HG_STRIDE + HG_YB, lt);
}

constexpr int SD_SH = 0, SD_XDT = CH * 16 * 16 * 4, SD_XS = SD_XDT + CH * 32 * 4, SD_AB = SD_XS + CH * 32 * 4, SD_YB = SD_AB + CH * 4, SD_STRIDE = SD_YB + CH * 32 * 4;
struct SsdW { f32x4 w[4], b; };
__device__ __forceinline__ SsdW ssd_wload(const Params& p, int l, int ch) {
    SsdW r; const float* cw = p.in[I_CW] + (size_t)l * 4 * 768 + ch;
#pragma unroll
    for (int j = 0; j < 4; ++j) r.w[j] = *(const f32x4*)(cw + j * 768);
    r.b = *(const f32x4*)(p.in[I_CB] + l * 768 + ch);
    return r;
}
__device__ __forceinline__ f32x4 silu4(f32x4 a) { f32x4 o; o[0] = siluf_(a[0]); o[1] = siluf_(a[1]); o[2] = siluf_(a[2]); o[3] = siluf_(a[3]); return o; }
__device__ __forceinline__ void ssd_load(const h16* proj, int t0, int h, const SsdW& wbc, int chbc, const SsdW& wxs, int chxs, float dtb, float Ah, LAS unsigned char* buf, int lt) {
    LAS float* sh = (LAS float*)(buf + SD_SH);
    const int gi = lt & 63, tq = lt >> 6, vec = gi >> 5, gj = gi & 31;
    const int tA = t0 + tq * 8, posA = tA & (SEQ_ - 1);
    h16x4 rows[11];
#pragma unroll
    for (int j = 0; j < 11; ++j) rows[j] = (posA - 3 + j >= 0) ? *(const h16x4*)(proj + (size_t)(tA - 3 + j) * NP + C_SX + chbc) : (h16x4){(h16)0.f, (h16)0.f, (h16)0.f, (h16)0.f};
    const int tokx = lt >> 3, r8 = lt & 7, tX = t0 + tokx, posX = tX & (SEQ_ - 1);
    h16x4 rx[4];
#pragma unroll
    for (int j = 0; j < 4; ++j) rx[j] = (posX - 3 + j >= 0) ? *(const h16x4*)(proj + (size_t)(tX - 3 + j) * NP + C_SX + chxs) : (h16x4){(h16)0.f, (h16)0.f, (h16)0.f, (h16)0.f};
    const float dtraw = (float)proj[(size_t)tX * NP + C_SDT + h];
#pragma unroll
    for (int j = 0; j < 8; ++j) {
        f32x4 acc = wbc.b;
#pragma unroll
        for (int k = 0; k < 4; ++k) acc += h4f(rows[j + k]) * wbc.w[k];
        *(LAS f32x4*)(sh + ((tq * 8 + j) * 16 + (gj >> 1)) * 16 + vec * 8 + (gj & 1) * 4) = silu4(acc);
    }
    {
        f32x4 acc = wxs.b;
#pragma unroll
        for (int k = 0; k < 4; ++k) acc += h4f(rx[k]) * wxs.w[k];
        const f32x4 xs = silu4(acc);
        const float dt = softplusf_(dtraw + dtb);
        *(LAS f32x4*)(buf + SD_XS + (tokx * 32 + r8 * 4) * 4) = xs;
        *(LAS f32x4*)(buf + SD_XDT + (tokx * 32 + r8 * 4) * 4) = xs * dt;
        if (r8 == 0) *(LAS float*)(buf + SD_AB + tokx * 4) = __expf(dt * Ah);
    }
}
__device__ __forceinline__ void ssd_write_y(const h16* proj, h16* mix, int t0, int cc0, LAS unsigned char* ybuf, int lt) {
    const int tok = lt >> 3, r8 = lt & 7, cc = cc0 + r8 * 4;
    const f32x4 y = *(const LAS f32x4*)(ybuf + (tok * 32 + r8 * 4) * 4);
    const f32x4 z = h4f(*(const h16x4*)(proj + (size_t)(t0 + tok) * NP + C_SZ + cc));
    *(h16x4*)(mix + (size_t)(t0 + tok) * DM + 512 + cc) = f4h(y * silu4(z));
}
__device__ __forceinline__ void ssd_scan(const Params& p, int l, int item, LAS unsigned char* lds, const int tidx) {
    const int b = item >> 3, h = (item >> 1) & 3, q2 = item & 1;
    const int tid = tidx, wid = tid >> 6, lane = tid & 63, lt = tid - 256;
    const h16* proj = (const h16*)(p.ws + OFF_BIG);
    h16* mix = (h16*)(p.ws + OFF_MIX);
    const int tb = b * SEQ_, cc0 = h * 64 + q2 * 32;
    const bool loader = wid >= 4;
    const int rowl = (wid & 3) * 4 + (lane >> 4), sub = lane & 15;
    const float dtb = p.in[I_DTB][l * 4 + h], Ah = -__expf(p.in[I_ALOG][l * 4 + h]), Dh = p.in[I_SD][l * 4 + h];
    const int chbc = 256 + ((lt & 63) >> 5) * 256 + (h >> 1) * 128 + (lt & 31) * 4, chxs = cc0 + (lt & 7) * 4;
    SsdW wbc, wxs;
    if (loader) { wbc = ssd_wload(p, l, chbc); wxs = ssd_wload(p, l, chxs); }
    f32x4 Sa0 = {0.f, 0.f, 0.f, 0.f}, Sa1 = Sa0, Sb0 = Sa0, Sb1 = Sa0;
    __syncthreads();
    if (loader) ssd_load(proj, tb, h, wbc, chbc, wxs, chxs, dtb, Ah, lds, lt);
    __syncthreads();
#pragma unroll 1
    for (int c = 0; c < SEQ_ / CH; ++c) {
        LAS unsigned char* buf = lds + (c & 1) * SD_STRIDE;
        if (loader) {
            if (c + 1 < SEQ_ / CH) ssd_load(proj, tb + (c + 1) * CH, h, wbc, chbc, wxs, chxs, dtb, Ah, lds + ((c + 1) & 1) * SD_STRIDE, lt);
            if (c > 0) ssd_write_y(proj, mix, tb + (c - 1) * CH, cc0, lds + ((c - 1) & 1) * SD_STRIDE + SD_YB, lt);
        } else {
            const LAS float* sh = (const LAS float*)(buf + SD_SH);
            const LAS float* xdt = (const LAS float*)(buf + SD_XDT);
            const LAS float* xsb = (const LAS float*)(buf + SD_XS);
            const LAS float* ab = (const LAS float*)(buf + SD_AB);
            LAS float* yb = (LAS float*)(buf + SD_YB);
#pragma unroll 4
            for (int s = 0; s < CH; ++s) {
                const LAS f32x4* q = (const LAS f32x4*)(sh + (s * 16 + sub) * 16);
                const f32x4 B0 = q[0], B1 = q[1], C0 = q[2], C1 = q[3];
                const float a = ab[s];
                const float xda = xdt[s * 32 + rowl], xdb = xdt[s * 32 + rowl + 16], xsa = xsb[s * 32 + rowl], xsb2 = xsb[s * 32 + rowl + 16];
                Sa0 = Sa0 * a + B0 * xda; Sa1 = Sa1 * a + B1 * xda;
                Sb0 = Sb0 * a + B0 * xdb; Sb1 = Sb1 * a + B1 * xdb;
                const float ya = sum16(dot4(Sa0, C0) + dot4(Sa1, C1)) + Dh * xsa;
                const float yb2 = sum16(dot4(Sb0, C0) + dot4(Sb1, C1)) + Dh * xsb2;
                if (sub == 0) { yb[s * 32 + rowl] = ya; yb[s * 32 + rowl + 16] = yb2; }
            }
        }
        __syncthreads();
    }
    if (loader) ssd_write_y(proj, mix, tb + (SEQ_ / CH - 1) * CH, cc0, lds + ((SEQ_ / CH - 1) & 1) * SD_STRIDE + SD_YB, lt);
}

__device__ __forceinline__ void attn_item(const Params& p, int item, const int tidx) {
    const int b = item / 192, rem = item - b * 192, h = rem / 48, s = rem - h * 48;
    int br, dil, r, n;
    if (s < 16) { br = 0; dil = 1; r = 0; n = s; } else if (s < 32) { br = 1; dil = 4; r = (s - 16) >> 2; n = (s - 16) & 3; } else { br = 2; dil = 16; r = s - 32; n = 0; }
    const int tid = tidx, wid = tid >> 6, lane = tid & 63, c16 = lane & 15, g = lane >> 4;
    const h16* base = (const h16*)(p.ws + OFF_BIG) + (size_t)b * SEQ_ * NP;
    const int tq = (n * 128 + 16 * wid + c16) * dil + r;
    h16x8 qf0 = *(const h16x8*)(base + (size_t)tq * NP + C_AQ + h * 64 + g * 8);
    h16x8 qf1 = *(const h16x8*)(base + (size_t)tq * NP + C_AQ + h * 64 + 32 + g * 8);
    f32x4 sc[9];
#pragma unroll
    for (int kt = 0; kt < 9; ++kt) {
        int kp = (n - 1) * 128 + 16 * wid + 16 * kt + c16; kp = kp < 0 ? 0 : kp;
        const h16* kr = base + (size_t)(kp * dil + r) * NP + C_AK + h * 64 + g * 8;
        const h16x8 k0 = *(const h16x8*)kr, k1 = *(const h16x8*)(kr + 32);
        f32x4 a = {0.f, 0.f, 0.f, 0.f};
        a = __builtin_amdgcn_mfma_f32_16x16x32_f16(k0, qf0, a, 0, 0, 0);
        a = __builtin_amdgcn_mfma_f32_16x16x32_f16(k1, qf1, a, 0, 0, 0);
        sc[kt] = a;
    }
    const float slope = exp2f(-2.0f * (float)(h + 1)) * (float)dil;
    float m = -INFINITY;
#pragma unroll
    for (int kt = 0; kt < 9; ++kt)
#pragma unroll
        for (int rg = 0; rg < 4; ++rg) {
            const int jj = 16 * kt + 4 * g + rg, dist = 128 + c16 - jj;
            const bool valid = (dist >= 0) && (dist <= 128) && (n > 0 || (16 * wid + jj) >= 128);
            const float v = valid ? (sc[kt][rg] * 0.125f - slope * (float)dist) : -INFINITY;
            sc[kt][rg] = v; m = fmaxf(m, v);
        }
    m = fmaxf(m, __shfl_xor(m, 16)); m = fmaxf(m, __shfl_xor(m, 32));
    float lsum = 0.f;
#pragma unroll
    for (int kt = 0; kt < 9; ++kt)
#pragma unroll
        for (int rg = 0; rg < 4; ++rg) { const float e = __expf(sc[kt][rg] - m); sc[kt][rg] = e; lsum += e; }
    lsum += __shfl_xor(lsum, 16); lsum += __shfl_xor(lsum, 32);
    f32x4 o[4];
#pragma unroll
    for (int d = 0; d < 4; ++d) o[d] = (f32x4){0.f, 0.f, 0.f, 0.f};
#pragma unroll
    for (int kt = 0; kt < 9; ++kt)
#pragma unroll
        for (int rg = 0; rg < 4; ++rg) {
            int kp = (n - 1) * 128 + 16 * wid + 16 * kt + 4 * g + rg; kp = kp < 0 ? 0 : kp;
            const f32x4 v = h4f(*(const h16x4*)(base + (size_t)(kp * dil + r) * NP + C_AV + h * 64 + 4 * c16));
#pragma unroll
            for (int d = 0; d < 4; ++d) o[d] = __builtin_amdgcn_mfma_f32_16x16x4f32(sc[kt][rg], v[d], o[d], 0, 0, 0);
        }
    h16* dst; int ld, co;
    if (br == 0) { dst = (h16*)(p.ws + OFF_MIX); ld = DM; co = 256; } else { dst = (h16*)(p.ws + (br == 1 ? OFF_O2 : OFF_O3)); ld = 256; co = 0; }
    float* lse = (float*)(p.ws + OFF_LSE) + (size_t)br * T_ * 4;
#pragma unroll
    for (int rg = 0; rg < 4; ++rg) {
        const int q = 4 * g + rg;
        const float inv = 1.0f / __shfl(lsum, q);
        const int t = b * SEQ_ + (n * 128 + 16 * wid + q) * dil + r;
        h16x4 ov; ov[0] = (h16)(o[0][rg] * inv); ov[1] = (h16)(o[1][rg] * inv); ov[2] = (h16)(o[2][rg] * inv); ov[3] = (h16)(o[3][rg] * inv);
        *(h16x4*)(dst + (size_t)t * ld + co + h * 64 + 4 * c16) = ov;
    }
    if (g == 0) lse[(size_t)(b * SEQ_ + tq) * 4 + h] = m + __logf(lsum);
}

__device__ __forceinline__ void mix_phase(const Params& p, int l, int cidx, LAS unsigned char* lds, const int tidx) {
    unsigned* ctr = (unsigned*)(p.ws + OFF_MISC) + cidx;
    LAS unsigned* slot = (LAS unsigned*)(lds + LDS_BYTES - 16);
    for (;;) {
        __syncthreads();
        if (tidx == 0) *slot = atomicAdd(ctr, 1u);
        __syncthreads();
        const int it = (int)*slot;
        if (it >= 64 * 3 + 1536) break;
        int t2 = tidx; asm volatile("" : "+v"(t2));
        if (it < 64) rwkv_scan(p, it, lds, t2);
        else if (it < 128) ssd_scan(p, l, it - 64, lds, t2);
        else if (it < 192) hgrn_scan(p, l, it - 128, lds, t2);
        else attn_item(p, it - 192, t2);
    }
}

__device__ __forceinline__ void post_phase(const Params& p, int l, const int tidx) {
    const int wid = tidx >> 6, lane = tidx & 63;
    h16* mix = (h16*)(p.ws + OFF_MIX);
    const h16* prep = (const h16*)p.out;
    const h16* proj = (const h16*)(p.ws + OFF_BIG);
    const h16* o2 = (const h16*)(p.ws + OFF_O2);
    const h16* o3 = (const h16*)(p.ws + OFF_O3);
    const float* lse = (const float*)(p.ws + OFF_LSE);
    const f32x4 snw = *(const f32x4*)(p.in[I_SNW] + l * 256 + 4 * lane);
    const f32x4 hnw = *(const f32x4*)(p.in[I_HNW] + l * 256 + 4 * lane);
    const int hd = lane >> 4;
    for (int t = blockIdx.x * 8 + wid; t < T_; t += gridDim.x * 8) {
        h16* mr = mix + (size_t)t * DM + 4 * lane;
        {
            const f32x4 y = h4f(*(const h16x4*)mr);
            const float mu = sum16(y[0] + y[1] + y[2] + y[3]) * (1.0f / 64.0f);
            const f32x4 d = y - mu;
            const float var = sum16(d[0] * d[0] + d[1] * d[1] + d[2] * d[2] + d[3] * d[3]) * (1.0f / 64.0f);
            const float rstd = rsqrtf(var + 64e-5f);
            const f32x4 A = h4f(*(const h16x4*)(prep + (size_t)t * 2048 + 1536 + 4 * lane));
            const f32x4 Bc = h4f(*(const h16x4*)(prep + (size_t)t * 2048 + 1792 + 4 * lane));
            *(h16x4*)mr = f4h(d * rstd * A + Bc);
        }
        {
            const f32x4 a1 = h4f(*(const h16x4*)(mr + 256));
            const f32x4 a2 = h4f(*(const h16x4*)(o2 + (size_t)t * 256 + 4 * lane));
            const f32x4 a3 = h4f(*(const h16x4*)(o3 + (size_t)t * 256 + 4 * lane));
            const float l1 = lse[(size_t)t * 4 + hd], l2 = lse[(size_t)(T_ + t) * 4 + hd], l3 = lse[(size_t)(2 * T_ + t) * 4 + hd];
            const float mx = fmaxf(l1, fmaxf(l2, l3));
            const float w1 = __expf(l1 - mx), w2 = __expf(l2 - mx), w3 = __expf(l3 - mx);
            const float inv = 1.0f / (w1 + w2 + w3);
            *(h16x4*)(mr + 256) = f4h((a1 * w1 + a2 * w2 + a3 * w3) * inv);
        }
        {
            const f32x4 u = h4f(*(const h16x4*)(mr + 512));
            float ss = sum16(u[0] * u[0] + u[1] * u[1] + u[2] * u[2] + u[3] * u[3]);
            ss += __shfl_xor(ss, 16);
            const float rstd = rsqrtf(ss * (1.0f / 128.0f) + 1e-5f);
            *(h16x4*)(mr + 512) = f4h(u * rstd * snw);
        }
        {
            const f32x4 u = h4f(*(const h16x4*)(mr + 768));
            const float ss = sum16(u[0] * u[0] + u[1] * u[1] + u[2] * u[2] + u[3] * u[3]);
            const float rstd = rsqrtf(ss * (1.0f / 64.0f) + 1e-5f);
            const f32x4 gz = h4f(*(const h16x4*)(proj + (size_t)t * NP + C_HG + 4 * lane));
            f32x4 gt; gt[0] = siluf_(gz[0]); gt[1] = siluf_(gz[1]); gt[2] = siluf_(gz[2]); gt[3] = siluf_(gz[3]);
            *(h16x4*)(mr + 768) = f4h(u * rstd * hnw * gt);
        }
    }
}

__device__ __forceinline__ void ln_phase(const Params& p, const float* w, const float* bvec, bool final_out, const int tidx) {
    const int wid = tidx >> 6, lane = tidx & 63;
    h16* x16 = (h16*)(p.ws + OFF_X16);
    f32x4 wv[4], bv[4];
#pragma unroll
    for (int q = 0; q < 4; ++q) { wv[q] = *(const f32x4*)(w + lane * 16 + 4 * q); bv[q] = *(const f32x4*)(bvec + lane * 16 + 4 * q); }
    for (int t = blockIdx.x * 8 + wid; t < T_; t += gridDim.x * 8) {
        h16* row = x16 + (size_t)t * DM + lane * 16;
        const h16x8 v0 = *(const h16x8*)row, v1 = *(const h16x8*)(row + 8);
        float x[16];
#pragma unroll
        for (int j = 0; j < 8; ++j) { x[j] = (float)v0[j]; x[8 + j] = (float)v1[j]; }
        float s = 0.f;
#pragma unroll
        for (int j = 0; j < 16; ++j) s += x[j];
        const float mu = sum64(s) * (1.0f / 1024.0f);
        float q2 = 0.f;
#pragma unroll
        for (int j = 0; j < 16; ++j) { x[j] -= mu; q2 += x[j] * x[j]; }
        const float rstd = rsqrtf(sum64(q2) * (1.0f / 1024.0f) + 1e-5f);
#pragma unroll
        for (int j = 0; j < 16; ++j) x[j] = x[j] * rstd * wv[j >> 2][j & 3] + bv[j >> 2][j & 3];
        if (final_out) {
            float* orow = p.out + (size_t)t * DM + lane * 16;
#pragma unroll
            for (int q = 0; q < 4; ++q) *(f32x4*)(orow + 4 * q) = (f32x4){x[4 * q], x[4 * q + 1], x[4 * q + 2], x[4 * q + 3]};
        } else {
            h16x8 o0, o1;
#pragma unroll
            for (int j = 0; j < 8; ++j) { o0[j] = (h16)x[j]; o1[j] = (h16)x[8 + j]; }
            *(h16x8*)row = o0; *(h16x8*)(row + 8) = o1;
        }
    }
}

constexpr int NPHASE = 19;
__device__ __forceinline__ void run_phase(const Params& p, int ph, LAS unsigned char* lds, const int tidx, const int rep) {
    const int l = (ph == 0) ? 0 : (ph - 1) / 9, s = (ph == 0) ? -1 : (ph - 1) % 9;
    h16* x16 = (h16*)(p.ws + OFF_X16);
    h16* mix = (h16*)(p.ws + OFF_MIX);
    h16* big = (h16*)(p.ws + OFF_BIG);
    if (ph == 0) {
        if (blockIdx.x == 0 && tidx < 8) ((unsigned*)(p.ws + OFF_MISC))[tidx] = 0u;
        conv_x(p, tidx);
    }
    if (s == 0 || s == 4 || s == 6 || s == 7) {
        const h16* A = (s == 0 || s == 6) ? x16 : (s == 4 ? mix : big);
        const h16* Bt = (const h16*)(p.ws + (s == 0 ? OFF_WIN : s == 4 ? OFF_WOUT : s == 6 ? OFF_WUP : OFF_WDN));
        const int N = (s == 0) ? NP : (s == 6 ? DFF : DM), K = (s == 7) ? DFF : DM;
        h16* O = (s == 0 || s == 6) ? big : x16;
        run_gemm(lds, A, Bt, N, K, O, N, (s == 0) ? 0 : (s == 6 ? 1 : 2), tidx);
    }
    if (s == 1) pre_phase(p, l, lds, tidx);
    if (s == 2) mix_phase(p, l, 2 * rep + l, lds, tidx);
    if (s == 3) post_phase(p, l, tidx);
    if (s == 5 || s == 8) ln_phase(p, p.in[s == 5 ? I_LN1W : I_LN2W] + l * DM, p.in[s == 5 ? I_LN1B : I_LN2B] + l * DM, s == 8 && l == 1, tidx);
    if (ph == 0 || (s == 8 && l == 0)) conv_weights(p, ph == 0 ? 0 : 1, lds, tidx);
}

__global__ void __launch_bounds__(512, 2) k_phase(Params p, int ph) {
    extern __shared__ __attribute__((aligned(16))) unsigned char shm[];
    const int tidx = threadIdx.x;
    run_phase(p, ph, (LAS unsigned char*)shm, tidx, 0);
}

#ifndef DUPMASK
#define DUPMASK 0
#endif
#if COOP
__global__ void __launch_bounds__(512, 2) k_mega(Params p) {
    extern __shared__ __attribute__((aligned(16))) unsigned char shm[];
    cg::grid_group grid = cg::this_grid();
#pragma unroll 1
    for (int ph = 0; ph < NPHASE; ++ph) {
        const int nrep = ((DUPMASK >> ph) & 1) ? 2 : 1;
#pragma unroll 1
        for (int rep = 0; rep < nrep; ++rep) {
            int tidx = threadIdx.x; asm volatile("" : "+v"(tidx));
            run_phase(p, ph, (LAS unsigned char*)shm, tidx, rep);
            if (ph + 1 < NPHASE) grid.sync();
        }
    }
}
#endif

extern "C" void kernel_launch(void* const* d_in, const int* in_sizes, int n_in, void* d_out, int out_size, void* d_ws, size_t ws_size, hipStream_t stream) {
    static int grid_blocks = 0;
    if (!grid_blocks) {
        int dev = 0, cus = 0, per_cu = 0;
        hipGetDevice(&dev);
        hipDeviceGetAttribute(&cus, hipDeviceAttributeMultiprocessorCount, dev);
        hipFuncSetAttribute((const void*)k_phase, hipFuncAttributeMaxDynamicSharedMemorySize, LDS_BYTES);
#if COOP
        hipFuncSetAttribute((const void*)k_mega, hipFuncAttributeMaxDynamicSharedMemorySize, LDS_BYTES);
        hipOccupancyMaxActiveBlocksPerMultiprocessor(&per_cu, (const void*)k_mega, 512, LDS_BYTES);
#endif
        if (per_cu < 1) per_cu = 1;
        grid_blocks = cus * 1;
        (void)hipGetLastError();
    }
    Params p{};
    for (int i = 0; i < 32; ++i) p.in[i] = (const float*)d_in[i];
    p.out = (float*)d_out; p.ws = (unsigned char*)d_ws;
#if COOP
    void* args[] = {&p};
    hipError_t e = hipLaunchCooperativeKernel((const void*)k_mega, dim3(grid_blocks), dim3(512), args, LDS_BYTES, stream);
    if (e != hipSuccess) fprintf(stderr, "cooperative launch failed: %s (grid %d)\n", hipGetErrorString(e), grid_blocks);
#else
    for (int ph = 0; ph < NPHASE; ++ph) k_phase<<<dim3(grid_blocks), dim3(512), LDS_BYTES, stream>>>(p, ph);
#endif
}
```

```cpp
#include <hip/hip_runtime.h>
#include <hip/hip_cooperative_groups.h>
#include <cstdio>
namespace cg = cooperative_groups;

#ifndef COOP
#define COOP 1
#endif

#define LAS __attribute__((address_space(3)))
typedef _Float16 h16;
typedef _Float16 h16x4 __attribute__((ext_vector_type(4)));
typedef _Float16 h16x8 __attribute__((ext_vector_type(8)));
typedef float f32x2 __attribute__((ext_vector_type(2)));
typedef float f32x4 __attribute__((ext_vector_type(4)));

constexpr int T_ = 16384, SEQ_ = 2048, DM = 1024, NP = 3840, DFF = 4096, INC = 3716;
constexpr int C_R = 0, C_K = 256, C_V = 512, C_FW = 768, C_VR = 896, C_AQ = 928, C_AK = 1184, C_AV = 1440;
constexpr int C_SZ = 1696, C_SX = 1952, C_SDT = 2720, C_HQ = 2728, C_HF = 2984, C_HI = 3240, C_HG = 3496;
constexpr float ALPHA_ = 1.41421356237f;
constexpr size_t OFF_WIN = 0, OFF_WOUT = 7864320, OFF_WUP = OFF_WOUT + 2097152, OFF_WDN = OFF_WUP + 8388608;
constexpr size_t OFF_X16 = 26738688, OFF_MIX = OFF_X16 + 33554432, OFF_BIG = OFF_MIX + 33554432;
constexpr size_t OFF_VF = OFF_BIG + 134217728, OFF_O2 = OFF_VF + 8388608, OFF_O3 = OFF_O2 + 8388608, OFF_LSE = OFF_O3 + 8388608;
constexpr size_t OFF_MISC = OFF_LSE + 786432;
constexpr int LDS_BYTES = 131072, LDS_TOTAL = 131072 + 64;

struct Params { const float* in[32]; float* out; unsigned char* ws; };

enum { I_X = 0, I_LB, I_WIN, I_WINV, I_MU, I_MUV, I_W0, I_W2, I_A0, I_A2, I_G2, I_KK, I_KA, I_RK, I_LNW, I_LNB, I_V0, I_V2,
       I_CW, I_CB, I_DTB, I_ALOG, I_SD, I_SNW, I_HNW, I_WOUT, I_LN1W, I_LN1B, I_WUP, I_WDN, I_LN2W, I_LN2B };

template <int CTRL> __device__ __forceinline__ float dpp_f(float x) {
    return __builtin_bit_cast(float, __builtin_amdgcn_update_dpp(0, __builtin_bit_cast(int, x), CTRL, 0xF, 0xF, true));
}
__device__ __forceinline__ float sum16(float x) {
    x += dpp_f<0xB1>(x);
    x += dpp_f<0x4E>(x);
    x += dpp_f<0x141>(x);
    x += dpp_f<0x140>(x);
    return x;
}
__device__ __forceinline__ float sum64(float x) { x = sum16(x); x += __shfl_xor(x, 16); x += __shfl_xor(x, 32); return x; }
__device__ __forceinline__ float sigmoidf_(float x) { return 1.0f / (1.0f + __expf(-x)); }
__device__ __forceinline__ float siluf_(float x) { return x / (1.0f + __expf(-x)); }
__device__ __forceinline__ float softplusf_(float x) { return fmaxf(x, 0.f) + log1pf(__expf(-fabsf(x))); }
__device__ __forceinline__ f32x4 h4f(h16x4 v) { return (f32x4){(float)v[0], (float)v[1], (float)v[2], (float)v[3]}; }
__device__ __forceinline__ h16x4 f4h(f32x4 v) { return (h16x4){(h16)v[0], (h16)v[1], (h16)v[2], (h16)v[3]}; }

namespace pg8 {
constexpr int BM = 256, BK = 64, HALF = 128, HTB = HALF * BK * 2, STAGE_BYTES = 8 * HTB, NXCD = 8, WGM = 8;
__host__ __device__ __forceinline__ int lds_byte(int r, int c) { const int st = (r >> 4) * 2 + (c >> 5), rr = r & 15, cc = c & 31, ob = rr * 64 + cc * 2; return st * 1024 + (ob ^ (((ob >> 9) & 1) << 5)); }
__host__ __device__ __forceinline__ void stage_rc(int b, int& R, int& C) { const int st = b / 1024, sb = b % 1024, swz = sb ^ (((sb >> 9) & 1) << 5); R = (st >> 1) * 16 + swz / 64; C = (st & 1) * 32 + (swz % 64) / 2; }
__host__ __device__ __forceinline__ int perm32(int rho) { const int n = rho >> 4, i = rho & 15; return 8 * (i >> 2) + 4 * n + (i & 3); }
struct Unit { int pm, pn; };
struct Gemm { const h16* A; const h16* Bt; int M, N, K; };
struct StaticOrder {
    int nM, nN, nwg, G, c;
    __device__ void init(int M, int N, int G_, int c_) { nM = M / BM; nN = N / BM; nwg = nM * nN; G = G_; c = c_; }
    __device__ bool next(int i, Unit& u) const {
        const long L = (long)i * G + c; if (L >= nwg) return false;
        int wgid = (int)L; { const int q = nwg / NXCD, r = nwg % NXCD, xcd = wgid % NXCD, off = wgid / NXCD; wgid = (xcd < r ? xcd * (q + 1) : r * (q + 1) + (xcd - r) * q) + off; }
        const int nig = WGM * nN, gid = wgid / nig, fm = gid * WGM, gsz = (nM - fm) < WGM ? (nM - fm) : WGM;
        u.pm = fm + ((wgid % nig) % gsz); u.pn = (wgid % nig) / gsz; return true;
    }
};
struct EpiH {
    h16* O; int ldc; int MODE;
    __device__ __forceinline__ void operator()(const f32x4 (&acc)[2][2][4][2], const Unit& u, int wr, int wc, int fr, int fq) const {
        const int row0 = u.pm * BM + wr * 64 + fr, col0 = u.pn * BM + wc * 32 + 8 * fq;
#pragma unroll
        for (int ai = 0; ai < 2; ++ai)
#pragma unroll
            for (int m = 0; m < 4; ++m) { h16* rowp = O + (size_t)(row0 + ai * HALF + m * 16) * ldc + col0;
#pragma unroll
                for (int bj = 0; bj < 2; ++bj) { f32x4 v0 = acc[ai][bj][m][0], v1 = acc[ai][bj][m][1];
                    if (MODE == 1) {
#pragma unroll
                        for (int j = 0; j < 4; ++j) { float a = fmaxf(v0[j], 0.f), b = fmaxf(v1[j], 0.f); v0[j] = a * a; v1[j] = b * b; } }
                    if (MODE == 2) { const h16x8 x = *(const h16x8*)(rowp + bj * HALF);
#pragma unroll
                        for (int j = 0; j < 4; ++j) { v0[j] += ALPHA_ * (float)x[j]; v1[j] += ALPHA_ * (float)x[4 + j]; } }
                    h16x8 w;
#pragma unroll
                    for (int j = 0; j < 4; ++j) { w[j] = (h16)v0[j]; w[4 + j] = (h16)v1[j]; }
                    *(h16x8*)(rowp + bj * HALF) = w; } }
    }
};

template <class Epi>
__device__ __forceinline__ void gemm_phase(LAS unsigned char* lds, const Gemm g, const StaticOrder& S, const Epi& E, const int tidx) {
    const int tid = tidx, wid = __builtin_amdgcn_readfirstlane(tid >> 6), lane = tid & 63, wr = wid >> 2, wc = wid & 3, fr = lane & 15, fq = lane >> 4;
    const int K = g.K, nt = K / BK;
    unsigned voffA[2], voffB[2];
#pragma unroll
    for (int i = 0; i < 2; ++i) { int R, C; stage_rc(tid * 16 + i * 8192, R, C); const int Rb = (R & ~31) + perm32(R & 31);
        voffA[i] = (unsigned)(R * K + C) * 2u; voffB[i] = (unsigned)(Rb * K + C) * 2u; }
    const size_t kstep = (size_t)(BK * 2);
    const size_t hstep = (size_t)HALF * K * 2;
    const size_t tstep = 2 * hstep;
    const unsigned ldsw = (unsigned)wid * 1024u;
    const int aoff = lds_byte(wr * 64 + fr, fq * 8), boff = lds_byte(wc * 32 + fr, fq * 8);
#define PG8_SA(b, h) (((b) * 2 + (h)) * HTB)
#define PG8_SB(b, h) ((4 + (b) * 2 + (h)) * HTB)
#define PG8_STAGE(bufoff, gbase, voff) do { _Pragma("unroll") for (int _i = 0; _i < 2; ++_i) \
        __builtin_amdgcn_global_load_lds((const unsigned*)((const char*)(gbase) + (voff)[_i]), (LAS unsigned*)(lds + (bufoff) + ldsw + _i * 8192), 16, 0, 0); } while (0)
#define PG8_LDA(dst, b, h) do { _Pragma("unroll") for (int m = 0; m < 4; ++m) _Pragma("unroll") for (int k = 0; k < 2; ++k) dst[m][k] = *(const LAS h16x8*)(lds + PG8_SA(b, h) + aoff + m * 2048 + k * 1024); } while (0)
#define PG8_LDB(dst, b, h) do { _Pragma("unroll") for (int n = 0; n < 2; ++n) _Pragma("unroll") for (int k = 0; k < 2; ++k) dst[n][k] = *(const LAS h16x8*)(lds + PG8_SB(b, h) + boff + n * 2048 + k * 1024); } while (0)
#define PG8_MMA(ai, bj, At, Bt) do { __builtin_amdgcn_s_setprio(1); _Pragma("unroll") for (int m = 0; m < 4; ++m) _Pragma("unroll") for (int n = 0; n < 2; ++n) _Pragma("unroll") for (int k = 0; k < 2; ++k) \
        acc[ai][bj][m][n] = __builtin_amdgcn_mfma_f32_16x16x32_f16(Bt[n][k], At[m][k], acc[ai][bj][m][n], 0, 0, 0); __builtin_amdgcn_s_setprio(0); } while (0)
#define PG8_WAIT_V(n) asm volatile("s_waitcnt vmcnt(" #n ")" ::: "memory")
#define PG8_WAIT_L(n) asm volatile("s_waitcnt lgkmcnt(" #n ")" ::: "memory")
#define PG8_BAR __builtin_amdgcn_s_barrier()
#define PG8_SCHED __builtin_amdgcn_sched_barrier(0)
    Unit cur, nxt; int ui = 0;
    if (!S.next(0, cur)) return;
    f32x4 acc[2][2][4][2];
#pragma unroll
    for (int a = 0; a < 2; ++a)
#pragma unroll
        for (int b = 0; b < 2; ++b)
#pragma unroll
            for (int m = 0; m < 4; ++m)
#pragma unroll
                for (int n = 0; n < 2; ++n) acc[a][b][m][n] = (f32x4){0.f, 0.f, 0.f, 0.f};
    h16x8 At[4][2], B0[2][2], B1[2][2];
    const char* cA = (const char*)g.A + (size_t)cur.pm * tstep; const char* cB = (const char*)g.Bt + (size_t)cur.pn * tstep;
    PG8_STAGE(PG8_SB(0, 0), cB, voffB); PG8_STAGE(PG8_SA(0, 0), cA, voffA); PG8_STAGE(PG8_SB(0, 1), cB + hstep, voffB); PG8_STAGE(PG8_SA(0, 1), cA + hstep, voffA);
    if (wr == 1) PG8_BAR;
    PG8_WAIT_V(4); PG8_BAR;
    PG8_STAGE(PG8_SB(1, 0), cB + kstep, voffB); PG8_STAGE(PG8_SA(1, 0), cA + kstep, voffA); PG8_STAGE(PG8_SB(1, 1), cB + hstep + kstep, voffB);
    PG8_WAIT_V(6); PG8_BAR;
    for (;;) {
        const bool has_next = S.next(ui + 1, nxt);
        const char* nA = has_next ? (const char*)g.A + (size_t)nxt.pm * tstep : cA; const char* nB = has_next ? (const char*)g.Bt + (size_t)nxt.pn * tstep : cB;
        for (int t = 0; t < nt; t += 2) {
            const bool last = (t == nt - 2);
            const char* a1 = cA + (size_t)(t + 1) * kstep;
            const char* a2 = last ? nA : cA + (size_t)(t + 2) * kstep; const char* b2 = last ? nB : cB + (size_t)(t + 2) * kstep;
            const char* a3 = a2 + kstep; const char* b3 = b2 + kstep;
            PG8_LDB(B0, 0, 0); PG8_SCHED; PG8_LDA(At, 0, 0); PG8_STAGE(PG8_SA(1, 1), a1 + hstep, voffA);
            PG8_WAIT_L(8); PG8_BAR; PG8_WAIT_L(0); PG8_MMA(0, 0, At, B0); PG8_BAR; PG8_SCHED;
            PG8_LDB(B1, 0, 1); PG8_STAGE(PG8_SB(0, 0), b2, voffB);
            PG8_BAR; PG8_WAIT_L(0); PG8_MMA(0, 1, At, B1); PG8_BAR;
            PG8_LDA(At, 0, 1); PG8_STAGE(PG8_SA(0, 0), a2, voffA);
            PG8_BAR; PG8_WAIT_L(0); PG8_MMA(1, 0, At, B0); PG8_BAR; PG8_SCHED;
            PG8_STAGE(PG8_SB(0, 1), b2 + hstep, voffB);
            PG8_WAIT_V(6); PG8_BAR; PG8_MMA(1, 1, At, B1); PG8_BAR;
            PG8_LDB(B0, 1, 0); PG8_SCHED; PG8_LDA(At, 1, 0); PG8_STAGE(PG8_SA(0, 1), a2 + hstep, voffA);
            PG8_WAIT_L(8); PG8_BAR; PG8_WAIT_L(0); PG8_MMA(0, 0, At, B0); PG8_BAR; PG8_SCHED;
            PG8_LDB(B1, 1, 1); PG8_STAGE(PG8_SB(1, 0), b3, voffB);
            PG8_BAR; PG8_WAIT_L(0); PG8_MMA(0, 1, At, B1); PG8_BAR;
            PG8_LDA(At, 1, 1); PG8_STAGE(PG8_SA(1, 0), a3, voffA);
            PG8_BAR; PG8_WAIT_L(0); PG8_MMA(1, 0, At, B0); PG8_BAR; PG8_SCHED;
            PG8_STAGE(PG8_SB(1, 1), b3 + hstep, voffB);
            PG8_WAIT_V(6); PG8_BAR; PG8_MMA(1, 1, At, B1); PG8_BAR;
        }
        E(acc, cur, wr, wc, fr, fq);
        if (!has_next) break;
#pragma unroll
        for (int a = 0; a < 2; ++a)
#pragma unroll
            for (int b = 0; b < 2; ++b)
#pragma unroll
                for (int m = 0; m < 4; ++m)
#pragma unroll
                    for (int n = 0; n < 2; ++n) acc[a][b][m][n] = (f32x4){0.f, 0.f, 0.f, 0.f};
        cur = nxt; cA = nA; cB = nB; ++ui;
    }
    PG8_WAIT_V(0);
    if (wr == 0) PG8_BAR;
    PG8_BAR;
#undef PG8_SA
#undef PG8_SB
#undef PG8_STAGE
#undef PG8_LDA
#undef PG8_LDB
#undef PG8_MMA
#undef PG8_WAIT_V
#undef PG8_WAIT_L
#undef PG8_BAR
#undef PG8_SCHED
}
}

__device__ __forceinline__ void run_gemm(LAS unsigned char* lds, const h16* A, const h16* Bt, int N, int K, h16* O, int ldc, int mode, const int tidx) {
    pg8::Gemm g; g.A = A; g.Bt = Bt; g.M = T_; g.N = N; g.K = K;
    pg8::StaticOrder S; S.init(T_, N, (int)gridDim.x, (int)blockIdx.x);
    pg8::EpiH E; E.O = O; E.ldc = ldc; E.MODE = mode;
    pg8::gemm_phase(lds, g, S, E, tidx);
}

__device__ __forceinline__ void conv_weights(const Params& p, int l, LAS unsigned char* lds, const int tidx) {
    LAS float* tile = (LAS float*)lds;
    const int tid = tidx;
    for (int id = blockIdx.x; id < 3264; id += gridDim.x) {
        int mat, tl;
        if (id < 960) { mat = 0; tl = id; } else if (id < 1216) { mat = 1; tl = id - 960; } else if (id < 2240) { mat = 2; tl = id - 1216; } else { mat = 3; tl = id - 2240; }
        const int K = (mat == 3) ? 4096 : 1024;
        const int nkt = K / 64;
        const int n0 = (tl / nkt) * 64, k0 = (tl % nkt) * 64;
        h16* dst = (h16*)(p.ws + (mat == 0 ? OFF_WIN : mat == 1 ? OFF_WOUT : mat == 2 ? OFF_WUP : OFF_WDN));
        __syncthreads();
        {
            const int nj = tid & 63, n = n0 + nj;
            const float* src = nullptr; int sstride = 0;
            if (mat == 0) {
                if (n < 896) { src = p.in[I_WIN] + (size_t)l * DM * INC + n; sstride = INC; }
                else if (n < 928) { if (l > 0) { src = p.in[I_WINV] + (size_t)(l - 1) * DM * 32 + (n - 896); sstride = 32; } }
                else if (n < 2724) { src = p.in[I_WIN] + (size_t)l * DM * INC + (n - 32); sstride = INC; }
                else if (n < 2728) { }
                else if (n < 3752) { src = p.in[I_WIN] + (size_t)l * DM * INC + (n - 36); sstride = INC; }
            } else if (mat == 1) { src = p.in[I_WOUT] + (size_t)l * 1024 * 1024 + n; sstride = 1024; }
            else if (mat == 2) { src = p.in[I_WUP] + (size_t)l * 1024 * 4096 + n; sstride = 4096; }
            else { src = p.in[I_WDN] + (size_t)l * 4096 * 1024 + n; sstride = 1024; }
#pragma unroll
            for (int i = 0; i < 8; ++i) { const int ki = (tid >> 6) + 8 * i; tile[ki * 65 + nj] = src ? src[(size_t)(k0 + ki) * sstride] : 0.f; }
        }
        __syncthreads();
        {
            const int ki = tid & 63;
#pragma unroll
            for (int i = 0; i < 8; ++i) { const int nj = (tid >> 6) + 8 * i; dst[(size_t)(n0 + nj) * K + k0 + ki] = (h16)tile[ki * 65 + nj]; }
        }
    }
    __syncthreads();
}

__device__ __forceinline__ void conv_x(const Params& p, const int tidx) {
    const f32x4* src = (const f32x4*)p.in[I_X]; h16x4* dst = (h16x4*)(p.ws + OFF_X16);
    for (size_t i = (size_t)blockIdx.x * 512 + tidx; i < (size_t)T_ * DM / 4; i += (size_t)gridDim.x * 512) dst[i] = f4h(src[i]);
}

__device__ __forceinline__ void pre_phase(const Params& p, int l, LAS unsigned char* lds, const int tidx) {
    LAS float* act = (LAS float*)lds;
    const h16* proj = (const h16*)(p.ws + OFF_BIG);
    h16* prep = (h16*)p.out;
    h16* vfirst = (h16*)(p.ws + OFF_VF);
    const int tid = tidx;
    const int c = tid & 255, hf = tid >> 8, hh = c >> 6;
    const int nact = (l == 0) ? 128 : 160;
    const float mu_r = p.in[I_MU][l * 896 + c], mu_k = p.in[I_MU][l * 896 + 256 + c], mu_v = p.in[I_MU][l * 896 + 512 + c];
    const float w0 = p.in[I_W0][l * 256 + c], a0 = p.in[I_A0][l * 256 + c], k_k = p.in[I_KK][l * 256 + c], k_a = p.in[I_KA][l * 256 + c];
    const float r_k = p.in[I_RK][l * 256 + c], lnw = p.in[I_LNW][l * 256 + c], lnb = p.in[I_LNB][l * 256 + c];
    const float v0 = (l > 0) ? p.in[I_V0][(l - 1) * 256 + c] : 0.f;
    const float* w2 = p.in[I_W2] + (size_t)l * 32 * 256 + c;
    const float* a2 = p.in[I_A2] + (size_t)l * 32 * 256 + c;
    const float* g2 = p.in[I_G2] + (size_t)l * 64 * 256 + c;
    const float* v2 = p.in[I_V2] + (size_t)(l > 0 ? l - 1 : 0) * 32 * 256 + c;
    for (int tt = blockIdx.x; tt < T_ / 64; tt += gridDim.x) {
        const int t0 = tt * 64;
        __syncthreads();
        for (int e = tid; e < 64 * 160; e += 512) {
            const int tok = e / 160, i = e - tok * 160;
            if (i < nact) {
                const int t = t0 + tok;
                const float cur = (float)proj[(size_t)t * NP + C_FW + i];
                const float prv = (t & (SEQ_ - 1)) ? (float)proj[(size_t)(t - 1) * NP + C_FW + i] : 0.f;
                const float mu = (i < 128) ? p.in[I_MU][l * 896 + 768 + i] : p.in[I_MUV][(l - 1) * 32 + (i - 128)];
                const float f = cur + (prv - cur) * mu;
                float a = f;
                if (i < 32) a = tanhf(f); else if (i >= 64 && i < 128) a = sigmoidf_(f);
                act[i * 64 + tok] = a;
            }
        }
        __syncthreads();
#pragma unroll 1
        for (int grp = 0; grp < 2; ++grp) {
            const int tb = hf * 32 + grp * 16;
            float aw[16], aa[16], ag[16], av[16];
#pragma unroll
            for (int j = 0; j < 16; ++j) { aw[j] = 0.f; aa[j] = 0.f; ag[j] = 0.f; av[j] = 0.f; }
#pragma unroll 2
            for (int i = 0; i < 32; ++i) {
                const float ww = w2[i * 256], wa = a2[i * 256];
                const LAS f32x4* r1 = (const LAS f32x4*)(act + i * 64 + tb);
                const LAS f32x4* r2 = (const LAS f32x4*)(act + (32 + i) * 64 + tb);
#pragma unroll
                for (int q = 0; q < 4; ++q) { const f32x4 x = r1[q], y = r2[q];
#pragma unroll
                    for (int j = 0; j < 4; ++j) { aw[4 * q + j] += x[j] * ww; aa[4 * q + j] += y[j] * wa; } }
            }
#pragma unroll 2
            for (int i = 0; i < 64; ++i) {
                const float wg = g2[i * 256];
                const LAS f32x4* r1 = (const LAS f32x4*)(act + (64 + i) * 64 + tb);
#pragma unroll
                for (int q = 0; q < 4; ++q) { const f32x4 x = r1[q];
#pragma unroll
                    for (int j = 0; j < 4; ++j) ag[4 * q + j] += x[j] * wg; }
            }
            if (l > 0) {
#pragma unroll 2
                for (int i = 0; i < 32; ++i) {
                    const float wv = v2[i * 256];
                    const LAS f32x4* r1 = (const LAS f32x4*)(act + (128 + i) * 64 + tb);
#pragma unroll
                    for (int q = 0; q < 4; ++q) { const f32x4 x = r1[q];
#pragma unroll
                        for (int j = 0; j < 4; ++j) av[4 * q + j] += x[j] * wv; }
                }
            }
#pragma unroll
            for (int j = 0; j < 16; ++j) {
                const int t = t0 + tb + j;
                const h16* row = proj + (size_t)t * NP;
                float r = (float)row[C_R + c], k = (float)row[C_K + c], v = (float)row[C_V + c];
                float pr = 0.f, pk = 0.f, pv = 0.f;
                if (t & (SEQ_ - 1)) { pr = (float)row[C_R + c - NP]; pk = (float)row[C_K + c - NP]; pv = (float)row[C_V + c - NP]; }
                r += (pr - r) * mu_r; k += (pk - k) * mu_k; v += (pv - v) * mu_v;
                const float wl = w0 + aw[j];
                const float wlog = -softplusf_(-wl) - 0.5f;
                const float ee = __expf(wlog);
                const float a = sigmoidf_(a0 + aa[j]);
                if (l == 0) vfirst[(size_t)t * 256 + c] = (h16)v;
                else { const float vf = (float)vfirst[(size_t)t * 256 + c]; v += (vf - v) * sigmoidf_(v0 + av[j]); }
                const float kkr = k * k_k;
                const float nrm = sqrtf(sum64(kkr * kkr));
                const float kk = kkr / fmaxf(nrm, 1e-12f);
                const float kp = k * (1.0f + (a - 1.0f) * k_a);
                const float bb = kk * a;
                const float bonus = sum64(r * kp * r_k);
                const float g = ag[j];
                h16* o = prep + (size_t)t * 2048 + c;
                o[0] = (h16)r; o[256] = (h16)ee; o[512] = (h16)kp; o[768] = (h16)kk; o[1024] = (h16)bb; o[1280] = (h16)v;
                o[1536] = (h16)(lnw * g); o[1792] = (h16)((lnb + bonus * v) * g);
            }
        }
    }
    __syncthreads();
    (void)hh;
}

constexpr int CH = 32;

__device__ __forceinline__ float dot4(f32x4 a, f32x4 b) { return (a[0] * b[0] + a[1] * b[1]) + (a[2] * b[2] + a[3] * b[3]); }
__device__ __forceinline__ void plain_write_y(h16* mix, int t0, int col, LAS unsigned char* ybuf, int lt) {
    const int tok = lt >> 3, r8 = lt & 7;
    const f32x4 y = *(const LAS f32x4*)(ybuf + (tok * 32 + r8 * 4) * 4);
    *(h16x4*)(mix + (size_t)(t0 + tok) * DM + col + r8 * 4) = f4h(y);
}

constexpr int RW_SH = 0, RW_VB = CH * 16 * 20 * 4, RW_YB = RW_VB + CH * 32 * 4, RW_STRIDE = RW_YB + CH * 32 * 4;
__device__ __forceinline__ void rwkv_load(const h16* prep, int t0, int h, int rowbase, LAS unsigned char* buf, int lt) {
    LAS float* sh = (LAS float*)(buf + RW_SH);
    h16x4 raw[10];
#pragma unroll
    for (int i = 0; i < 10; ++i) {
        const int e = i * 256 + lt, tok = e / 80, rem = e - tok * 80, vec = rem >> 4, sub = rem & 15;
        const int pv = (vec == 0) ? 3 : (vec == 1) ? 1 : (vec == 2) ? 4 : (vec == 3) ? 2 : 0;
        raw[i] = *(const h16x4*)(prep + (size_t)(t0 + tok) * 2048 + pv * 256 + h * 64 + sub * 4);
    }
    const int tokv = lt >> 3, r8 = lt & 7;
    const h16x4 rv = *(const h16x4*)(prep + (size_t)(t0 + tokv) * 2048 + 5 * 256 + rowbase + r8 * 4);
#pragma unroll
    for (int i = 0; i < 10; ++i) {
        const int e = i * 256 + lt, tok = e / 80, rem = e - tok * 80, vec = rem >> 4, sub = rem & 15;
        f32x4 f = h4f(raw[i]);
        if (vec == 1) { f[0] = __expf(-f[0]); f[1] = __expf(-f[1]); f[2] = __expf(-f[2]); f[3] = __expf(-f[3]); }
        *(LAS f32x4*)(sh + ((tok * 16 + sub) * 5 + vec) * 4) = f;
    }
    *(LAS f32x4*)(buf + RW_VB + (tokv * 32 + r8 * 4) * 4) = h4f(rv);
}
__device__ __forceinline__ void rwkv_scan(const Params& p, int item, LAS unsigned char* lds, const int tidx) {
    const int b = item >> 3, h = (item >> 1) & 3, q2 = item & 1;
    const int tid = tidx, wid = tid >> 6, lane = tid & 63, lt = tid - 256;
    const h16* prep = (const h16*)p.out;
    h16* mix = (h16*)(p.ws + OFF_MIX);
    const int rowbase = h * 64 + q2 * 32, tb = b * SEQ_;
    const bool loader = wid >= 4;
    const int rowl = (wid & 3) * 4 + (lane >> 4), sub = lane & 15;
    LAS float* dump = (LAS float*)(lds + LDS_BYTES - 8192) + tid;
    f32x4 Sa = {0.f, 0.f, 0.f, 0.f}, Sb = {0.f, 0.f, 0.f, 0.f};
    __syncthreads();
    if (loader) rwkv_load(prep, tb, h, rowbase, lds, lt);
    __syncthreads();
#pragma unroll 1
    for (int c = 0; c < SEQ_ / CH; ++c) {
        LAS unsigned char* buf = lds + (c & 1) * RW_STRIDE;
        if (loader) {
            if (c + 1 < SEQ_ / CH) rwkv_load(prep, tb + (c + 1) * CH, h, rowbase, lds + ((c + 1) & 1) * RW_STRIDE, lt);
            if (c > 0) plain_write_y(mix, tb + (c - 1) * CH, rowbase, lds + ((c - 1) & 1) * RW_STRIDE + RW_YB, lt);
        } else {
            const LAS float* sh = (const LAS float*)(buf + RW_SH);
            const LAS float* vb = (const LAS float*)(buf + RW_VB);
            LAS float* yb = (LAS float*)(buf + RW_YB);
            const LAS f32x4* q0 = (const LAS f32x4*)(sh + sub * 20);
            f32x4 nkk = q0[0], nw = q0[1], nbb = q0[2], nk = q0[3], nr = q0[4];
            float nva = vb[rowl], nvb = vb[rowl + 16];
#pragma unroll 4
            for (int s = 0; s < CH; ++s) {
                const f32x4 kk = nkk, w = nw, bb = nbb, k = nk, r = nr;
                const float va = nva, vbb = nvb;
                const LAS f32x4* q = (const LAS f32x4*)(sh + ((s + 1) * 16 + sub) * 20);
                nkk = q[0]; nw = q[1]; nbb = q[2]; nk = q[3]; nr = q[4];
                nva = vb[(s + 1) * 32 + rowl]; nvb = vb[(s + 1) * 32 + rowl + 16];
                const float da = sum16(dot4(Sa, kk)), db = sum16(dot4(Sb, kk));
                Sa = Sa * w + (k * va - bb * da);
                Sb = Sb * w + (k * vbb - bb * db);
                const float ya = sum16(dot4(Sa, r)), yb2 = sum16(dot4(Sb, r));
                LAS float* wp = (sub == 0) ? (yb + s * 32 + rowl) : dump;
                wp[0] = ya; wp[16] = yb2;
            }
        }
        __syncthreads();
    }
    if (loader) plain_write_y(mix, tb + (SEQ_ / CH - 1) * CH, rowbase, lds + ((SEQ_ / CH - 1) & 1) * RW_STRIDE + RW_YB, lt);
}

constexpr int HG_SH = 0, HG_VB = CH * 16 * 12 * 4, HG_YB = HG_VB + CH * 32 * 4, HG_STRIDE = HG_YB + CH * 32 * 4;
__device__ __forceinline__ void hgrn_load(const h16* proj, int t0, int h, int rowbase, f32x4 lb, LAS unsigned char* buf, int lt) {
    LAS float* sh = (LAS float*)(buf + HG_SH);
    h16x4 rq[2], rf[2];
#pragma unroll
    for (int i = 0; i < 2; ++i) {
        const int e = i * 256 + lt, tok = e >> 4, sub = e & 15;
        const h16* row = proj + (size_t)(t0 + tok) * NP + h * 64 + sub * 4;
        rq[i] = *(const h16x4*)(row + C_HQ); rf[i] = *(const h16x4*)(row + C_HF);
    }
    const int tokv = lt >> 3, r8 = lt & 7;
    const h16x4 rv = *(const h16x4*)(proj + (size_t)(t0 + tokv) * NP + C_HI + rowbase + r8 * 4);
#pragma unroll
    for (int i = 0; i < 2; ++i) {
        const int e = i * 256 + lt, tok = e >> 4, sub = e & 15;
        const f32x4 qv = h4f(rq[i]), fv = h4f(rf[i]);
        f32x4 fo, ko, qo;
#pragma unroll
        for (int j = 0; j < 4; ++j) { const float fg = lb[j] + (1.0f - lb[j]) * sigmoidf_(fv[j]); fo[j] = fg; ko[j] = 1.0f - fg; qo[j] = siluf_(qv[j]); }
        LAS f32x4* d = (LAS f32x4*)(sh + (tok * 16 + sub) * 12);
        d[0] = fo; d[1] = ko; d[2] = qo;
    }
    *(LAS f32x4*)(buf + HG_VB + (tokv * 32 + r8 * 4) * 4) = h4f(rv);
}
__device__ __forceinline__ void hgrn_scan(const Params& p, int l, int item, LAS unsigned char* lds, const int tidx) {
    const int b = item >> 3, h = (item >> 1) & 3, q2 = item & 1;
    const int tid = tidx, wid = tid >> 6, lane = tid & 63, lt = tid - 256;
    const h16* proj = (const h16*)(p.ws + OFF_BIG);
    h16* mix = (h16*)(p.ws + OFF_MIX);
    const int rowbase = h * 64 + q2 * 32, tb = b * SEQ_;
    const bool loader = wid >= 4;
    const int rowl = (wid & 3) * 4 + (lane >> 4), sub = lane & 15;
    LAS float* dump = (LAS float*)(lds + LDS_BYTES - 8192) + tid;
    f32x4 lb = {0.f, 0.f, 0.f, 0.f};
    if (l > 0) {
#pragma unroll
        for (int j = 0; j < 4; ++j) { const int ch = h * 64 + (lt & 15) * 4 + j; lb[j] = sigmoidf_(p.in[I_LB][256 + ch] - p.in[I_LB][ch]); }
    }
    f32x4 Sa = {0.f, 0.f, 0.f, 0.f}, Sb = {0.f, 0.f, 0.f, 0.f};
    __syncthreads();
    if (loader) hgrn_load(proj, tb, h, rowbase, lb, lds, lt);
    __syncthreads();
#pragma unroll 1
    for (int c = 0; c < SEQ_ / CH; ++c) {
        LAS unsigned char* buf = lds + (c & 1) * HG_STRIDE;
        if (loader) {
            if (c + 1 < SEQ_ / CH) hgrn_load(proj, tb + (c + 1) * CH, h, rowbase, lb, lds + ((c + 1) & 1) * HG_STRIDE, lt);
            if (c > 0) plain_write_y(mix, tb + (c - 1) * CH, 768 + rowbase, lds + ((c - 1) & 1) * HG_STRIDE + HG_YB, lt);
        } else {
            const LAS float* sh = (const LAS float*)(buf + HG_SH);
            const LAS float* vb = (const LAS float*)(buf + HG_VB);
            LAS float* yb = (LAS float*)(buf + HG_YB);
            const LAS f32x4* q0 = (const LAS f32x4*)(sh + sub * 12);
            f32x4 nf = q0[0], nk = q0[1], nq = q0[2];
            float nva = vb[rowl], nvb = vb[rowl + 16];
#pragma unroll 4
            for (int s = 0; s < CH; ++s) {
                const f32x4 f = nf, k = nk, qq = nq;
                const float va = nva, vbb = nvb;
                const LAS f32x4* q = (const LAS f32x4*)(sh + ((s + 1) * 16 + sub) * 12);
                nf = q[0]; nk = q[1]; nq = q[2];
                nva = vb[(s + 1) * 32 + rowl]; nvb = vb[(s + 1) * 32 + rowl + 16];
                Sa = Sa * f + k * va; Sb = Sb * f + k * vbb;
                const float ya = sum16(dot4(Sa, qq)), yb2 = sum16(dot4(Sb, qq));
                LAS float* wp = (sub == 0) ? (yb + s * 32 + rowl) : dump;
                wp[0] = ya; wp[16] = yb2;
            }
        }
        __syncthreads();
    }
    if (loader) plain_write_y(mix, tb + (SEQ_ / CH - 1) * CH, 768 + rowbase, lds + ((SEQ_ / CH - 1) & 1) * HG_STRIDE + HG_YB, lt);
}

constexpr int SD_SH = 0, SD_XDT = CH * 16 * 16 * 4, SD_XS = SD_XDT + CH * 32 * 4, SD_AB = SD_XS + CH * 32 * 4, SD_YB = SD_AB + CH * 4, SD_STRIDE = SD_YB + CH * 32 * 4;
struct SsdW { f32x4 w[4], b; };
__device__ __forceinline__ SsdW ssd_wload(const Params& p, int l, int ch) {
    SsdW r; const float* cw = p.in[I_CW] + (size_t)l * 4 * 768 + ch;
#pragma unroll
    for (int j = 0; j < 4; ++j) r.w[j] = *(const f32x4*)(cw + j * 768);
    r.b = *(const f32x4*)(p.in[I_CB] + l * 768 + ch);
    return r;
}
__device__ __forceinline__ f32x4 silu4(f32x4 a) { f32x4 o; o[0] = siluf_(a[0]); o[1] = siluf_(a[1]); o[2] = siluf_(a[2]); o[3] = siluf_(a[3]); return o; }
__device__ __forceinline__ void ssd_load(const h16* proj, int t0, int h, const SsdW& wbc, int chbc, const SsdW& wxs, int chxs, float dtb, float Ah, LAS unsigned char* buf, int lt) {
    LAS float* sh = (LAS float*)(buf + SD_SH);
    const int gi = lt & 63, tq = lt >> 6, vec = gi >> 5, gj = gi & 31;
    const int tA = t0 + tq * 8, posA = tA & (SEQ_ - 1);
    h16x4 rows[11];
#pragma unroll
    for (int j = 0; j < 11; ++j) rows[j] = (posA - 3 + j >= 0) ? *(const h16x4*)(proj + (size_t)(tA - 3 + j) * NP + C_SX + chbc) : (h16x4){(h16)0.f, (h16)0.f, (h16)0.f, (h16)0.f};
    const int tokx = lt >> 3, r8 = lt & 7, tX = t0 + tokx, posX = tX & (SEQ_ - 1);
    h16x4 rx[4];
#pragma unroll
    for (int j = 0; j < 4; ++j) rx[j] = (posX - 3 + j >= 0) ? *(const h16x4*)(proj + (size_t)(tX - 3 + j) * NP + C_SX + chxs) : (h16x4){(h16)0.f, (h16)0.f, (h16)0.f, (h16)0.f};
    const float dtraw = (float)proj[(size_t)tX * NP + C_SDT + h];
#pragma unroll
    for (int j = 0; j < 8; ++j) {
        f32x4 acc = wbc.b;
#pragma unroll
        for (int k = 0; k < 4; ++k) acc += h4f(rows[j + k]) * wbc.w[k];
        *(LAS f32x4*)(sh + ((tq * 8 + j) * 16 + (gj >> 1)) * 16 + vec * 8 + (gj & 1) * 4) = silu4(acc);
    }
    {
        f32x4 acc = wxs.b;
#pragma unroll
        for (int k = 0; k < 4; ++k) acc += h4f(rx[k]) * wxs.w[k];
        const f32x4 xs = silu4(acc);
        const float dt = softplusf_(dtraw + dtb);
        *(LAS f32x4*)(buf + SD_XS + (tokx * 32 + r8 * 4) * 4) = xs;
        *(LAS f32x4*)(buf + SD_XDT + (tokx * 32 + r8 * 4) * 4) = xs * dt;
        if (r8 == 0) *(LAS float*)(buf + SD_AB + tokx * 4) = __expf(dt * Ah);
    }
}
__device__ __forceinline__ void ssd_write_y(const h16* proj, h16* mix, int t0, int cc0, LAS unsigned char* ybuf, int lt) {
    const int tok = lt >> 3, r8 = lt & 7, cc = cc0 + r8 * 4;
    const f32x4 y = *(const LAS f32x4*)(ybuf + (tok * 32 + r8 * 4) * 4);
    const f32x4 z = h4f(*(const h16x4*)(proj + (size_t)(t0 + tok) * NP + C_SZ + cc));
    *(h16x4*)(mix + (size_t)(t0 + tok) * DM + 512 + cc) = f4h(y * silu4(z));
}
__device__ __forceinline__ void ssd_scan(const Params& p, int l, int item, LAS unsigned char* lds, const int tidx) {
    const int b = item >> 3, h = (item >> 1) & 3, q2 = item & 1;
    const int tid = tidx, wid = tid >> 6, lane = tid & 63, lt = tid - 256;
    const h16* proj = (const h16*)(p.ws + OFF_BIG);
    h16* mix = (h16*)(p.ws + OFF_MIX);
    const int tb = b * SEQ_, cc0 = h * 64 + q2 * 32;
    const bool loader = wid >= 4;
    const int rowl = (wid & 3) * 4 + (lane >> 4), sub = lane & 15;
    LAS float* dump = (LAS float*)(lds + LDS_BYTES - 8192) + tid;
    const float dtb = p.in[I_DTB][l * 4 + h], Ah = -__expf(p.in[I_ALOG][l * 4 + h]), Dh = p.in[I_SD][l * 4 + h];
    const int chbc = 256 + ((lt & 63) >> 5) * 256 + (h >> 1) * 128 + (lt & 31) * 4, chxs = cc0 + (lt & 7) * 4;
    SsdW wbc, wxs;
    if (loader) { wbc = ssd_wload(p, l, chbc); wxs = ssd_wload(p, l, chxs); }
    f32x4 Sa0 = {0.f, 0.f, 0.f, 0.f}, Sa1 = Sa0, Sb0 = Sa0, Sb1 = Sa0;
    __syncthreads();
    if (loader) ssd_load(proj, tb, h, wbc, chbc, wxs, chxs, dtb, Ah, lds, lt);
    __syncthreads();
#pragma unroll 1
    for (int c = 0; c < SEQ_ / CH; ++c) {
        LAS unsigned char* buf = lds + (c & 1) * SD_STRIDE;
        if (loader) {
            if (c + 1 < SEQ_ / CH) ssd_load(proj, tb + (c + 1) * CH, h, wbc, chbc, wxs, chxs, dtb, Ah, lds + ((c + 1) & 1) * SD_STRIDE, lt);
            if (c > 0) ssd_write_y(proj, mix, tb + (c - 1) * CH, cc0, lds + ((c - 1) & 1) * SD_STRIDE + SD_YB, lt);
        } else {
            const LAS float* sh = (const LAS float*)(buf + SD_SH);
            const LAS float* xdt = (const LAS float*)(buf + SD_XDT);
            const LAS float* xsb = (const LAS float*)(buf + SD_XS);
            const LAS float* ab = (const LAS float*)(buf + SD_AB);
            LAS float* yb = (LAS float*)(buf + SD_YB);
            const LAS f32x4* q0 = (const LAS f32x4*)(sh + sub * 16);
            f32x4 nB0 = q0[0], nB1 = q0[1], nC0 = q0[2], nC1 = q0[3];
            float na = ab[0], nxda = xdt[rowl], nxdb = xdt[rowl + 16], nxsa = xsb[rowl], nxsb = xsb[rowl + 16];
#pragma unroll 4
            for (int s = 0; s < CH; ++s) {
                const f32x4 B0 = nB0, B1 = nB1, C0 = nC0, C1 = nC1;
                const float a = na, xda = nxda, xdb = nxdb, xsa = nxsa, xsb2 = nxsb;
                const LAS f32x4* q = (const LAS f32x4*)(sh + ((s + 1) * 16 + sub) * 16);
                nB0 = q[0]; nB1 = q[1]; nC0 = q[2]; nC1 = q[3];
                na = ab[s + 1]; nxda = xdt[(s + 1) * 32 + rowl]; nxdb = xdt[(s + 1) * 32 + rowl + 16]; nxsa = xsb[(s + 1) * 32 + rowl]; nxsb = xsb[(s + 1) * 32 + rowl + 16];
                Sa0 = Sa0 * a + B0 * xda; Sa1 = Sa1 * a + B1 * xda;
                Sb0 = Sb0 * a + B0 * xdb; Sb1 = Sb1 * a + B1 * xdb;
                const float ya = sum16(dot4(Sa0, C0) + dot4(Sa1, C1)) + Dh * xsa;
                const float yb2 = sum16(dot4(Sb0, C0) + dot4(Sb1, C1)) + Dh * xsb2;
                LAS float* wp = (sub == 0) ? (yb + s * 32 + rowl) : dump;
                wp[0] = ya; wp[16] = yb2;
            }
        }
        __syncthreads();
    }
    if (loader) ssd_write_y(proj, mix, tb + (SEQ_ / CH - 1) * CH, cc0, lds + ((SEQ_ / CH - 1) & 1) * SD_STRIDE + SD_YB, lt);
}

__device__ __forceinline__ void attn_item(const Params& p, int item, const int tidx) {
    const int b = item / 192, rem = item - b * 192, h = rem / 48, s = rem - h * 48;
    int br, dil, r, n;
    if (s < 16) { br = 0; dil = 1; r = 0; n = s; } else if (s < 32) { br = 1; dil = 4; r = (s - 16) >> 2; n = (s - 16) & 3; } else { br = 2; dil = 16; r = s - 32; n = 0; }
    const int tid = tidx, wid = tid >> 6, lane = tid & 63, c16 = lane & 15, g = lane >> 4;
    const h16* base = (const h16*)(p.ws + OFF_BIG) + (size_t)b * SEQ_ * NP;
    const int tq = (n * 128 + 16 * wid + c16) * dil + r;
    h16x8 qf0 = *(const h16x8*)(base + (size_t)tq * NP + C_AQ + h * 64 + g * 8);
    h16x8 qf1 = *(const h16x8*)(base + (size_t)tq * NP + C_AQ + h * 64 + 32 + g * 8);
    f32x4 sc[9];
#pragma unroll
    for (int kt = 0; kt < 9; ++kt) {
        int kp = (n - 1) * 128 + 16 * wid + 16 * kt + c16; kp = kp < 0 ? 0 : kp;
        const h16* kr = base + (size_t)(kp * dil + r) * NP + C_AK + h * 64 + g * 8;
        const h16x8 k0 = *(const h16x8*)kr, k1 = *(const h16x8*)(kr + 32);
        f32x4 a = {0.f, 0.f, 0.f, 0.f};
        a = __builtin_amdgcn_mfma_f32_16x16x32_f16(k0, qf0, a, 0, 0, 0);
        a = __builtin_amdgcn_mfma_f32_16x16x32_f16(k1, qf1, a, 0, 0, 0);
        sc[kt] = a;
    }
    const float slope = exp2f(-2.0f * (float)(h + 1)) * (float)dil;
    float m = -INFINITY;
#pragma unroll
    for (int kt = 0; kt < 9; ++kt)
#pragma unroll
        for (int rg = 0; rg < 4; ++rg) {
            const int jj = 16 * kt + 4 * g + rg, dist = 128 + c16 - jj;
            const bool valid = (dist >= 0) && (dist <= 128) && (n > 0 || (16 * wid + jj) >= 128);
            const float v = valid ? (sc[kt][rg] * 0.125f - slope * (float)dist) : -INFINITY;
            sc[kt][rg] = v; m = fmaxf(m, v);
        }
    m = fmaxf(m, __shfl_xor(m, 16)); m = fmaxf(m, __shfl_xor(m, 32));
    float lsum = 0.f;
#pragma unroll
    for (int kt = 0; kt < 9; ++kt)
#pragma unroll
        for (int rg = 0; rg < 4; ++rg) { const float e = __expf(sc[kt][rg] - m); sc[kt][rg] = e; lsum += e; }
    lsum += __shfl_xor(lsum, 16); lsum += __shfl_xor(lsum, 32);
    f32x4 o[4];
#pragma unroll
    for (int d = 0; d < 4; ++d) o[d] = (f32x4){0.f, 0.f, 0.f, 0.f};
#pragma unroll
    for (int kt = 0; kt < 9; ++kt)
#pragma unroll
        for (int rg = 0; rg < 4; ++rg) {
            int kp = (n - 1) * 128 + 16 * wid + 16 * kt + 4 * g + rg; kp = kp < 0 ? 0 : kp;
            const f32x4 v = h4f(*(const h16x4*)(base + (size_t)(kp * dil + r) * NP + C_AV + h * 64 + 4 * c16));
#pragma unroll
            for (int d = 0; d < 4; ++d) o[d] = __builtin_amdgcn_mfma_f32_16x16x4f32(sc[kt][rg], v[d], o[d], 0, 0, 0);
        }
    h16* dst; int ld, co;
    if (br == 0) { dst = (h16*)(p.ws + OFF_MIX); ld = DM; co = 256; } else { dst = (h16*)(p.ws + (br == 1 ? OFF_O2 : OFF_O3)); ld = 256; co = 0; }
    float* lse = (float*)(p.ws + OFF_LSE) + (size_t)br * T_ * 4;
#pragma unroll
    for (int rg = 0; rg < 4; ++rg) {
        const int q = 4 * g + rg;
        const float inv = 1.0f / __shfl(lsum, q);
        const int t = b * SEQ_ + (n * 128 + 16 * wid + q) * dil + r;
        h16x4 ov; ov[0] = (h16)(o[0][rg] * inv); ov[1] = (h16)(o[1][rg] * inv); ov[2] = (h16)(o[2][rg] * inv); ov[3] = (h16)(o[3][rg] * inv);
        *(h16x4*)(dst + (size_t)t * ld + co + h * 64 + 4 * c16) = ov;
    }
    if (g == 0) lse[(size_t)(b * SEQ_ + tq) * 4 + h] = m + __logf(lsum);
}

__device__ __forceinline__ void mix_phase(const Params& p, int l, int cidx, LAS unsigned char* lds, const int tidx) {
    unsigned* ctr = (unsigned*)(p.ws + OFF_MISC) + cidx;
    LAS unsigned* slot = (LAS unsigned*)(lds + LDS_BYTES - 16);
    for (;;) {
        __syncthreads();
        if (tidx == 0) *slot = atomicAdd(ctr, 1u);
        __syncthreads();
        const int it = (int)*slot;
        if (it >= 64 * 3 + 1536) break;
        int t2 = tidx; asm volatile("" : "+v"(t2));
        if (it < 64) rwkv_scan(p, it, lds, t2);
        else if (it < 128) ssd_scan(p, l, it - 64, lds, t2);
        else if (it < 192) hgrn_scan(p, l, it - 128, lds, t2);
        else attn_item(p, it - 192, t2);
    }
}

__device__ __forceinline__ void post_phase(const Params& p, int l, const int tidx) {
    const int wid = tidx >> 6, lane = tidx & 63;
    h16* mix = (h16*)(p.ws + OFF_MIX);
    const h16* prep = (const h16*)p.out;
    const h16* proj = (const h16*)(p.ws + OFF_BIG);
    const h16* o2 = (const h16*)(p.ws + OFF_O2);
    const h16* o3 = (const h16*)(p.ws + OFF_O3);
    const float* lse = (const float*)(p.ws + OFF_LSE);
    const f32x4 snw = *(const f32x4*)(p.in[I_SNW] + l * 256 + 4 * lane);
    const f32x4 hnw = *(const f32x4*)(p.in[I_HNW] + l * 256 + 4 * lane);
    const int hd = lane >> 4;
    for (int t = blockIdx.x * 8 + wid; t < T_; t += gridDim.x * 8) {
        h16* mr = mix + (size_t)t * DM + 4 * lane;
        {
            const f32x4 y = h4f(*(const h16x4*)mr);
            const float mu = sum16(y[0] + y[1] + y[2] + y[3]) * (1.0f / 64.0f);
            const f32x4 d = y - mu;
            const float var = sum16(d[0] * d[0] + d[1] * d[1] + d[2] * d[2] + d[3] * d[3]) * (1.0f / 64.0f);
            const float rstd = rsqrtf(var + 64e-5f);
            const f32x4 A = h4f(*(const h16x4*)(prep + (size_t)t * 2048 + 1536 + 4 * lane));
            const f32x4 Bc = h4f(*(const h16x4*)(prep + (size_t)t * 2048 + 1792 + 4 * lane));
            *(h16x4*)mr = f4h(d * rstd * A + Bc);
        }
        {
            const f32x4 a1 = h4f(*(const h16x4*)(mr + 256));
            const f32x4 a2 = h4f(*(const h16x4*)(o2 + (size_t)t * 256 + 4 * lane));
            const f32x4 a3 = h4f(*(const h16x4*)(o3 + (size_t)t * 256 + 4 * lane));
            const float l1 = lse[(size_t)t * 4 + hd], l2 = lse[(size_t)(T_ + t) * 4 + hd], l3 = lse[(size_t)(2 * T_ + t) * 4 + hd];
            const float mx = fmaxf(l1, fmaxf(l2, l3));
            const float w1 = __expf(l1 - mx), w2 = __expf(l2 - mx), w3 = __expf(l3 - mx);
            const float inv = 1.0f / (w1 + w2 + w3);
            *(h16x4*)(mr + 256) = f4h((a1 * w1 + a2 * w2 + a3 * w3) * inv);
        }
        {
            const f32x4 u = h4f(*(const h16x4*)(mr + 512));
            float ss = sum16(u[0] * u[0] + u[1] * u[1] + u[2] * u[2] + u[3] * u[3]);
            ss += __shfl_xor(ss, 16);
            const float rstd = rsqrtf(ss * (1.0f / 128.0f) + 1e-5f);
            *(h16x4*)(mr + 512) = f4h(u * rstd * snw);
        }
        {
            const f32x4 u = h4f(*(const h16x4*)(mr + 768));
            const float ss = sum16(u[0] * u[0] + u[1] * u[1] + u[2] * u[2] + u[3] * u[3]);
            const float rstd = rsqrtf(ss * (1.0f / 64.0f) + 1e-5f);
            const f32x4 gz = h4f(*(const h16x4*)(proj + (size_t)t * NP + C_HG + 4 * lane));
            f32x4 gt; gt[0] = siluf_(gz[0]); gt[1] = siluf_(gz[1]); gt[2] = siluf_(gz[2]); gt[3] = siluf_(gz[3]);
            *(h16x4*)(mr + 768) = f4h(u * rstd * hnw * gt);
        }
    }
}

__device__ __forceinline__ void ln_phase(const Params& p, const float* w, const float* bvec, bool final_out, const int tidx) {
    const int wid = tidx >> 6, lane = tidx & 63;
    h16* x16 = (h16*)(p.ws + OFF_X16);
    f32x4 wv[4], bv[4];
#pragma unroll
    for (int q = 0; q < 4; ++q) { wv[q] = *(const f32x4*)(w + lane * 16 + 4 * q); bv[q] = *(const f32x4*)(bvec + lane * 16 + 4 * q); }
    for (int t = blockIdx.x * 8 + wid; t < T_; t += gridDim.x * 8) {
        h16* row = x16 + (size_t)t * DM + lane * 16;
        const h16x8 v0 = *(const h16x8*)row, v1 = *(const h16x8*)(row + 8);
        float x[16];
#pragma unroll
        for (int j = 0; j < 8; ++j) { x[j] = (float)v0[j]; x[8 + j] = (float)v1[j]; }
        float s = 0.f;
#pragma unroll
        for (int j = 0; j < 16; ++j) s += x[j];
        const float mu = sum64(s) * (1.0f / 1024.0f);
        float q2 = 0.f;
#pragma unroll
        for (int j = 0; j < 16; ++j) { x[j] -= mu; q2 += x[j] * x[j]; }
        const float rstd = rsqrtf(sum64(q2) * (1.0f / 1024.0f) + 1e-5f);
#pragma unroll
        for (int j = 0; j < 16; ++j) x[j] = x[j] * rstd * wv[j >> 2][j & 3] + bv[j >> 2][j & 3];
        if (final_out) {
            float* orow = p.out + (size_t)t * DM + lane * 16;
#pragma unroll
            for (int q = 0; q < 4; ++q) *(f32x4*)(orow + 4 * q) = (f32x4){x[4 * q], x[4 * q + 1], x[4 * q + 2], x[4 * q + 3]};
        } else {
            h16x8 o0, o1;
#pragma unroll
            for (int j = 0; j < 8; ++j) { o0[j] = (h16)x[j]; o1[j] = (h16)x[8 + j]; }
            *(h16x8*)row = o0; *(h16x8*)(row + 8) = o1;
        }
    }
}

constexpr int NPHASE = 19;
__device__ __forceinline__ void run_phase(const Params& p, int ph, LAS unsigned char* lds, const int tidx, const int rep) {
    const int l = (ph == 0) ? 0 : (ph - 1) / 9, s = (ph == 0) ? -1 : (ph - 1) % 9;
    h16* x16 = (h16*)(p.ws + OFF_X16);
    h16* mix = (h16*)(p.ws + OFF_MIX);
    h16* big = (h16*)(p.ws + OFF_BIG);
    if (ph == 0) {
        if (blockIdx.x == 0) for (int i = tidx; i < 256 + 3456; i += 512) ((unsigned*)(p.ws + OFF_MISC))[i] = 0u;
        conv_x(p, tidx);
    }
    if (s == 0 || s == 4 || s == 6 || s == 7) {
        const h16* A = (s == 0 || s == 6) ? x16 : (s == 4 ? mix : big);
        const h16* Bt = (const h16*)(p.ws + (s == 0 ? OFF_WIN : s == 4 ? OFF_WOUT : s == 6 ? OFF_WUP : OFF_WDN));
        const int N = (s == 0) ? NP : (s == 6 ? DFF : DM), K = (s == 7) ? DFF : DM;
        h16* O = (s == 0 || s == 6) ? big : x16;
        run_gemm(lds, A, Bt, N, K, O, N, (s == 0) ? 0 : (s == 6 ? 1 : 2), tidx);
    }
    if (s == 1) pre_phase(p, l, lds, tidx);
    if (s == 2) mix_phase(p, l, 2 * rep + l, lds, tidx);
    if (s == 3) post_phase(p, l, tidx);
    if (s == 5 || s == 8) ln_phase(p, p.in[s == 5 ? I_LN1W : I_LN2W] + l * DM, p.in[s == 5 ? I_LN1B : I_LN2B] + l * DM, s == 8 && l == 1, tidx);
    if (ph == 0 || (s == 8 && l == 0)) conv_weights(p, ph == 0 ? 0 : 1, lds, tidx);
}

__global__ void __launch_bounds__(512, 2) k_phase(Params p, int ph) {
    extern __shared__ __attribute__((aligned(16))) unsigned char shm[];
    const int tidx = threadIdx.x;
    run_phase(p, ph, (LAS unsigned char*)shm, tidx, 0);
}

#define XB_TMO      128
#define XB_XCNT(j)  (256  + 64 * (j))
#define XB_XSUB(j)  (1280 + 64 * (j))
#define XB_XGEN(j)  (2304 + 64 * (j))
#define XB_TOP      3328
#define XB_TOPGEN   3392
#define XCD_BAR_WORDS 3456
#define XB_SPIN_CAP (1u << 18)

__device__ __forceinline__ unsigned xb_ld(unsigned* p)              { return __hip_atomic_load(p, __ATOMIC_RELAXED, __HIP_MEMORY_SCOPE_AGENT); }
__device__ __forceinline__ unsigned xb_add(unsigned* p, unsigned v) { return __hip_atomic_fetch_add(p, v, __ATOMIC_RELAXED, __HIP_MEMORY_SCOPE_AGENT); }
__device__ __forceinline__ unsigned xb_xcc_id() { return (unsigned)__builtin_amdgcn_s_getreg((3 << 11) | 20) & 0xFu; }
#define XB_SPIN(cond, bar) do { unsigned _sp = 0; while (cond) { __builtin_amdgcn_s_sleep(1); \
    if ((++_sp & 255u) == 0u) { if (xb_ld(&(bar)[XB_TMO])) break; if (_sp > XB_SPIN_CAP) { atomicAdd(&(bar)[XB_TMO], 1u); break; } } } } while (0)

struct XcdBarrier {
    unsigned* bar; unsigned x;
    volatile LAS unsigned* st;
};

__device__ __forceinline__ XcdBarrier xcd_barrier_post(unsigned* bar, volatile LAS unsigned* st) {
    XcdBarrier b; b.bar = bar; b.x = xb_xcc_id(); b.st = st;
    if (threadIdx.x == 0) (void)xb_add(&bar[XB_XCNT(b.x)], 1u);
    return b;
}
__device__ __forceinline__ void xcd_barrier_complete(unsigned* bar, unsigned x, unsigned& nloc, unsigned& nx) {
    const unsigned G = gridDim.x * gridDim.y * gridDim.z;
    unsigned sum, cnt, mine, sp = 0u;
    for (;;) {
        sum = 0u; cnt = 0u; mine = 0u;
#pragma unroll
        for (unsigned j = 0; j < 16; ++j) { const unsigned c = xb_ld(&bar[XB_XCNT(j)]); sum += c; cnt += (c > 0u) ? 1u : 0u; mine = (j == x) ? c : mine; }
        if (sum == G) break;
        __builtin_amdgcn_s_sleep(1);
        if ((++sp & 255u) == 0u) { if (xb_ld(&bar[XB_TMO])) break; if (sp > XB_SPIN_CAP) { atomicAdd(&bar[XB_TMO], 1u); break; } }
    }
    nloc = mine > 0u ? mine : 1u; nx = cnt > 0u ? cnt : 1u;
}

__device__ __forceinline__ void xcd_barrier(const XcdBarrier& b) {
    asm volatile("s_waitcnt vmcnt(0)" ::: "memory");
    __syncthreads();
    if (threadIdx.x == 0) {
        unsigned* bar = b.bar;
        __builtin_amdgcn_s_waitcnt(0);
        unsigned nloc = b.st[0], nx = b.st[1];
        if (nloc == 0u) { xcd_barrier_complete(bar, b.x, nloc, nx); b.st[0] = nloc; b.st[1] = nx; }
        const unsigned old = xb_add(&bar[XB_XSUB(b.x)], 1u);
        const unsigned gen = old / nloc;
        if (old + 1u == (gen + 1u) * nloc) {
            __builtin_amdgcn_fence(__ATOMIC_RELEASE, "agent");
            asm volatile("s_waitcnt vmcnt(0)" ::: "memory");
            const unsigned og = xb_add(&bar[XB_TOP], 1u);
            const unsigned tg = og / nx;
            if (og + 1u == (tg + 1u) * nx) xb_add(&bar[XB_TOPGEN], 1u);
            else XB_SPIN(xb_ld(&bar[XB_TOPGEN]) == tg, bar);
            __builtin_amdgcn_fence(__ATOMIC_ACQUIRE, "agent");
            xb_add(&bar[XB_XGEN(b.x)], 1u);
            asm volatile("s_waitcnt vmcnt(0)" ::: "memory");
        } else {
            XB_SPIN(xb_ld(&bar[XB_XGEN(b.x)]) == gen, bar);
            __builtin_amdgcn_fence(__ATOMIC_ACQUIRE, "agent");
            asm volatile("s_waitcnt vmcnt(0)" ::: "memory");
        }
    }
    __syncthreads();
}


#ifndef DUPMASK
#define DUPMASK 0
#endif
#if COOP
__global__ void __launch_bounds__(512, 2) k_mega(Params p) {
    extern __shared__ __attribute__((aligned(16))) unsigned char shm[];
    cg::grid_group grid = cg::this_grid();
    unsigned* barw = (unsigned*)(p.ws + OFF_MISC + 1024);
    volatile LAS unsigned* xst = (volatile LAS unsigned*)((LAS unsigned char*)shm + LDS_BYTES);
    if (threadIdx.x < 4) xst[threadIdx.x] = 0u;
    XcdBarrier xb; xb.bar = barw; xb.x = 0; xb.st = xst;
#pragma unroll 1
    for (int ph = 0; ph < NPHASE; ++ph) {
        const int nrep = ((DUPMASK >> ph) & 1) ? 2 : 1;
#pragma unroll 1
        for (int rep = 0; rep < nrep; ++rep) {
            int tidx = threadIdx.x; asm volatile("" : "+v"(tidx));
            run_phase(p, ph, (LAS unsigned char*)shm, tidx, rep);
            if (ph == 0) { grid.sync(); xb = xcd_barrier_post(barw, xst); }
            else if (ph + 1 < NPHASE) xcd_barrier(xb);
        }
#ifdef EXTRA_SYNCS
        if (ph == 1) for (int i = 0; i < EXTRA_SYNCS; ++i) xcd_barrier(xb);
#endif
    }
}
#endif

extern "C" void kernel_launch(void* const* d_in, const int* in_sizes, int n_in, void* d_out, int out_size, void* d_ws, size_t ws_size, hipStream_t stream) {
    static int grid_blocks = 0;
    if (!grid_blocks) {
        int dev = 0, cus = 0, per_cu = 0;
        hipGetDevice(&dev);
        hipDeviceGetAttribute(&cus, hipDeviceAttributeMultiprocessorCount, dev);
        hipFuncSetAttribute((const void*)k_phase, hipFuncAttributeMaxDynamicSharedMemorySize, LDS_TOTAL);
#if COOP
        hipFuncSetAttribute((const void*)k_mega, hipFuncAttributeMaxDynamicSharedMemorySize, LDS_TOTAL);
        hipOccupancyMaxActiveBlocksPerMultiprocessor(&per_cu, (const void*)k_mega, 512, LDS_TOTAL);
#endif
        if (per_cu < 1) per_cu = 1;
        grid_blocks = cus * 1;
        (void)hipGetLastError();
    }
    Params p{};
    for (int i = 0; i < 32; ++i) p.in[i] = (const float*)d_in[i];
    p.out = (float*)d_out; p.ws = (unsigned char*)d_ws;
#if COOP
    void* args[] = {&p};
    hipError_t e = hipLaunchCooperativeKernel((const void*)k_mega, dim3(grid_blocks), dim3(512), args, LDS_TOTAL, stream);
    if (e != hipSuccess) fprintf(stderr, "cooperative launch failed: %s (grid %d)\n", hipGetErrorString(e), grid_blocks);
#else
    for (int ph = 0; ph < NPHASE; ++ph) k_phase<<<dim3(grid_blocks), dim3(512), LDS_TOTAL, stream>>>(p, ph);
#endif
}
```

```cpp
#include <hip/hip_runtime.h>
#include <hip/hip_cooperative_groups.h>
#include <cstdio>
namespace cg = cooperative_groups;

#ifndef COOP
#define COOP 1
#endif
#ifndef DUPITEMS
#define DUPITEMS 15
#endif

#define LAS __attribute__((address_space(3)))
typedef _Float16 h16;
typedef _Float16 h16x4 __attribute__((ext_vector_type(4)));
typedef _Float16 h16x8 __attribute__((ext_vector_type(8)));
typedef float f32x2 __attribute__((ext_vector_type(2)));
typedef float f32x4 __attribute__((ext_vector_type(4)));

constexpr int T_ = 16384, SEQ_ = 2048, DM = 1024, NP = 3840, DFF = 4096, INC = 3716;
constexpr int C_R = 0, C_K = 256, C_V = 512, C_FW = 768, C_VR = 896, C_AQ = 928, C_AK = 1184, C_AV = 1440;
constexpr int C_SZ = 1696, C_SX = 1952, C_SDT = 2720, C_HQ = 2728, C_HF = 2984, C_HI = 3240, C_HG = 3496;
constexpr float ALPHA_ = 1.41421356237f;
constexpr size_t OFF_WIN = 0, OFF_WOUT = 7864320, OFF_WUP = OFF_WOUT + 2097152, OFF_WDN = OFF_WUP + 8388608;
constexpr size_t OFF_X16 = 26738688, OFF_MIX = OFF_X16 + 33554432, OFF_BIG = OFF_MIX + 33554432;
constexpr size_t OFF_VF = OFF_BIG + 134217728, OFF_O2 = OFF_VF + 8388608, OFF_O3 = OFF_O2 + 8388608, OFF_LSE = OFF_O3 + 8388608;
constexpr size_t OFF_MISC = OFF_LSE + 786432;
constexpr int LDS_BYTES = 131072, LDS_TOTAL = 131072 + 64;

struct Params { const float* in[32]; float* out; unsigned char* ws; };

enum { I_X = 0, I_LB, I_WIN, I_WINV, I_MU, I_MUV, I_W0, I_W2, I_A0, I_A2, I_G2, I_KK, I_KA, I_RK, I_LNW, I_LNB, I_V0, I_V2,
       I_CW, I_CB, I_DTB, I_ALOG, I_SD, I_SNW, I_HNW, I_WOUT, I_LN1W, I_LN1B, I_WUP, I_WDN, I_LN2W, I_LN2B };

template <int CTRL> __device__ __forceinline__ float dpp_f(float x) {
    return __builtin_bit_cast(float, __builtin_amdgcn_update_dpp(0, __builtin_bit_cast(int, x), CTRL, 0xF, 0xF, true));
}
__device__ __forceinline__ float sum16(float x) {
    x += dpp_f<0xB1>(x);
    x += dpp_f<0x4E>(x);
    x += dpp_f<0x141>(x);
    x += dpp_f<0x140>(x);
    return x;
}
__device__ __forceinline__ float sum64(float x) { x = sum16(x); x += __shfl_xor(x, 16); x += __shfl_xor(x, 32); return x; }
__device__ __forceinline__ float sigmoidf_(float x) { return 1.0f / (1.0f + __expf(-x)); }
__device__ __forceinline__ float siluf_(float x) { return x / (1.0f + __expf(-x)); }
__device__ __forceinline__ float softplusf_(float x) { return fmaxf(x, 0.f) + log1pf(__expf(-fabsf(x))); }
__device__ __forceinline__ f32x4 h4f(h16x4 v) { return (f32x4){(float)v[0], (float)v[1], (float)v[2], (float)v[3]}; }
__device__ __forceinline__ h16x4 f4h(f32x4 v) { return (h16x4){(h16)v[0], (h16)v[1], (h16)v[2], (h16)v[3]}; }

namespace pg8 {
constexpr int BM = 256, BK = 64, HALF = 128, HTB = HALF * BK * 2, STAGE_BYTES = 8 * HTB, NXCD = 8, WGM = 8;
__host__ __device__ __forceinline__ int lds_byte(int r, int c) { const int st = (r >> 4) * 2 + (c >> 5), rr = r & 15, cc = c & 31, ob = rr * 64 + cc * 2; return st * 1024 + (ob ^ (((ob >> 9) & 1) << 5)); }
__host__ __device__ __forceinline__ void stage_rc(int b, int& R, int& C) { const int st = b / 1024, sb = b % 1024, swz = sb ^ (((sb >> 9) & 1) << 5); R = (st >> 1) * 16 + swz / 64; C = (st & 1) * 32 + (swz % 64) / 2; }
__host__ __device__ __forceinline__ int perm32(int rho) { const int n = rho >> 4, i = rho & 15; return 8 * (i >> 2) + 4 * n + (i & 3); }
struct Unit { int pm, pn; };
struct Gemm { const h16* A; const h16* Bt; int M, N, K; };
struct StaticOrder {
    int nM, nN, nwg, G, c;
    __device__ void init(int M, int N, int G_, int c_) { nM = M / BM; nN = N / BM; nwg = nM * nN; G = G_; c = c_; }
    __device__ bool next(int i, Unit& u) const {
        const long L = (long)i * G + c; if (L >= nwg) return false;
        int wgid = (int)L; { const int q = nwg / NXCD, r = nwg % NXCD, xcd = wgid % NXCD, off = wgid / NXCD; wgid = (xcd < r ? xcd * (q + 1) : r * (q + 1) + (xcd - r) * q) + off; }
        const int nig = WGM * nN, gid = wgid / nig, fm = gid * WGM, gsz = (nM - fm) < WGM ? (nM - fm) : WGM;
        u.pm = fm + ((wgid % nig) % gsz); u.pn = (wgid % nig) / gsz; return true;
    }
};
struct EpiH {
    h16* O; int ldc; int MODE;
    __device__ __forceinline__ void operator()(const f32x4 (&acc)[2][2][4][2], const Unit& u, int wr, int wc, int fr, int fq) const {
        const int row0 = u.pm * BM + wr * 64 + fr, col0 = u.pn * BM + wc * 32 + 8 * fq;
#pragma unroll
        for (int ai = 0; ai < 2; ++ai)
#pragma unroll
            for (int m = 0; m < 4; ++m) { h16* rowp = O + (size_t)(row0 + ai * HALF + m * 16) * ldc + col0;
#pragma unroll
                for (int bj = 0; bj < 2; ++bj) { f32x4 v0 = acc[ai][bj][m][0], v1 = acc[ai][bj][m][1];
                    if (MODE == 1) {
#pragma unroll
                        for (int j = 0; j < 4; ++j) { float a = fmaxf(v0[j], 0.f), b = fmaxf(v1[j], 0.f); v0[j] = a * a; v1[j] = b * b; } }
                    if (MODE == 2) { const h16x8 x = *(const h16x8*)(rowp + bj * HALF);
#pragma unroll
                        for (int j = 0; j < 4; ++j) { v0[j] += ALPHA_ * (float)x[j]; v1[j] += ALPHA_ * (float)x[4 + j]; } }
                    h16x8 w;
#pragma unroll
                    for (int j = 0; j < 4; ++j) { w[j] = (h16)v0[j]; w[4 + j] = (h16)v1[j]; }
                    *(h16x8*)(rowp + bj * HALF) = w; } }
    }
};

template <class Epi>
__device__ __forceinline__ void gemm_phase(LAS unsigned char* lds, const Gemm g, const StaticOrder& S, const Epi& E, const int tidx) {
    const int tid = tidx, wid = __builtin_amdgcn_readfirstlane(tid >> 6), lane = tid & 63, wr = wid >> 2, wc = wid & 3, fr = lane & 15, fq = lane >> 4;
    const int K = g.K, nt = K / BK;
    unsigned voffA[2], voffB[2];
#pragma unroll
    for (int i = 0; i < 2; ++i) { int R, C; stage_rc(tid * 16 + i * 8192, R, C); const int Rb = (R & ~31) + perm32(R & 31);
        voffA[i] = (unsigned)(R * K + C) * 2u; voffB[i] = (unsigned)(Rb * K + C) * 2u; }
    const size_t kstep = (size_t)(BK * 2);
    const size_t hstep = (size_t)HALF * K * 2;
    const size_t tstep = 2 * hstep;
    const unsigned ldsw = (unsigned)wid * 1024u;
    const int aoff = lds_byte(wr * 64 + fr, fq * 8), boff = lds_byte(wc * 32 + fr, fq * 8);
#define PG8_SA(b, h) (((b) * 2 + (h)) * HTB)
#define PG8_SB(b, h) ((4 + (b) * 2 + (h)) * HTB)
#define PG8_STAGE(bufoff, gbase, voff) do { _Pragma("unroll") for (int _i = 0; _i < 2; ++_i) \
        __builtin_amdgcn_global_load_lds((const unsigned*)((const char*)(gbase) + (voff)[_i]), (LAS unsigned*)(lds + (bufoff) + ldsw + _i * 8192), 16, 0, 0); } while (0)
#define PG8_LDA(dst, b, h) do { _Pragma("unroll") for (int m = 0; m < 4; ++m) _Pragma("unroll") for (int k = 0; k < 2; ++k) dst[m][k] = *(const LAS h16x8*)(lds + PG8_SA(b, h) + aoff + m * 2048 + k * 1024); } while (0)
#define PG8_LDB(dst, b, h) do { _Pragma("unroll") for (int n = 0; n < 2; ++n) _Pragma("unroll") for (int k = 0; k < 2; ++k) dst[n][k] = *(const LAS h16x8*)(lds + PG8_SB(b, h) + boff + n * 2048 + k * 1024); } while (0)
#define PG8_MMA(ai, bj, At, Bt) do { __builtin_amdgcn_s_setprio(1); _Pragma("unroll") for (int m = 0; m < 4; ++m) _Pragma("unroll") for (int n = 0; n < 2; ++n) _Pragma("unroll") for (int k = 0; k < 2; ++k) \
        acc[ai][bj][m][n] = __builtin_amdgcn_mfma_f32_16x16x32_f16(Bt[n][k], At[m][k], acc[ai][bj][m][n], 0, 0, 0); __builtin_amdgcn_s_setprio(0); } while (0)
#define PG8_WAIT_V(n) asm volatile("s_waitcnt vmcnt(" #n ")" ::: "memory")
#define PG8_WAIT_L(n) asm volatile("s_waitcnt lgkmcnt(" #n ")" ::: "memory")
#define PG8_BAR __builtin_amdgcn_s_barrier()
#define PG8_SCHED __builtin_amdgcn_sched_barrier(0)
    Unit cur, nxt; int ui = 0;
    if (!S.next(0, cur)) return;
    f32x4 acc[2][2][4][2];
#pragma unroll
    for (int a = 0; a < 2; ++a)
#pragma unroll
        for (int b = 0; b < 2; ++b)
#pragma unroll
            for (int m = 0; m < 4; ++m)
#pragma unroll
                for (int n = 0; n < 2; ++n) acc[a][b][m][n] = (f32x4){0.f, 0.f, 0.f, 0.f};
    h16x8 At[4][2], B0[2][2], B1[2][2];
    const char* cA = (const char*)g.A + (size_t)cur.pm * tstep; const char* cB = (const char*)g.Bt + (size_t)cur.pn * tstep;
    PG8_STAGE(PG8_SB(0, 0), cB, voffB); PG8_STAGE(PG8_SA(0, 0), cA, voffA); PG8_STAGE(PG8_SB(0, 1), cB + hstep, voffB); PG8_STAGE(PG8_SA(0, 1), cA + hstep, voffA);
    if (wr == 1) PG8_BAR;
    PG8_WAIT_V(4); PG8_BAR;
    PG8_STAGE(PG8_SB(1, 0), cB + kstep, voffB); PG8_STAGE(PG8_SA(1, 0), cA + kstep, voffA); PG8_STAGE(PG8_SB(1, 1), cB + hstep + kstep, voffB);
    PG8_WAIT_V(6); PG8_BAR;
    for (;;) {
        const bool has_next = S.next(ui + 1, nxt);
        const char* nA = has_next ? (const char*)g.A + (size_t)nxt.pm * tstep : cA; const char* nB = has_next ? (const char*)g.Bt + (size_t)nxt.pn * tstep : cB;
        for (int t = 0; t < nt; t += 2) {
            const bool last = (t == nt - 2);
            const char* a1 = cA + (size_t)(t + 1) * kstep;
            const char* a2 = last ? nA : cA + (size_t)(t + 2) * kstep; const char* b2 = last ? nB : cB + (size_t)(t + 2) * kstep;
            const char* a3 = a2 + kstep; const char* b3 = b2 + kstep;
            PG8_LDB(B0, 0, 0); PG8_SCHED; PG8_LDA(At, 0, 0); PG8_STAGE(PG8_SA(1, 1), a1 + hstep, voffA);
            PG8_WAIT_L(8); PG8_BAR; PG8_WAIT_L(0); PG8_MMA(0, 0, At, B0); PG8_BAR; PG8_SCHED;
            PG8_LDB(B1, 0, 1); PG8_STAGE(PG8_SB(0, 0), b2, voffB);
            PG8_BAR; PG8_WAIT_L(0); PG8_MMA(0, 1, At, B1); PG8_BAR;
            PG8_LDA(At, 0, 1); PG8_STAGE(PG8_SA(0, 0), a2, voffA);
            PG8_BAR; PG8_WAIT_L(0); PG8_MMA(1, 0, At, B0); PG8_BAR; PG8_SCHED;
            PG8_STAGE(PG8_SB(0, 1), b2 + hstep, voffB);
            PG8_WAIT_V(6); PG8_BAR; PG8_MMA(1, 1, At, B1); PG8_BAR;
            PG8_LDB(B0, 1, 0); PG8_SCHED; PG8_LDA(At, 1, 0); PG8_STAGE(PG8_SA(0, 1), a2 + hstep, voffA);
            PG8_WAIT_L(8); PG8_BAR; PG8_WAIT_L(0); PG8_MMA(0, 0, At, B0); PG8_BAR; PG8_SCHED;
            PG8_LDB(B1, 1, 1); PG8_STAGE(PG8_SB(1, 0), b3, voffB);
            PG8_BAR; PG8_WAIT_L(0); PG8_MMA(0, 1, At, B1); PG8_BAR;
            PG8_LDA(At, 1, 1); PG8_STAGE(PG8_SA(1, 0), a3, voffA);
            PG8_BAR; PG8_WAIT_L(0); PG8_MMA(1, 0, At, B0); PG8_BAR; PG8_SCHED;
            PG8_STAGE(PG8_SB(1, 1), b3 + hstep, voffB);
            PG8_WAIT_V(6); PG8_BAR; PG8_MMA(1, 1, At, B1); PG8_BAR;
        }
        E(acc, cur, wr, wc, fr, fq);
        if (!has_next) break;
#pragma unroll
        for (int a = 0; a < 2; ++a)
#pragma unroll
            for (int b = 0; b < 2; ++b)
#pragma unroll
                for (int m = 0; m < 4; ++m)
#pragma unroll
                    for (int n = 0; n < 2; ++n) acc[a][b][m][n] = (f32x4){0.f, 0.f, 0.f, 0.f};
        cur = nxt; cA = nA; cB = nB; ++ui;
    }
    PG8_WAIT_V(0);
    if (wr == 0) PG8_BAR;
    PG8_BAR;
#undef PG8_SA
#undef PG8_SB
#undef PG8_STAGE
#undef PG8_LDA
#undef PG8_LDB
#undef PG8_MMA
#undef PG8_WAIT_V
#undef PG8_WAIT_L
#undef PG8_BAR
#undef PG8_SCHED
}
}

__device__ __forceinline__ void run_gemm(LAS unsigned char* lds, const h16* A, const h16* Bt, int N, int K, h16* O, int ldc, int mode, const int tidx) {
    pg8::Gemm g; g.A = A; g.Bt = Bt; g.M = T_; g.N = N; g.K = K;
    pg8::StaticOrder S; S.init(T_, N, (int)gridDim.x, (int)blockIdx.x);
    pg8::EpiH E; E.O = O; E.ldc = ldc; E.MODE = mode;
    pg8::gemm_phase(lds, g, S, E, tidx);
}

__device__ __forceinline__ void conv_weights(const Params& p, int l, LAS unsigned char* lds, const int tidx) {
    LAS float* tile = (LAS float*)lds;
    const int tid = tidx;
    for (int id = blockIdx.x; id < 3264; id += gridDim.x) {
        int mat, tl;
        if (id < 960) { mat = 0; tl = id; } else if (id < 1216) { mat = 1; tl = id - 960; } else if (id < 2240) { mat = 2; tl = id - 1216; } else { mat = 3; tl = id - 2240; }
        const int K = (mat == 3) ? 4096 : 1024;
        const int nkt = K / 64;
        const int n0 = (tl / nkt) * 64, k0 = (tl % nkt) * 64;
        h16* dst = (h16*)(p.ws + (mat == 0 ? OFF_WIN : mat == 1 ? OFF_WOUT : mat == 2 ? OFF_WUP : OFF_WDN));
        __syncthreads();
        {
            const int nj = tid & 63, n = n0 + nj;
            const float* src = nullptr; int sstride = 0;
            if (mat == 0) {
                if (n < 896) { src = p.in[I_WIN] + (size_t)l * DM * INC + n; sstride = INC; }
                else if (n < 928) { if (l > 0) { src = p.in[I_WINV] + (size_t)(l - 1) * DM * 32 + (n - 896); sstride = 32; } }
                else if (n < 2724) { src = p.in[I_WIN] + (size_t)l * DM * INC + (n - 32); sstride = INC; }
                else if (n < 2728) { }
                else if (n < 3752) { src = p.in[I_WIN] + (size_t)l * DM * INC + (n - 36); sstride = INC; }
            } else if (mat == 1) { src = p.in[I_WOUT] + (size_t)l * 1024 * 1024 + n; sstride = 1024; }
            else if (mat == 2) { src = p.in[I_WUP] + (size_t)l * 1024 * 4096 + n; sstride = 4096; }
            else { src = p.in[I_WDN] + (size_t)l * 4096 * 1024 + n; sstride = 1024; }
#pragma unroll
            for (int i = 0; i < 8; ++i) { const int ki = (tid >> 6) + 8 * i; tile[ki * 65 + nj] = src ? src[(size_t)(k0 + ki) * sstride] : 0.f; }
        }
        __syncthreads();
        {
            const int ki = tid & 63;
#pragma unroll
            for (int i = 0; i < 8; ++i) { const int nj = (tid >> 6) + 8 * i; dst[(size_t)(n0 + nj) * K + k0 + ki] = (h16)tile[ki * 65 + nj]; }
        }
    }
    __syncthreads();
}

__device__ __forceinline__ void conv_x(const Params& p, const int tidx) {
    const f32x4* src = (const f32x4*)p.in[I_X]; h16x4* dst = (h16x4*)(p.ws + OFF_X16);
    for (size_t i = (size_t)blockIdx.x * 512 + tidx; i < (size_t)T_ * DM / 4; i += (size_t)gridDim.x * 512) dst[i] = f4h(src[i]);
}

__device__ __forceinline__ void pre_phase(const Params& p, int l, LAS unsigned char* lds, const int tidx) {
    LAS float* act = (LAS float*)lds;
    const h16* proj = (const h16*)(p.ws + OFF_BIG);
    h16* prep = (h16*)p.out;
    h16* vfirst = (h16*)(p.ws + OFF_VF);
    const int tid = tidx;
    const int c = tid & 255, hf = tid >> 8, hh = c >> 6;
    const int nact = (l == 0) ? 128 : 160;
    const float mu_r = p.in[I_MU][l * 896 + c], mu_k = p.in[I_MU][l * 896 + 256 + c], mu_v = p.in[I_MU][l * 896 + 512 + c];
    const float w0 = p.in[I_W0][l * 256 + c], a0 = p.in[I_A0][l * 256 + c], k_k = p.in[I_KK][l * 256 + c], k_a = p.in[I_KA][l * 256 + c];
    const float r_k = p.in[I_RK][l * 256 + c], lnw = p.in[I_LNW][l * 256 + c], lnb = p.in[I_LNB][l * 256 + c];
    const float v0 = (l > 0) ? p.in[I_V0][(l - 1) * 256 + c] : 0.f;
    LAS h16* wts = (LAS h16*)(lds + 40960);
    __syncthreads();
#pragma unroll 1
    for (int e0 = 0; e0 < nact * 256; e0 += 512 * 16) {
        float wv16[16];
#pragma unroll
        for (int u = 0; u < 16; ++u) {
            const int e = e0 + u * 512 + tid, i = e >> 8, cc = e & 255;
            const float* sp;
            if (i < 32) sp = p.in[I_W2] + (size_t)(l * 32 + i) * 256 + cc;
            else if (i < 64) sp = p.in[I_A2] + (size_t)(l * 32 + i - 32) * 256 + cc;
            else if (i < 128) sp = p.in[I_G2] + (size_t)(l * 64 + i - 64) * 256 + cc;
            else sp = p.in[I_V2] + (size_t)((l - 1) * 32 + i - 128) * 256 + cc;
            wv16[u] = *sp;
        }
#pragma unroll
        for (int u = 0; u < 16; ++u) wts[e0 + u * 512 + tid] = (h16)wv16[u];
    }
    for (int tt = blockIdx.x; tt < T_ / 64; tt += gridDim.x) {
        const int t0 = tt * 64;
        __syncthreads();
#pragma unroll 1
        for (int eb = 0; eb < 20; eb += 10) {
            float curv[10], prvv[10];
#pragma unroll
            for (int u = 0; u < 10; ++u) {
                const int e = (eb + u) * 512 + tid, tok = e / 160, i = e - tok * 160, t = t0 + tok;
                curv[u] = 0.f; prvv[u] = 0.f;
                if (i < nact) {
                    curv[u] = (float)proj[(size_t)t * NP + C_FW + i];
                    if (t & (SEQ_ - 1)) prvv[u] = (float)proj[(size_t)(t - 1) * NP + C_FW + i];
                }
            }
#pragma unroll
            for (int u = 0; u < 10; ++u) {
                const int e = (eb + u) * 512 + tid, tok = e / 160, i = e - tok * 160;
                if (i < nact) {
                    const float mu = (i < 128) ? p.in[I_MU][l * 896 + 768 + i] : p.in[I_MUV][(l - 1) * 32 + (i - 128)];
                    const float f = curv[u] + (prvv[u] - curv[u]) * mu;
                    float a = f;
                    if (i < 32) a = tanhf(f); else if (i >= 64 && i < 128) a = sigmoidf_(f);
                    act[i * 64 + tok] = a;
                }
            }
        }
        __syncthreads();
#pragma unroll 1
        for (int grp = 0; grp < 2; ++grp) {
            const int tb = hf * 32 + grp * 16;
            float aw[16], aa[16], ag[16], av[16];
#pragma unroll
            for (int j = 0; j < 16; ++j) { aw[j] = 0.f; aa[j] = 0.f; ag[j] = 0.f; av[j] = 0.f; }
#pragma unroll 4
            for (int i = 0; i < 32; ++i) {
                const float ww = (float)wts[i * 256 + c], wa = (float)wts[(32 + i) * 256 + c];
                const LAS f32x4* r1 = (const LAS f32x4*)(act + i * 64 + tb);
                const LAS f32x4* r2 = (const LAS f32x4*)(act + (32 + i) * 64 + tb);
#pragma unroll
                for (int q = 0; q < 4; ++q) { const f32x4 x = r1[q], y = r2[q];
#pragma unroll
                    for (int j = 0; j < 4; ++j) { aw[4 * q + j] += x[j] * ww; aa[4 * q + j] += y[j] * wa; } }
            }
#pragma unroll 4
            for (int i = 0; i < 64; ++i) {
                const float wg = (float)wts[(64 + i) * 256 + c];
                const LAS f32x4* r1 = (const LAS f32x4*)(act + (64 + i) * 64 + tb);
#pragma unroll
                for (int q = 0; q < 4; ++q) { const f32x4 x = r1[q];
#pragma unroll
                    for (int j = 0; j < 4; ++j) ag[4 * q + j] += x[j] * wg; }
            }
            if (l > 0) {
#pragma unroll 4
                for (int i = 0; i < 32; ++i) {
                    const float wv = (float)wts[(128 + i) * 256 + c];
                    const LAS f32x4* r1 = (const LAS f32x4*)(act + (128 + i) * 64 + tb);
#pragma unroll
                    for (int q = 0; q < 4; ++q) { const f32x4 x = r1[q];
#pragma unroll
                        for (int j = 0; j < 4; ++j) av[4 * q + j] += x[j] * wv; }
                }
            }
#pragma unroll
            for (int jb = 0; jb < 16; jb += 8) {
            h16 lr[8], lk[8], lv[8], lpr[8], lpk[8], lpv[8], lvf[8];
#pragma unroll
            for (int u = 0; u < 8; ++u) {
                const int t = t0 + tb + jb + u;
                const h16* row = proj + (size_t)t * NP;
                lr[u] = row[C_R + c]; lk[u] = row[C_K + c]; lv[u] = row[C_V + c];
                lpr[u] = (h16)0.f; lpk[u] = (h16)0.f; lpv[u] = (h16)0.f; lvf[u] = (h16)0.f;
                if (t & (SEQ_ - 1)) { lpr[u] = row[C_R + c - NP]; lpk[u] = row[C_K + c - NP]; lpv[u] = row[C_V + c - NP]; }
                if (l > 0) lvf[u] = vfirst[(size_t)t * 256 + c];
            }
#pragma unroll
            for (int u = 0; u < 8; ++u) {
                const int j = jb + u;
                const int t = t0 + tb + j;
                float r = (float)lr[u], k = (float)lk[u], v = (float)lv[u];
                const float pr = (float)lpr[u], pk = (float)lpk[u], pv = (float)lpv[u];
                r += (pr - r) * mu_r; k += (pk - k) * mu_k; v += (pv - v) * mu_v;
                const float wl = w0 + aw[j];
                const float wlog = -softplusf_(-wl) - 0.5f;
                const float ee = __expf(wlog);
                const float a = sigmoidf_(a0 + aa[j]);
                if (l == 0) vfirst[(size_t)t * 256 + c] = (h16)v;
                else { const float vf = (float)lvf[u]; v += (vf - v) * sigmoidf_(v0 + av[j]); }
                const float kkr = k * k_k;
                const float nrm = sqrtf(sum64(kkr * kkr));
                const float kk = kkr / fmaxf(nrm, 1e-12f);
                const float kp = k * (1.0f + (a - 1.0f) * k_a);
                const float bb = kk * a;
                const float bonus = sum64(r * kp * r_k);
                const float g = ag[j];
                h16* o = prep + (size_t)t * 2048 + c;
                o[0] = (h16)r; o[256] = (h16)ee; o[512] = (h16)kp; o[768] = (h16)kk; o[1024] = (h16)bb; o[1280] = (h16)v;
                o[1536] = (h16)(lnw * g); o[1792] = (h16)((lnb + bonus * v) * g);
            }
            }
        }
    }
    __syncthreads();
    (void)hh;
}

constexpr int CH = 32;

__device__ __forceinline__ float dot4(f32x4 a, f32x4 b) { f32x2 p = (f32x2){a[0], a[1]} * (f32x2){b[0], b[1]}; p = __builtin_elementwise_fma((f32x2){a[2], a[3]}, (f32x2){b[2], b[3]}, p); return p[0] + p[1]; }
__device__ __forceinline__ void plain_write_y(h16* mix, int t0, int col, LAS unsigned char* ybuf, int lt) {
    const int tok = lt >> 3, r8 = lt & 7;
    const f32x4 y = *(const LAS f32x4*)(ybuf + (tok * 32 + r8 * 4) * 4);
    *(h16x4*)(mix + (size_t)(t0 + tok) * DM + col + r8 * 4) = f4h(y);
}

constexpr int RW_SH = 0, RW_VB = CH * 16 * 20 * 4, RW_YB = RW_VB + CH * 32 * 4, RW_STRIDE = RW_YB + CH * 32 * 4;
__device__ __forceinline__ void rwkv_load(const h16* prep, int t0, int h, int rowbase, LAS unsigned char* buf, int lt) {
    LAS float* sh = (LAS float*)(buf + RW_SH);
    h16x4 raw[10];
#pragma unroll
    for (int i = 0; i < 10; ++i) {
        const int e = i * 256 + lt, tok = e / 80, rem = e - tok * 80, vec = rem >> 4, sub = rem & 15;
        const int pv = (vec == 0) ? 3 : (vec == 1) ? 1 : (vec == 2) ? 4 : (vec == 3) ? 2 : 0;
        raw[i] = *(const h16x4*)(prep + (size_t)(t0 + tok) * 2048 + pv * 256 + h * 64 + sub * 4);
    }
    const int tokv = lt >> 3, r8 = lt & 7;
    const h16x4 rv = *(const h16x4*)(prep + (size_t)(t0 + tokv) * 2048 + 5 * 256 + rowbase + r8 * 4);
#pragma unroll
    for (int i = 0; i < 10; ++i) {
        const int e = i * 256 + lt, tok = e / 80, rem = e - tok * 80, vec = rem >> 4, sub = rem & 15;
        f32x4 f = h4f(raw[i]);
        if (vec == 1) { f[0] = __expf(-f[0]); f[1] = __expf(-f[1]); f[2] = __expf(-f[2]); f[3] = __expf(-f[3]); }
        *(LAS f32x4*)(sh + ((tok * 16 + sub) * 5 + vec) * 4) = f;
    }
    *(LAS f32x4*)(buf + RW_VB + (tokv * 32 + r8 * 4) * 4) = h4f(rv);
}
__device__ __forceinline__ void rwkv_scan(const Params& p, int item, LAS unsigned char* lds, const int tidx) {
    const int b = item >> 3, h = (item >> 1) & 3, q2 = item & 1;
    const int tid = tidx, wid = tid >> 6, lane = tid & 63, lt = tid - 256;
    const h16* prep = (const h16*)p.out;
    h16* mix = (h16*)(p.ws + OFF_MIX);
    const int rowbase = h * 64 + q2 * 32, tb = b * SEQ_;
    const bool loader = wid >= 4;
    const int rowl = (wid & 3) * 4 + (lane >> 4), sub = lane & 15;
    LAS float* dump = (LAS float*)(lds + LDS_BYTES - 8192) + tid;
    f32x4 Sa = {0.f, 0.f, 0.f, 0.f}, Sb = {0.f, 0.f, 0.f, 0.f};
    __syncthreads();
    if (loader) rwkv_load(prep, tb, h, rowbase, lds, lt);
    __syncthreads();
#pragma unroll 1
    for (int c = 0; c < SEQ_ / CH; ++c) {
        LAS unsigned char* buf = lds + (c & 1) * RW_STRIDE;
        if (loader) {
            if (c + 1 < SEQ_ / CH) rwkv_load(prep, tb + (c + 1) * CH, h, rowbase, lds + ((c + 1) & 1) * RW_STRIDE, lt);
            if (c > 0) plain_write_y(mix, tb + (c - 1) * CH, rowbase, lds + ((c - 1) & 1) * RW_STRIDE + RW_YB, lt);
        } else {
            const LAS float* sh = (const LAS float*)(buf + RW_SH);
            const LAS float* vb = (const LAS float*)(buf + RW_VB);
            LAS float* yb = (LAS float*)(buf + RW_YB);
            const LAS f32x4* q0 = (const LAS f32x4*)(sh + sub * 20);
            f32x4 nkk = q0[0], nw = q0[1], nbb = q0[2], nk = q0[3], nr = q0[4];
            float nva = vb[rowl], nvb = vb[rowl + 16];
#pragma unroll 4
            for (int s = 0; s < CH; ++s) {
                const f32x4 kk = nkk, w = nw, bb = nbb, k = nk, r = nr;
                const float va = nva, vbb = nvb;
                const LAS f32x4* q = (const LAS f32x4*)(sh + ((s + 1) * 16 + sub) * 20);
                nkk = q[0]; nw = q[1]; nbb = q[2]; nk = q[3]; nr = q[4];
                nva = vb[(s + 1) * 32 + rowl]; nvb = vb[(s + 1) * 32 + rowl + 16];
                const float da = sum16(dot4(Sa, kk)), db = sum16(dot4(Sb, kk));
                Sa = Sa * w + (k * va - bb * da);
                Sb = Sb * w + (k * vbb - bb * db);
                const float ya = sum16(dot4(Sa, r)), yb2 = sum16(dot4(Sb, r));
                LAS float* wp = (sub == 0) ? (yb + s * 32 + rowl) : dump;
                wp[0] = ya; wp[16] = yb2;
            }
        }
        __syncthreads();
    }
    if (loader) plain_write_y(mix, tb + (SEQ_ / CH - 1) * CH, rowbase, lds + ((SEQ_ / CH - 1) & 1) * RW_STRIDE + RW_YB, lt);
}

constexpr int HG_SH = 0, HG_VB = CH * 16 * 12 * 4, HG_YB = HG_VB + CH * 32 * 4, HG_STRIDE = HG_YB + CH * 32 * 4;
__device__ __forceinline__ void hgrn_load(const h16* proj, int t0, int h, int rowbase, f32x4 lb, LAS unsigned char* buf, int lt) {
    LAS float* sh = (LAS float*)(buf + HG_SH);
    h16x4 rq[2], rf[2];
#pragma unroll
    for (int i = 0; i < 2; ++i) {
        const int e = i * 256 + lt, tok = e >> 4, sub = e & 15;
        const h16* row = proj + (size_t)(t0 + tok) * NP + h * 64 + sub * 4;
        rq[i] = *(const h16x4*)(row + C_HQ); rf[i] = *(const h16x4*)(row + C_HF);
    }
    const int tokv = lt >> 3, r8 = lt & 7;
    const h16x4 rv = *(const h16x4*)(proj + (size_t)(t0 + tokv) * NP + C_HI + rowbase + r8 * 4);
#pragma unroll
    for (int i = 0; i < 2; ++i) {
        const int e = i * 256 + lt, tok = e >> 4, sub = e & 15;
        const f32x4 qv = h4f(rq[i]), fv = h4f(rf[i]);
        f32x4 fo, ko, qo;
#pragma unroll
        for (int j = 0; j < 4; ++j) { const float fg = lb[j] + (1.0f - lb[j]) * sigmoidf_(fv[j]); fo[j] = fg; ko[j] = 1.0f - fg; qo[j] = siluf_(qv[j]); }
        LAS f32x4* d = (LAS f32x4*)(sh + (tok * 16 + sub) * 12);
        d[0] = fo; d[1] = ko; d[2] = qo;
    }
    *(LAS f32x4*)(buf + HG_VB + (tokv * 32 + r8 * 4) * 4) = h4f(rv);
}
__device__ __forceinline__ void hgrn_scan(const Params& p, int l, int item, LAS unsigned char* lds, const int tidx) {
    const int b = item >> 3, h = (item >> 1) & 3, q2 = item & 1;
    const int tid = tidx, wid = tid >> 6, lane = tid & 63, lt = tid - 256;
    const h16* proj = (const h16*)(p.ws + OFF_BIG);
    h16* mix = (h16*)(p.ws + OFF_MIX);
    const int rowbase = h * 64 + q2 * 32, tb = b * SEQ_;
    const bool loader = wid >= 4;
    const int rowl = (wid & 3) * 4 + (lane >> 4), sub = lane & 15;
    LAS float* dump = (LAS float*)(lds + LDS_BYTES - 8192) + tid;
    f32x4 lb = {0.f, 0.f, 0.f, 0.f};
    if (l > 0) {
#pragma unroll
        for (int j = 0; j < 4; ++j) { const int ch = h * 64 + (lt & 15) * 4 + j; lb[j] = sigmoidf_(p.in[I_LB][256 + ch] - p.in[I_LB][ch]); }
    }
    f32x4 Sa = {0.f, 0.f, 0.f, 0.f}, Sb = {0.f, 0.f, 0.f, 0.f};
    __syncthreads();
    if (loader) hgrn_load(proj, tb, h, rowbase, lb, lds, lt);
    __syncthreads();
#pragma unroll 1
    for (int c = 0; c < SEQ_ / CH; ++c) {
        LAS unsigned char* buf = lds + (c & 1) * HG_STRIDE;
        if (loader) {
            if (c + 1 < SEQ_ / CH) hgrn_load(proj, tb + (c + 1) * CH, h, rowbase, lb, lds + ((c + 1) & 1) * HG_STRIDE, lt);
            if (c > 0) plain_write_y(mix, tb + (c - 1) * CH, 768 + rowbase, lds + ((c - 1) & 1) * HG_STRIDE + HG_YB, lt);
        } else {
            const LAS float* sh = (const LAS float*)(buf + HG_SH);
            const LAS float* vb = (const LAS float*)(buf + HG_VB);
            LAS float* yb = (LAS float*)(buf + HG_YB);
            const LAS f32x4* q0 = (const LAS f32x4*)(sh + sub * 12);
            f32x4 nf = q0[0], nk = q0[1], nq = q0[2];
            float nva = vb[rowl], nvb = vb[rowl + 16];
#pragma unroll 4
            for (int s = 0; s < CH; ++s) {
                const f32x4 f = nf, k = nk, qq = nq;
                const float va = nva, vbb = nvb;
                const LAS f32x4* q = (const LAS f32x4*)(sh + ((s + 1) * 16 + sub) * 12);
                nf = q[0]; nk = q[1]; nq = q[2];
                nva = vb[(s + 1) * 32 + rowl]; nvb = vb[(s + 1) * 32 + rowl + 16];
                Sa = Sa * f + k * va; Sb = Sb * f + k * vbb;
                const float ya = sum16(dot4(Sa, qq)), yb2 = sum16(dot4(Sb, qq));
                LAS float* wp = (sub == 0) ? (yb + s * 32 + rowl) : dump;
                wp[0] = ya; wp[16] = yb2;
            }
        }
        __syncthreads();
    }
    if (loader) plain_write_y(mix, tb + (SEQ_ / CH - 1) * CH, 768 + rowbase, lds + ((SEQ_ / CH - 1) & 1) * HG_STRIDE + HG_YB, lt);
}

constexpr int SD_SH = 0, SD_XDT = CH * 16 * 16 * 4, SD_XS = SD_XDT + CH * 32 * 4, SD_AB = SD_XS + CH * 32 * 4, SD_YB = SD_AB + CH * 4, SD_STRIDE = SD_YB + CH * 32 * 4;
struct SsdW { f32x4 w[4], b; };
__device__ __forceinline__ SsdW ssd_wload(const Params& p, int l, int ch) {
    SsdW r; const float* cw = p.in[I_CW] + (size_t)l * 4 * 768 + ch;
#pragma unroll
    for (int j = 0; j < 4; ++j) r.w[j] = *(const f32x4*)(cw + j * 768);
    r.b = *(const f32x4*)(p.in[I_CB] + l * 768 + ch);
    return r;
}
__device__ __forceinline__ f32x4 silu4(f32x4 a) { f32x4 o; o[0] = siluf_(a[0]); o[1] = siluf_(a[1]); o[2] = siluf_(a[2]); o[3] = siluf_(a[3]); return o; }
__device__ __forceinline__ void ssd_load(const h16* proj, int t0, int h, const SsdW& wbc, int chbc, const SsdW& wxs, int chxs, float dtb, float Ah, LAS unsigned char* buf, int lt) {
    LAS float* sh = (LAS float*)(buf + SD_SH);
    const int gi = lt & 63, tq = lt >> 6, vec = gi >> 5, gj = gi & 31;
    const int tA = t0 + tq * 8, posA = tA & (SEQ_ - 1);
    h16x4 rows[11];
#pragma unroll
    for (int j = 0; j < 11; ++j) rows[j] = (posA - 3 + j >= 0) ? *(const h16x4*)(proj + (size_t)(tA - 3 + j) * NP + C_SX + chbc) : (h16x4){(h16)0.f, (h16)0.f, (h16)0.f, (h16)0.f};
    const int tokx = lt >> 3, r8 = lt & 7, tX = t0 + tokx, posX = tX & (SEQ_ - 1);
    h16x4 rx[4];
#pragma unroll
    for (int j = 0; j < 4; ++j) rx[j] = (posX - 3 + j >= 0) ? *(const h16x4*)(proj + (size_t)(tX - 3 + j) * NP + C_SX + chxs) : (h16x4){(h16)0.f, (h16)0.f, (h16)0.f, (h16)0.f};
    const float dtraw = (float)proj[(size_t)tX * NP + C_SDT + h];
#pragma unroll
    for (int j = 0; j < 8; ++j) {
        f32x4 acc = wbc.b;
#pragma unroll
        for (int k = 0; k < 4; ++k) acc += h4f(rows[j + k]) * wbc.w[k];
        *(LAS f32x4*)(sh + ((tq * 8 + j) * 16 + (gj >> 1)) * 16 + vec * 8 + (gj & 1) * 4) = silu4(acc);
    }
    {
        f32x4 acc = wxs.b;
#pragma unroll
        for (int k = 0; k < 4; ++k) acc += h4f(rx[k]) * wxs.w[k];
        const f32x4 xs = silu4(acc);
        const float dt = softplusf_(dtraw + dtb);
        *(LAS f32x4*)(buf + SD_XS + (tokx * 32 + r8 * 4) * 4) = xs;
        *(LAS f32x4*)(buf + SD_XDT + (tokx * 32 + r8 * 4) * 4) = xs * dt;
        if (r8 == 0) *(LAS float*)(buf + SD_AB + tokx * 4) = __expf(dt * Ah);
    }
}
__device__ __forceinline__ void ssd_write_y(const h16* proj, h16* mix, int t0, int cc0, LAS unsigned char* ybuf, int lt) {
    const int tok = lt >> 3, r8 = lt & 7, cc = cc0 + r8 * 4;
    const f32x4 y = *(const LAS f32x4*)(ybuf + (tok * 32 + r8 * 4) * 4);
    const f32x4 z = h4f(*(const h16x4*)(proj + (size_t)(t0 + tok) * NP + C_SZ + cc));
    *(h16x4*)(mix + (size_t)(t0 + tok) * DM + 512 + cc) = f4h(y * silu4(z));
}
__device__ __forceinline__ void ssd_scan(const Params& p, int l, int item, LAS unsigned char* lds, const int tidx) {
    const int b = item >> 3, h = (item >> 1) & 3, q2 = item & 1;
    const int tid = tidx, wid = tid >> 6, lane = tid & 63, lt = tid - 256;
    const h16* proj = (const h16*)(p.ws + OFF_BIG);
    h16* mix = (h16*)(p.ws + OFF_MIX);
    const int tb = b * SEQ_, cc0 = h * 64 + q2 * 32;
    const bool loader = wid >= 4;
    const int rowl = (wid & 3) * 4 + (lane >> 4), sub = lane & 15;
    LAS float* dump = (LAS float*)(lds + LDS_BYTES - 8192) + tid;
    const float dtb = p.in[I_DTB][l * 4 + h], Ah = -__expf(p.in[I_ALOG][l * 4 + h]), Dh = p.in[I_SD][l * 4 + h];
    const int chbc = 256 + ((lt & 63) >> 5) * 256 + (h >> 1) * 128 + (lt & 31) * 4, chxs = cc0 + (lt & 7) * 4;
    SsdW wbc, wxs;
    if (loader) { wbc = ssd_wload(p, l, chbc); wxs = ssd_wload(p, l, chxs); }
    f32x4 Sa0 = {0.f, 0.f, 0.f, 0.f}, Sa1 = Sa0, Sb0 = Sa0, Sb1 = Sa0;
    __syncthreads();
    if (loader) ssd_load(proj, tb, h, wbc, chbc, wxs, chxs, dtb, Ah, lds, lt);
    __syncthreads();
#pragma unroll 1
    for (int c = 0; c < SEQ_ / CH; ++c) {
        LAS unsigned char* buf = lds + (c & 1) * SD_STRIDE;
        if (loader) {
            if (c + 1 < SEQ_ / CH) ssd_load(proj, tb + (c + 1) * CH, h, wbc, chbc, wxs, chxs, dtb, Ah, lds + ((c + 1) & 1) * SD_STRIDE, lt);
            if (c > 0) ssd_write_y(proj, mix, tb + (c - 1) * CH, cc0, lds + ((c - 1) & 1) * SD_STRIDE + SD_YB, lt);
        } else {
            const LAS float* sh = (const LAS float*)(buf + SD_SH);
            const LAS float* xdt = (const LAS float*)(buf + SD_XDT);
            const LAS float* xsb = (const LAS float*)(buf + SD_XS);
            const LAS float* ab = (const LAS float*)(buf + SD_AB);
            LAS float* yb = (LAS float*)(buf + SD_YB);
            const LAS f32x4* q0 = (const LAS f32x4*)(sh + sub * 16);
            f32x4 nB0 = q0[0], nB1 = q0[1], nC0 = q0[2], nC1 = q0[3];
            float na = ab[0], nxda = xdt[rowl], nxdb = xdt[rowl + 16], nxsa = xsb[rowl], nxsb = xsb[rowl + 16];
#pragma unroll 4
            for (int s = 0; s < CH; ++s) {
                const f32x4 B0 = nB0, B1 = nB1, C0 = nC0, C1 = nC1;
                const float a = na, xda = nxda, xdb = nxdb, xsa = nxsa, xsb2 = nxsb;
                const LAS f32x4* q = (const LAS f32x4*)(sh + ((s + 1) * 16 + sub) * 16);
                nB0 = q[0]; nB1 = q[1]; nC0 = q[2]; nC1 = q[3];
                na = ab[s + 1]; nxda = xdt[(s + 1) * 32 + rowl]; nxdb = xdt[(s + 1) * 32 + rowl + 16]; nxsa = xsb[(s + 1) * 32 + rowl]; nxsb = xsb[(s + 1) * 32 + rowl + 16];
                Sa0 = Sa0 * a + B0 * xda; Sa1 = Sa1 * a + B1 * xda;
                Sb0 = Sb0 * a + B0 * xdb; Sb1 = Sb1 * a + B1 * xdb;
                const float ya = sum16(dot4(Sa0, C0) + dot4(Sa1, C1)) + Dh * xsa;
                const float yb2 = sum16(dot4(Sb0, C0) + dot4(Sb1, C1)) + Dh * xsb2;
                LAS float* wp = (sub == 0) ? (yb + s * 32 + rowl) : dump;
                wp[0] = ya; wp[16] = yb2;
            }
        }
        __syncthreads();
    }
    if (loader) ssd_write_y(proj, mix, tb + (SEQ_ / CH - 1) * CH, cc0, lds + ((SEQ_ / CH - 1) & 1) * SD_STRIDE + SD_YB, lt);
}

__device__ __forceinline__ void attn_item(const Params& p, int item, const int tidx) {
    const int b = item / 192, rem = item - b * 192, h = rem / 48, s = rem - h * 48;
    int br, dil, r, n;
    if (s < 16) { br = 0; dil = 1; r = 0; n = s; } else if (s < 32) { br = 1; dil = 4; r = (s - 16) >> 2; n = (s - 16) & 3; } else { br = 2; dil = 16; r = s - 32; n = 0; }
    const int tid = tidx, wid = tid >> 6, lane = tid & 63, c16 = lane & 15, g = lane >> 4;
    const h16* base = (const h16*)(p.ws + OFF_BIG) + (size_t)b * SEQ_ * NP;
    const int tq = (n * 128 + 16 * wid + c16) * dil + r;
    h16x8 qf0 = *(const h16x8*)(base + (size_t)tq * NP + C_AQ + h * 64 + g * 8);
    h16x8 qf1 = *(const h16x8*)(base + (size_t)tq * NP + C_AQ + h * 64 + 32 + g * 8);
    f32x4 sc[9];
    h16x8 kf0[9], kf1[9];
    h16x4 vreg[36];
#pragma unroll
    for (int kt = 0; kt < 9; ++kt) {
        int kp = (n - 1) * 128 + 16 * wid + 16 * kt + c16; kp = kp < 0 ? 0 : kp;
        const h16* kr = base + (size_t)(kp * dil + r) * NP + C_AK + h * 64 + g * 8;
        kf0[kt] = *(const h16x8*)kr; kf1[kt] = *(const h16x8*)(kr + 32);
    }
#pragma unroll
    for (int kt = 0; kt < 9; ++kt)
#pragma unroll
        for (int rg = 0; rg < 4; ++rg) {
            int kp = (n - 1) * 128 + 16 * wid + 16 * kt + 4 * g + rg; kp = kp < 0 ? 0 : kp;
            vreg[kt * 4 + rg] = *(const h16x4*)(base + (size_t)(kp * dil + r) * NP + C_AV + h * 64 + 4 * c16);
        }
    __builtin_amdgcn_sched_barrier(0);
#pragma unroll
    for (int kt = 0; kt < 9; ++kt) {
        f32x4 a = {0.f, 0.f, 0.f, 0.f};
        a = __builtin_amdgcn_mfma_f32_16x16x32_f16(kf0[kt], qf0, a, 0, 0, 0);
        a = __builtin_amdgcn_mfma_f32_16x16x32_f16(kf1[kt], qf1, a, 0, 0, 0);
        sc[kt] = a;
    }
    const float slope = exp2f(-2.0f * (float)(h + 1)) * (float)dil;
    float m = -INFINITY;
#pragma unroll
    for (int kt = 0; kt < 9; ++kt)
#pragma unroll
        for (int rg = 0; rg < 4; ++rg) {
            const int jj = 16 * kt + 4 * g + rg, dist = 128 + c16 - jj;
            const bool valid = (dist >= 0) && (dist <= 128) && (n > 0 || (16 * wid + jj) >= 128);
            const float v = valid ? (sc[kt][rg] * 0.125f - slope * (float)dist) : -INFINITY;
            sc[kt][rg] = v; m = fmaxf(m, v);
        }
    m = fmaxf(m, __shfl_xor(m, 16)); m = fmaxf(m, __shfl_xor(m, 32));
    float lsum = 0.f;
#pragma unroll
    for (int kt = 0; kt < 9; ++kt)
#pragma unroll
        for (int rg = 0; rg < 4; ++rg) { const float e = __expf(sc[kt][rg] - m); sc[kt][rg] = e; lsum += e; }
    lsum += __shfl_xor(lsum, 16); lsum += __shfl_xor(lsum, 32);
    f32x4 o[4];
#pragma unroll
    for (int d = 0; d < 4; ++d) o[d] = (f32x4){0.f, 0.f, 0.f, 0.f};
#pragma unroll
    for (int kt = 0; kt < 9; ++kt)
#pragma unroll
        for (int rg = 0; rg < 4; ++rg) {
            const f32x4 v = h4f(vreg[kt * 4 + rg]);
#pragma unroll
            for (int d = 0; d < 4; ++d) o[d] = __builtin_amdgcn_mfma_f32_16x16x4f32(sc[kt][rg], v[d], o[d], 0, 0, 0);
        }
    h16* dst; int ld, co;
    if (br == 0) { dst = (h16*)(p.ws + OFF_MIX); ld = DM; co = 256; } else { dst = (h16*)(p.ws + (br == 1 ? OFF_O2 : OFF_O3)); ld = 256; co = 0; }
    float* lse = (float*)(p.ws + OFF_LSE) + (size_t)br * T_ * 4;
#pragma unroll
    for (int rg = 0; rg < 4; ++rg) {
        const int q = 4 * g + rg;
        const float inv = 1.0f / __shfl(lsum, q);
        const int t = b * SEQ_ + (n * 128 + 16 * wid + q) * dil + r;
        h16x4 ov; ov[0] = (h16)(o[0][rg] * inv); ov[1] = (h16)(o[1][rg] * inv); ov[2] = (h16)(o[2][rg] * inv); ov[3] = (h16)(o[3][rg] * inv);
        *(h16x4*)(dst + (size_t)t * ld + co + h * 64 + 4 * c16) = ov;
    }
    if (g == 0) lse[(size_t)(b * SEQ_ + tq) * 4 + h] = m + __logf(lsum);
}

__device__ __forceinline__ void mix_phase(const Params& p, int l, int cidx, int imask, LAS unsigned char* lds, const int tidx) {
    unsigned* ctr = (unsigned*)(p.ws + OFF_MISC) + cidx;
    LAS unsigned* slot = (LAS unsigned*)(lds + LDS_BYTES - 16);
    for (;;) {
        __syncthreads();
        if (tidx == 0) *slot = atomicAdd(ctr, 1u);
        __syncthreads();
        const int it = (int)*slot;
        if (it >= 64 * 3 + 1536) break;
        int t2 = tidx; asm volatile("" : "+v"(t2));
        if (it < 64) { if (imask & 1) rwkv_scan(p, it, lds, t2); }
        else if (it < 128) { if (imask & 2) ssd_scan(p, l, it - 64, lds, t2); }
        else if (it < 192) { if (imask & 4) hgrn_scan(p, l, it - 128, lds, t2); }
        else if (imask & 8) attn_item(p, it - 192, t2);
    }
}

__device__ __forceinline__ void post_phase(const Params& p, int l, const int tidx) {
    const int wid = tidx >> 6, lane = tidx & 63;
    h16* mix = (h16*)(p.ws + OFF_MIX);
    const h16* prep = (const h16*)p.out;
    const h16* proj = (const h16*)(p.ws + OFF_BIG);
    const h16* o2 = (const h16*)(p.ws + OFF_O2);
    const h16* o3 = (const h16*)(p.ws + OFF_O3);
    const float* lse = (const float*)(p.ws + OFF_LSE);
    const f32x4 snw = *(const f32x4*)(p.in[I_SNW] + l * 256 + 4 * lane);
    const f32x4 hnw = *(const f32x4*)(p.in[I_HNW] + l * 256 + 4 * lane);
    const int hd = lane >> 4;
    for (int t = blockIdx.x * 8 + wid; t < T_; t += gridDim.x * 8) {
        h16* mr = mix + (size_t)t * DM + 4 * lane;
        {
            const f32x4 y = h4f(*(const h16x4*)mr);
            const float mu = sum16(y[0] + y[1] + y[2] + y[3]) * (1.0f / 64.0f);
            const f32x4 d = y - mu;
            const float var = sum16(d[0] * d[0] + d[1] * d[1] + d[2] * d[2] + d[3] * d[3]) * (1.0f / 64.0f);
            const float rstd = rsqrtf(var + 64e-5f);
            const f32x4 A = h4f(*(const h16x4*)(prep + (size_t)t * 2048 + 1536 + 4 * lane));
            const f32x4 Bc = h4f(*(const h16x4*)(prep + (size_t)t * 2048 + 1792 + 4 * lane));
            *(h16x4*)mr = f4h(d * rstd * A + Bc);
        }
        {
            const f32x4 a1 = h4f(*(const h16x4*)(mr + 256));
            const f32x4 a2 = h4f(*(const h16x4*)(o2 + (size_t)t * 256 + 4 * lane));
            const f32x4 a3 = h4f(*(const h16x4*)(o3 + (size_t)t * 256 + 4 * lane));
            const float l1 = lse[(size_t)t * 4 + hd], l2 = lse[(size_t)(T_ + t) * 4 + hd], l3 = lse[(size_t)(2 * T_ + t) * 4 + hd];
            const float mx = fmaxf(l1, fmaxf(l2, l3));
            const float w1 = __expf(l1 - mx), w2 = __expf(l2 - mx), w3 = __expf(l3 - mx);
            const float inv = 1.0f / (w1 + w2 + w3);
            *(h16x4*)(mr + 256) = f4h((a1 * w1 + a2 * w2 + a3 * w3) * inv);
        }
        {
            const f32x4 u = h4f(*(const h16x4*)(mr + 512));
            float ss = sum16(u[0] * u[0] + u[1] * u[1] + u[2] * u[2] + u[3] * u[3]);
            ss += __shfl_xor(ss, 16);
            const float rstd = rsqrtf(ss * (1.0f / 128.0f) + 1e-5f);
            *(h16x4*)(mr + 512) = f4h(u * rstd * snw);
        }
        {
            const f32x4 u = h4f(*(const h16x4*)(mr + 768));
            const float ss = sum16(u[0] * u[0] + u[1] * u[1] + u[2] * u[2] + u[3] * u[3]);
            const float rstd = rsqrtf(ss * (1.0f / 64.0f) + 1e-5f);
            const f32x4 gz = h4f(*(const h16x4*)(proj + (size_t)t * NP + C_HG + 4 * lane));
            f32x4 gt; gt[0] = siluf_(gz[0]); gt[1] = siluf_(gz[1]); gt[2] = siluf_(gz[2]); gt[3] = siluf_(gz[3]);
            *(h16x4*)(mr + 768) = f4h(u * rstd * hnw * gt);
        }
    }
}

__device__ __forceinline__ void ln_phase(const Params& p, const float* w, const float* bvec, bool final_out, const int tidx) {
    const int wid = tidx >> 6, lane = tidx & 63;
    h16* x16 = (h16*)(p.ws + OFF_X16);
    f32x4 wv[4], bv[4];
#pragma unroll
    for (int q = 0; q < 4; ++q) { wv[q] = *(const f32x4*)(w + lane * 16 + 4 * q); bv[q] = *(const f32x4*)(bvec + lane * 16 + 4 * q); }
    for (int t = blockIdx.x * 8 + wid; t < T_; t += gridDim.x * 8) {
        h16* row = x16 + (size_t)t * DM + lane * 16;
        const h16x8 v0 = *(const h16x8*)row, v1 = *(const h16x8*)(row + 8);
        float x[16];
#pragma unroll
        for (int j = 0; j < 8; ++j) { x[j] = (float)v0[j]; x[8 + j] = (float)v1[j]; }
        float s = 0.f;
#pragma unroll
        for (int j = 0; j < 16; ++j) s += x[j];
        const float mu = sum64(s) * (1.0f / 1024.0f);
        float q2 = 0.f;
#pragma unroll
        for (int j = 0; j < 16; ++j) { x[j] -= mu; q2 += x[j] * x[j]; }
        const float rstd = rsqrtf(sum64(q2) * (1.0f / 1024.0f) + 1e-5f);
#pragma unroll
        for (int j = 0; j < 16; ++j) x[j] = x[j] * rstd * wv[j >> 2][j & 3] + bv[j >> 2][j & 3];
        if (final_out) {
            float* orow = p.out + (size_t)t * DM + lane * 16;
#pragma unroll
            for (int q = 0; q < 4; ++q) *(f32x4*)(orow + 4 * q) = (f32x4){x[4 * q], x[4 * q + 1], x[4 * q + 2], x[4 * q + 3]};
        } else {
            h16x8 o0, o1;
#pragma unroll
            for (int j = 0; j < 8; ++j) { o0[j] = (h16)x[j]; o1[j] = (h16)x[8 + j]; }
            *(h16x8*)row = o0; *(h16x8*)(row + 8) = o1;
        }
    }
}

constexpr int NPHASE = 19;
__device__ __forceinline__ void run_phase(const Params& p, int ph, LAS unsigned char* lds, const int tidx, const int rep) {
    const int l = (ph == 0) ? 0 : (ph - 1) / 9, s = (ph == 0) ? -1 : (ph - 1) % 9;
    h16* x16 = (h16*)(p.ws + OFF_X16);
    h16* mix = (h16*)(p.ws + OFF_MIX);
    h16* big = (h16*)(p.ws + OFF_BIG);
    if (ph == 0) {
        if (blockIdx.x == 0) for (int i = tidx; i < 256 + 3456; i += 512) ((unsigned*)(p.ws + OFF_MISC))[i] = 0u;
        conv_x(p, tidx);
    }
    if (s == 0 || s == 4 || s == 6 || s == 7) {
        const h16* A = (s == 0 || s == 6) ? x16 : (s == 4 ? mix : big);
        const h16* Bt = (const h16*)(p.ws + (s == 0 ? OFF_WIN : s == 4 ? OFF_WOUT : s == 6 ? OFF_WUP : OFF_WDN));
        const int N = (s == 0) ? NP : (s == 6 ? DFF : DM), K = (s == 7) ? DFF : DM;
        h16* O = (s == 0 || s == 6) ? big : x16;
        run_gemm(lds, A, Bt, N, K, O, N, (s == 0) ? 0 : (s == 6 ? 1 : 2), tidx);
    }
    if (s == 1) pre_phase(p, l, lds, tidx);
    if (s == 2) mix_phase(p, l, 2 * rep + l, rep ? DUPITEMS : 15, lds, tidx);
    if (s == 3) post_phase(p, l, tidx);
    if (s == 5 || s == 8) ln_phase(p, p.in[s == 5 ? I_LN1W : I_LN2W] + l * DM, p.in[s == 5 ? I_LN1B : I_LN2B] + l * DM, s == 8 && l == 1, tidx);
    if (ph == 0 || (s == 8 && l == 0)) conv_weights(p, ph == 0 ? 0 : 1, lds, tidx);
}

__global__ void __launch_bounds__(512, 2) k_phase(Params p, int ph) {
    extern __shared__ __attribute__((aligned(16))) unsigned char shm[];
    const int tidx = threadIdx.x;
    run_phase(p, ph, (LAS unsigned char*)shm, tidx, 0);
}

#define XB_TMO      128
#define XB_XCNT(j)  (256  + 64 * (j))
#define XB_XSUB(j)  (1280 + 64 * (j))
#define XB_XGEN(j)  (2304 + 64 * (j))
#define XB_TOP      3328
#define XB_TOPGEN   3392
#define XCD_BAR_WORDS 3456
#define XB_SPIN_CAP (1u << 18)

__device__ __forceinline__ unsigned xb_ld(unsigned* p)              { return __hip_atomic_load(p, __ATOMIC_RELAXED, __HIP_MEMORY_SCOPE_AGENT); }
__device__ __forceinline__ unsigned xb_add(unsigned* p, unsigned v) { return __hip_atomic_fetch_add(p, v, __ATOMIC_RELAXED, __HIP_MEMORY_SCOPE_AGENT); }
__device__ __forceinline__ unsigned xb_xcc_id() { return (unsigned)__builtin_amdgcn_s_getreg((3 << 11) | 20) & 0xFu; }
#define XB_SPIN(cond, bar) do { unsigned _sp = 0; while (cond) { __builtin_amdgcn_s_sleep(1); \
    if ((++_sp & 255u) == 0u) { if (xb_ld(&(bar)[XB_TMO])) break; if (_sp > XB_SPIN_CAP) { atomicAdd(&(bar)[XB_TMO], 1u); break; } } } } while (0)

struct XcdBarrier {
    unsigned* bar; unsigned x;
    volatile LAS unsigned* st;
};

__device__ __forceinline__ XcdBarrier xcd_barrier_post(unsigned* bar, volatile LAS unsigned* st) {
    XcdBarrier b; b.bar = bar; b.x = xb_xcc_id(); b.st = st;
    if (threadIdx.x == 0) (void)xb_add(&bar[XB_XCNT(b.x)], 1u);
    return b;
}
__device__ __forceinline__ void xcd_barrier_complete(unsigned* bar, unsigned x, unsigned& nloc, unsigned& nx) {
    const unsigned G = gridDim.x * gridDim.y * gridDim.z;
    unsigned sum, cnt, mine, sp = 0u;
    for (;;) {
        sum = 0u; cnt = 0u; mine = 0u;
#pragma unroll
        for (unsigned j = 0; j < 16; ++j) { const unsigned c = xb_ld(&bar[XB_XCNT(j)]); sum += c; cnt += (c > 0u) ? 1u : 0u; mine = (j == x) ? c : mine; }
        if (sum == G) break;
        __builtin_amdgcn_s_sleep(1);
        if ((++sp & 255u) == 0u) { if (xb_ld(&bar[XB_TMO])) break; if (sp > XB_SPIN_CAP) { atomicAdd(&bar[XB_TMO], 1u); break; } }
    }
    nloc = mine > 0u ? mine : 1u; nx = cnt > 0u ? cnt : 1u;
}

__device__ __forceinline__ void xcd_barrier(const XcdBarrier& b) {
    asm volatile("s_waitcnt vmcnt(0)" ::: "memory");
    __syncthreads();
    if (threadIdx.x == 0) {
        unsigned* bar = b.bar;
        __builtin_amdgcn_s_waitcnt(0);
        unsigned nloc = b.st[0], nx = b.st[1];
        if (nloc == 0u) { xcd_barrier_complete(bar, b.x, nloc, nx); b.st[0] = nloc; b.st[1] = nx; }
        const unsigned old = xb_add(&bar[XB_XSUB(b.x)], 1u);
        const unsigned gen = old / nloc;
        if (old + 1u == (gen + 1u) * nloc) {
            __builtin_amdgcn_fence(__ATOMIC_RELEASE, "agent");
            asm volatile("s_waitcnt vmcnt(0)" ::: "memory");
            const unsigned og = xb_add(&bar[XB_TOP], 1u);
            const unsigned tg = og / nx;
            if (og + 1u == (tg + 1u) * nx) xb_add(&bar[XB_TOPGEN], 1u);
            else XB_SPIN(xb_ld(&bar[XB_TOPGEN]) == tg, bar);
            __builtin_amdgcn_fence(__ATOMIC_ACQUIRE, "agent");
            xb_add(&bar[XB_XGEN(b.x)], 1u);
            asm volatile("s_waitcnt vmcnt(0)" ::: "memory");
        } else {
            XB_SPIN(xb_ld(&bar[XB_XGEN(b.x)]) == gen, bar);
            __builtin_amdgcn_fence(__ATOMIC_ACQUIRE, "agent");
            asm volatile("s_waitcnt vmcnt(0)" ::: "memory");
        }
    }
    __syncthreads();
}


#ifndef DUPITEMS
#define DUPITEMS 15
#endif
#ifndef DUPMASK
#define DUPMASK 0
#endif
#if COOP
__global__ void __launch_bounds__(512, 2) k_mega(Params p) {
    extern __shared__ __attribute__((aligned(16))) unsigned char shm[];
    cg::grid_group grid = cg::this_grid();
    unsigned* barw = (unsigned*)(p.ws + OFF_MISC + 1024);
    volatile LAS unsigned* xst = (volatile LAS unsigned*)((LAS unsigned char*)shm + LDS_BYTES);
    if (threadIdx.x < 4) xst[threadIdx.x] = 0u;
    XcdBarrier xb; xb.bar = barw; xb.x = 0; xb.st = xst;
#pragma unroll 1
    for (int ph = 0; ph < NPHASE; ++ph) {
        const int nrep = ((DUPMASK >> ph) & 1) ? 2 : 1;
#pragma unroll 1
        for (int rep = 0; rep < nrep; ++rep) {
            int tidx = threadIdx.x; asm volatile("" : "+v"(tidx));
            run_phase(p, ph, (LAS unsigned char*)shm, tidx, rep);
            if (ph == 0) { grid.sync(); xb = xcd_barrier_post(barw, xst); }
            else if (ph + 1 < NPHASE) xcd_barrier(xb);
        }
#ifdef EXTRA_SYNCS
        if (ph == 1) for (int i = 0; i < EXTRA_SYNCS; ++i) xcd_barrier(xb);
#endif
    }
}
#endif

extern "C" void kernel_launch(void* const* d_in, const int* in_sizes, int n_in, void* d_out, int out_size, void* d_ws, size_t ws_size, hipStream_t stream) {
    static int grid_blocks = 0;
    if (!grid_blocks) {
        int dev = 0, cus = 0, per_cu = 0;
        hipGetDevice(&dev);
        hipDeviceGetAttribute(&cus, hipDeviceAttributeMultiprocessorCount, dev);
        hipFuncSetAttribute((const void*)k_phase, hipFuncAttributeMaxDynamicSharedMemorySize, LDS_TOTAL);
#if COOP
        hipFuncSetAttribute((const void*)k_mega, hipFuncAttributeMaxDynamicSharedMemorySize, LDS_TOTAL);
        hipOccupancyMaxActiveBlocksPerMultiprocessor(&per_cu, (const void*)k_mega, 512, LDS_TOTAL);
#endif
        if (per_cu < 1) per_cu = 1;
        grid_blocks = cus * 1;
        (void)hipGetLastError();
    }
    Params p{};
    for (int i = 0; i < 32; ++i) p.in[i] = (const float*)d_in[i];
    p.out = (float*)d_out; p.ws = (unsigned char*)d_ws;
#if COOP
    void* args[] = {&p};
    hipError_t e = hipLaunchCooperativeKernel((const void*)k_mega, dim3(grid_blocks), dim3(512), args, LDS_TOTAL, stream);
    if (e != hipSuccess) fprintf(stderr, "cooperative launch failed: %s (grid %d)\n", hipGetErrorString(e), grid_blocks);
#else
    for (int ph = 0; ph < NPHASE; ++ph) k_phase<<<dim3(grid_blocks), dim3(512), LDS_TOTAL, stream>>>(p, ph);
#endif
}
```

```cpp
#include <hip/hip_runtime.h>
#include <hip/hip_cooperative_groups.h>
#include <cstdio>
namespace cg = cooperative_groups;

#ifndef COOP
#define COOP 1
#endif
#ifndef DUPITEMS
#define DUPITEMS 15
#endif
#ifndef R_RWKV
#define R_RWKV 2
#endif
#ifndef R_SSD
#define R_SSD 2
#endif
#ifndef R_HGRN
#define R_HGRN 2
#endif

#define LAS __attribute__((address_space(3)))
typedef _Float16 h16;
typedef _Float16 h16x4 __attribute__((ext_vector_type(4)));
typedef _Float16 h16x8 __attribute__((ext_vector_type(8)));
typedef float f32x2 __attribute__((ext_vector_type(2)));
typedef float f32x4 __attribute__((ext_vector_type(4)));

constexpr int T_ = 16384, SEQ_ = 2048, DM = 1024, NP = 3840, DFF = 4096, INC = 3716;
constexpr int C_R = 0, C_K = 256, C_V = 512, C_FW = 768, C_VR = 896, C_AQ = 928, C_AK = 1184, C_AV = 1440;
constexpr int C_SZ = 1696, C_SX = 1952, C_SDT = 2720, C_HQ = 2728, C_HF = 2984, C_HI = 3240, C_HG = 3496;
constexpr float ALPHA_ = 1.41421356237f;
constexpr size_t OFF_WIN = 0, OFF_WOUT = 7864320, OFF_WUP = OFF_WOUT + 2097152, OFF_WDN = OFF_WUP + 8388608;
constexpr size_t OFF_X16 = 26738688, OFF_MIX = OFF_X16 + 33554432, OFF_BIG = OFF_MIX + 33554432;
constexpr size_t OFF_VF = OFF_BIG + 134217728, OFF_O2 = OFF_VF + 8388608, OFF_O3 = OFF_O2 + 8388608, OFF_LSE = OFF_O3 + 8388608;
constexpr size_t OFF_MISC = OFF_LSE + 786432;
constexpr int LDS_BYTES = 131072, LDS_TOTAL = 131072 + 64;

struct Params { const float* in[32]; float* out; unsigned char* ws; };

enum { I_X = 0, I_LB, I_WIN, I_WINV, I_MU, I_MUV, I_W0, I_W2, I_A0, I_A2, I_G2, I_KK, I_KA, I_RK, I_LNW, I_LNB, I_V0, I_V2,
       I_CW, I_CB, I_DTB, I_ALOG, I_SD, I_SNW, I_HNW, I_WOUT, I_LN1W, I_LN1B, I_WUP, I_WDN, I_LN2W, I_LN2B };

template <int CTRL> __device__ __forceinline__ float dpp_f(float x) {
    return __builtin_bit_cast(float, __builtin_amdgcn_update_dpp(0, __builtin_bit_cast(int, x), CTRL, 0xF, 0xF, true));
}
__device__ __forceinline__ float sum16(float x) {
    x += dpp_f<0xB1>(x);
    x += dpp_f<0x4E>(x);
    x += dpp_f<0x141>(x);
    x += dpp_f<0x140>(x);
    return x;
}
__device__ __forceinline__ float sum64(float x) { x = sum16(x); x += __shfl_xor(x, 16); x += __shfl_xor(x, 32); return x; }
__device__ __forceinline__ float sigmoidf_(float x) { return __builtin_amdgcn_rcpf(1.0f + __expf(-x)); }
__device__ __forceinline__ float siluf_(float x) { return x * __builtin_amdgcn_rcpf(1.0f + __expf(-x)); }
__device__ __forceinline__ float softplusf_(float x) { return fmaxf(x, 0.f) + __logf(1.0f + __expf(-fabsf(x))); }
__device__ __forceinline__ f32x4 h4f(h16x4 v) { return (f32x4){(float)v[0], (float)v[1], (float)v[2], (float)v[3]}; }
__device__ __forceinline__ h16x4 f4h(f32x4 v) { return (h16x4){(h16)v[0], (h16)v[1], (h16)v[2], (h16)v[3]}; }

namespace pg8 {
constexpr int BM = 256, BK = 64, HALF = 128, HTB = HALF * BK * 2, STAGE_BYTES = 8 * HTB, NXCD = 8, WGM = 8;
__host__ __device__ __forceinline__ int lds_byte(int r, int c) { const int st = (r >> 4) * 2 + (c >> 5), rr = r & 15, cc = c & 31, ob = rr * 64 + cc * 2; return st * 1024 + (ob ^ (((ob >> 9) & 1) << 5)); }
__host__ __device__ __forceinline__ void stage_rc(int b, int& R, int& C) { const int st = b / 1024, sb = b % 1024, swz = sb ^ (((sb >> 9) & 1) << 5); R = (st >> 1) * 16 + swz / 64; C = (st & 1) * 32 + (swz % 64) / 2; }
__host__ __device__ __forceinline__ int perm32(int rho) { const int n = rho >> 4, i = rho & 15; return 8 * (i >> 2) + 4 * n + (i & 3); }
struct Unit { int pm, pn; };
struct Gemm { const h16* A; const h16* Bt; int M, N, K; };
struct StaticOrder {
    int nM, nN, nwg, G, c;
    __device__ void init(int M, int N, int G_, int c_) { nM = M / BM; nN = N / BM; nwg = nM * nN; G = G_; c = c_; }
    __device__ bool next(int i, Unit& u) const {
        const long L = (long)i * G + c; if (L >= nwg) return false;
        int wgid = (int)L; { const int q = nwg / NXCD, r = nwg % NXCD, xcd = wgid % NXCD, off = wgid / NXCD; wgid = (xcd < r ? xcd * (q + 1) : r * (q + 1) + (xcd - r) * q) + off; }
        const int nig = WGM * nN, gid = wgid / nig, fm = gid * WGM, gsz = (nM - fm) < WGM ? (nM - fm) : WGM;
        u.pm = fm + ((wgid % nig) % gsz); u.pn = (wgid % nig) / gsz; return true;
    }
};
struct EpiH {
    h16* O; int ldc; int MODE;
    __device__ __forceinline__ void operator()(const f32x4 (&acc)[2][2][4][2], const Unit& u, int wr, int wc, int fr, int fq) const {
        const int row0 = u.pm * BM + wr * 64 + fr, col0 = u.pn * BM + wc * 32 + 8 * fq;
#pragma unroll
        for (int ai = 0; ai < 2; ++ai)
#pragma unroll
            for (int m = 0; m < 4; ++m) { h16* rowp = O + (size_t)(row0 + ai * HALF + m * 16) * ldc + col0;
#pragma unroll
                for (int bj = 0; bj < 2; ++bj) { f32x4 v0 = acc[ai][bj][m][0], v1 = acc[ai][bj][m][1];
                    if (MODE == 1) {
#pragma unroll
                        for (int j = 0; j < 4; ++j) { float a = fmaxf(v0[j], 0.f), b = fmaxf(v1[j], 0.f); v0[j] = a * a; v1[j] = b * b; } }
                    if (MODE == 2) { const h16x8 x = *(const h16x8*)(rowp + bj * HALF);
#pragma unroll
                        for (int j = 0; j < 4; ++j) { v0[j] += ALPHA_ * (float)x[j]; v1[j] += ALPHA_ * (float)x[4 + j]; } }
                    h16x8 w;
#pragma unroll
                    for (int j = 0; j < 4; ++j) { w[j] = (h16)v0[j]; w[4 + j] = (h16)v1[j]; }
                    *(h16x8*)(rowp + bj * HALF) = w; } }
    }
};

template <class Epi>
__device__ __forceinline__ void gemm_phase(LAS unsigned char* lds, const Gemm g, const StaticOrder& S, const Epi& E, const int tidx) {
    const int tid = tidx, wid = __builtin_amdgcn_readfirstlane(tid >> 6), lane = tid & 63, wr = wid >> 2, wc = wid & 3, fr = lane & 15, fq = lane >> 4;
    const int K = g.K, nt = K / BK;
    unsigned voffA[2], voffB[2];
#pragma unroll
    for (int i = 0; i < 2; ++i) { int R, C; stage_rc(tid * 16 + i * 8192, R, C); const int Rb = (R & ~31) + perm32(R & 31);
        voffA[i] = (unsigned)(R * K + C) * 2u; voffB[i] = (unsigned)(Rb * K + C) * 2u; }
    const size_t kstep = (size_t)(BK * 2);
    const size_t hstep = (size_t)HALF * K * 2;
    const size_t tstep = 2 * hstep;
    const unsigned ldsw = (unsigned)wid * 1024u;
    const int aoff = lds_byte(wr * 64 + fr, fq * 8), boff = lds_byte(wc * 32 + fr, fq * 8);
#define PG8_SA(b, h) (((b) * 2 + (h)) * HTB)
#define PG8_SB(b, h) ((4 + (b) * 2 + (h)) * HTB)
#define PG8_STAGE(bufoff, gbase, voff) do { _Pragma("unroll") for (int _i = 0; _i < 2; ++_i) \
        __builtin_amdgcn_global_load_lds((const unsigned*)((const char*)(gbase) + (voff)[_i]), (LAS unsigned*)(lds + (bufoff) + ldsw + _i * 8192), 16, 0, 0); } while (0)
#define PG8_LDA(dst, b, h) do { _Pragma("unroll") for (int m = 0; m < 4; ++m) _Pragma("unroll") for (int k = 0; k < 2; ++k) dst[m][k] = *(const LAS h16x8*)(lds + PG8_SA(b, h) + aoff + m * 2048 + k * 1024); } while (0)
#define PG8_LDB(dst, b, h) do { _Pragma("unroll") for (int n = 0; n < 2; ++n) _Pragma("unroll") for (int k = 0; k < 2; ++k) dst[n][k] = *(const LAS h16x8*)(lds + PG8_SB(b, h) + boff + n * 2048 + k * 1024); } while (0)
#define PG8_MMA(ai, bj, At, Bt) do { __builtin_amdgcn_s_setprio(1); _Pragma("unroll") for (int m = 0; m < 4; ++m) _Pragma("unroll") for (int n = 0; n < 2; ++n) _Pragma("unroll") for (int k = 0; k < 2; ++k) \
        acc[ai][bj][m][n] = __builtin_amdgcn_mfma_f32_16x16x32_f16(Bt[n][k], At[m][k], acc[ai][bj][m][n], 0, 0, 0); __builtin_amdgcn_s_setprio(0); } while (0)
#define PG8_WAIT_V(n) asm volatile("s_waitcnt vmcnt(" #n ")" ::: "memory")
#define PG8_WAIT_L(n) asm volatile("s_waitcnt lgkmcnt(" #n ")" ::: "memory")
#define PG8_BAR __builtin_amdgcn_s_barrier()
#define PG8_SCHED __builtin_amdgcn_sched_barrier(0)
    Unit cur, nxt; int ui = 0;
    if (!S.next(0, cur)) return;
    f32x4 acc[2][2][4][2];
#pragma unroll
    for (int a = 0; a < 2; ++a)
#pragma unroll
        for (int b = 0; b < 2; ++b)
#pragma unroll
            for (int m = 0; m < 4; ++m)
#pragma unroll
                for (int n = 0; n < 2; ++n) acc[a][b][m][n] = (f32x4){0.f, 0.f, 0.f, 0.f};
    h16x8 At[4][2], B0[2][2], B1[2][2];
    const char* cA = (const char*)g.A + (size_t)cur.pm * tstep; const char* cB = (const char*)g.Bt + (size_t)cur.pn * tstep;
    PG8_STAGE(PG8_SB(0, 0), cB, voffB); PG8_STAGE(PG8_SA(0, 0), cA, voffA); PG8_STAGE(PG8_SB(0, 1), cB + hstep, voffB); PG8_STAGE(PG8_SA(0, 1), cA + hstep, voffA);
    if (wr == 1) PG8_BAR;
    PG8_WAIT_V(4); PG8_BAR;
    PG8_STAGE(PG8_SB(1, 0), cB + kstep, voffB); PG8_STAGE(PG8_SA(1, 0), cA + kstep, voffA); PG8_STAGE(PG8_SB(1, 1), cB + hstep + kstep, voffB);
    PG8_WAIT_V(6); PG8_BAR;
    for (;;) {
        const bool has_next = S.next(ui + 1, nxt);
        const char* nA = has_next ? (const char*)g.A + (size_t)nxt.pm * tstep : cA; const char* nB = has_next ? (const char*)g.Bt + (size_t)nxt.pn * tstep : cB;
        for (int t = 0; t < nt; t += 2) {
            const bool last = (t == nt - 2);
            const char* a1 = cA + (size_t)(t + 1) * kstep;
            const char* a2 = last ? nA : cA + (size_t)(t + 2) * kstep; const char* b2 = last ? nB : cB + (size_t)(t + 2) * kstep;
            const char* a3 = a2 + kstep; const char* b3 = b2 + kstep;
            PG8_LDB(B0, 0, 0); PG8_SCHED; PG8_LDA(At, 0, 0); PG8_STAGE(PG8_SA(1, 1), a1 + hstep, voffA);
            PG8_WAIT_L(8); PG8_BAR; PG8_WAIT_L(0); PG8_MMA(0, 0, At, B0); PG8_BAR; PG8_SCHED;
            PG8_LDB(B1, 0, 1); PG8_STAGE(PG8_SB(0, 0), b2, voffB);
            PG8_BAR; PG8_WAIT_L(0); PG8_MMA(0, 1, At, B1); PG8_BAR;
            PG8_LDA(At, 0, 1); PG8_STAGE(PG8_SA(0, 0), a2, voffA);
            PG8_BAR; PG8_WAIT_L(0); PG8_MMA(1, 0, At, B0); PG8_BAR; PG8_SCHED;
            PG8_STAGE(PG8_SB(0, 1), b2 + hstep, voffB);
            PG8_WAIT_V(6); PG8_BAR; PG8_MMA(1, 1, At, B1); PG8_BAR;
            PG8_LDB(B0, 1, 0); PG8_SCHED; PG8_LDA(At, 1, 0); PG8_STAGE(PG8_SA(0, 1), a2 + hstep, voffA);
            PG8_WAIT_L(8); PG8_BAR; PG8_WAIT_L(0); PG8_MMA(0, 0, At, B0); PG8_BAR; PG8_SCHED;
            PG8_LDB(B1, 1, 1); PG8_STAGE(PG8_SB(1, 0), b3, voffB);
            PG8_BAR; PG8_WAIT_L(0); PG8_MMA(0, 1, At, B1); PG8_BAR;
            PG8_LDA(At, 1, 1); PG8_STAGE(PG8_SA(1, 0), a3, voffA);
            PG8_BAR; PG8_WAIT_L(0); PG8_MMA(1, 0, At, B0); PG8_BAR; PG8_SCHED;
            PG8_STAGE(PG8_SB(1, 1), b3 + hstep, voffB);
            PG8_WAIT_V(6); PG8_BAR; PG8_MMA(1, 1, At, B1); PG8_BAR;
        }
        E(acc, cur, wr, wc, fr, fq);
        if (!has_next) break;
#pragma unroll
        for (int a = 0; a < 2; ++a)
#pragma unroll
            for (int b = 0; b < 2; ++b)
#pragma unroll
                for (int m = 0; m < 4; ++m)
#pragma unroll
                    for (int n = 0; n < 2; ++n) acc[a][b][m][n] = (f32x4){0.f, 0.f, 0.f, 0.f};
        cur = nxt; cA = nA; cB = nB; ++ui;
    }
    PG8_WAIT_V(0);
    if (wr == 0) PG8_BAR;
    PG8_BAR;
#undef PG8_SA
#undef PG8_SB
#undef PG8_STAGE
#undef PG8_LDA
#undef PG8_LDB
#undef PG8_MMA
#undef PG8_WAIT_V
#undef PG8_WAIT_L
#undef PG8_BAR
#undef PG8_SCHED
}
}

__device__ __forceinline__ void run_gemm(LAS unsigned char* lds, const h16* A, const h16* Bt, int N, int K, h16* O, int ldc, int mode, const int tidx) {
    pg8::Gemm g; g.A = A; g.Bt = Bt; g.M = T_; g.N = N; g.K = K;
    pg8::StaticOrder S; S.init(T_, N, (int)gridDim.x, (int)blockIdx.x);
    pg8::EpiH E; E.O = O; E.ldc = ldc; E.MODE = mode;
    pg8::gemm_phase(lds, g, S, E, tidx);
}

__device__ __forceinline__ void conv_weights(const Params& p, int l, LAS unsigned char* lds, const int tidx) {
    LAS float* tile = (LAS float*)lds;
    const int tid = tidx;
    for (int id = blockIdx.x; id < 3264; id += gridDim.x) {
        int mat, tl;
        if (id < 960) { mat = 0; tl = id; } else if (id < 1216) { mat = 1; tl = id - 960; } else if (id < 2240) { mat = 2; tl = id - 1216; } else { mat = 3; tl = id - 2240; }
        const int K = (mat == 3) ? 4096 : 1024;
        const int nkt = K / 64;
        const int n0 = (tl / nkt) * 64, k0 = (tl % nkt) * 64;
        h16* dst = (h16*)(p.ws + (mat == 0 ? OFF_WIN : mat == 1 ? OFF_WOUT : mat == 2 ? OFF_WUP : OFF_WDN));
        __syncthreads();
        {
            const int nj = tid & 63, n = n0 + nj;
            const float* src = nullptr; int sstride = 0;
            if (mat == 0) {
                if (n < 896) { src = p.in[I_WIN] + (size_t)l * DM * INC + n; sstride = INC; }
                else if (n < 928) { if (l > 0) { src = p.in[I_WINV] + (size_t)(l - 1) * DM * 32 + (n - 896); sstride = 32; } }
                else if (n < 2724) { src = p.in[I_WIN] + (size_t)l * DM * INC + (n - 32); sstride = INC; }
                else if (n < 2728) { }
                else if (n < 3752) { src = p.in[I_WIN] + (size_t)l * DM * INC + (n - 36); sstride = INC; }
            } else if (mat == 1) { src = p.in[I_WOUT] + (size_t)l * 1024 * 1024 + n; sstride = 1024; }
            else if (mat == 2) { src = p.in[I_WUP] + (size_t)l * 1024 * 4096 + n; sstride = 4096; }
            else { src = p.in[I_WDN] + (size_t)l * 4096 * 1024 + n; sstride = 1024; }
#pragma unroll
            for (int i = 0; i < 8; ++i) { const int ki = (tid >> 6) + 8 * i; tile[ki * 65 + nj] = src ? src[(size_t)(k0 + ki) * sstride] : 0.f; }
        }
        __syncthreads();
        {
            const int ki = tid & 63;
#pragma unroll
            for (int i = 0; i < 8; ++i) { const int nj = (tid >> 6) + 8 * i; dst[(size_t)(n0 + nj) * K + k0 + ki] = (h16)tile[ki * 65 + nj]; }
        }
    }
    __syncthreads();
}

__device__ __forceinline__ void conv_x(const Params& p, const int tidx) {
    const f32x4* src = (const f32x4*)p.in[I_X]; h16x4* dst = (h16x4*)(p.ws + OFF_X16);
    for (size_t i = (size_t)blockIdx.x * 512 + tidx; i < (size_t)T_ * DM / 4; i += (size_t)gridDim.x * 512) dst[i] = f4h(src[i]);
}

__device__ __forceinline__ void pre_phase(const Params& p, int l, LAS unsigned char* lds, const int tidx) {
    constexpr int RS = 168;
    LAS h16* A16 = (LAS h16*)lds;
    LAS h16* W16 = (LAS h16*)(lds + 64 * RS * 2);
    const h16* proj = (const h16*)(p.ws + OFF_BIG);
    h16* prep = (h16*)p.out;
    h16* vfirst = (h16*)(p.ws + OFF_VF);
    const int tid = tidx, wid = tid >> 6, lane = tid & 63, c16 = lane & 15, g = lane >> 4, hh = wid & 3, mh = wid >> 2;
    const int nact = (l == 0) ? 128 : 160;
    __syncthreads();
#pragma unroll 1
    for (int e0 = 0; e0 < nact * 256; e0 += 512 * 16) {
        float wv16[16];
#pragma unroll
        for (int u = 0; u < 16; ++u) {
            const int e = e0 + u * 512 + tid, i = e >> 8, cc = e & 255;
            const float* sp;
            if (i < 32) sp = p.in[I_W2] + (size_t)(l * 32 + i) * 256 + cc;
            else if (i < 64) sp = p.in[I_A2] + (size_t)(l * 32 + i - 32) * 256 + cc;
            else if (i < 128) sp = p.in[I_G2] + (size_t)(l * 64 + i - 64) * 256 + cc;
            else sp = p.in[I_V2] + (size_t)((l - 1) * 32 + i - 128) * 256 + cc;
            wv16[u] = *sp;
        }
#pragma unroll
        for (int u = 0; u < 16; ++u) { const int e = e0 + u * 512 + tid; W16[(e & 255) * RS + (e >> 8)] = (h16)wv16[u]; }
    }
    float mu_r[4], mu_k[4], mu_v[4], w0[4], a0[4], k_k[4], k_a[4], r_k[4], lnw[4], lnb[4], v0[4];
#pragma unroll
    for (int nt = 0; nt < 4; ++nt) {
        const int ch = hh * 64 + nt * 16 + c16;
        mu_r[nt] = p.in[I_MU][l * 896 + ch]; mu_k[nt] = p.in[I_MU][l * 896 + 256 + ch]; mu_v[nt] = p.in[I_MU][l * 896 + 512 + ch];
        w0[nt] = p.in[I_W0][l * 256 + ch]; a0[nt] = p.in[I_A0][l * 256 + ch]; k_k[nt] = p.in[I_KK][l * 256 + ch]; k_a[nt] = p.in[I_KA][l * 256 + ch];
        r_k[nt] = p.in[I_RK][l * 256 + ch]; lnw[nt] = p.in[I_LNW][l * 256 + ch]; lnb[nt] = p.in[I_LNB][l * 256 + ch];
        v0[nt] = (l > 0) ? p.in[I_V0][(l - 1) * 256 + ch] : 0.f;
    }
    for (int tt = blockIdx.x; tt < T_ / 64; tt += gridDim.x) {
        const int t0 = tt * 64;
        __syncthreads();
#pragma unroll 1
        for (int eb = 0; eb < 20; eb += 10) {
            float curv[10], prvv[10];
#pragma unroll
            for (int u = 0; u < 10; ++u) {
                const int e = (eb + u) * 512 + tid, tok = e / 160, i = e - tok * 160, t = t0 + tok;
                curv[u] = 0.f; prvv[u] = 0.f;
                if (i < nact) {
                    curv[u] = (float)proj[(size_t)t * NP + C_FW + i];
                    if (t & (SEQ_ - 1)) prvv[u] = (float)proj[(size_t)(t - 1) * NP + C_FW + i];
                }
            }
#pragma unroll
            for (int u = 0; u < 10; ++u) {
                const int e = (eb + u) * 512 + tid, tok = e / 160, i = e - tok * 160;
                if (i < nact) {
                    const float mu = (i < 128) ? p.in[I_MU][l * 896 + 768 + i] : p.in[I_MUV][(l - 1) * 32 + (i - 128)];
                    const float f = curv[u] + (prvv[u] - curv[u]) * mu;
                    float a = f;
                    if (i < 32) { const float e2 = __expf(-2.0f * fabsf(f)); const float th = (1.0f - e2) * __builtin_amdgcn_rcpf(1.0f + e2); a = f < 0.f ? -th : th; } else if (i >= 64 && i < 128) a = sigmoidf_(f);
                    A16[tok * RS + i] = (h16)a;
                }
            }
        }
        __syncthreads();
#pragma unroll 1
        for (int mt = 0; mt < 2; ++mt) {
            const int tokb = mh * 32 + mt * 16;
            f32x4 aw[4], aa[4], ag[4], av[4];
            {
                const LAS h16* ar = A16 + (tokb + c16) * RS + 8 * g;
                const h16x8 A0 = *(const LAS h16x8*)(ar), A1 = *(const LAS h16x8*)(ar + 32), A2 = *(const LAS h16x8*)(ar + 64), A3 = *(const LAS h16x8*)(ar + 96);
                h16x8 A4 = A0; if (l > 0) A4 = *(const LAS h16x8*)(ar + 128);
#pragma unroll
                for (int nt = 0; nt < 4; ++nt) {
                    const LAS h16* br = W16 + (hh * 64 + nt * 16 + c16) * RS + 8 * g;
                    const f32x4 z = {0.f, 0.f, 0.f, 0.f};
                    aw[nt] = __builtin_amdgcn_mfma_f32_16x16x32_f16(A0, *(const LAS h16x8*)(br), z, 0, 0, 0);
                    aa[nt] = __builtin_amdgcn_mfma_f32_16x16x32_f16(A1, *(const LAS h16x8*)(br + 32), z, 0, 0, 0);
                    ag[nt] = __builtin_amdgcn_mfma_f32_16x16x32_f16(A2, *(const LAS h16x8*)(br + 64), z, 0, 0, 0);
                    ag[nt] = __builtin_amdgcn_mfma_f32_16x16x32_f16(A3, *(const LAS h16x8*)(br + 96), ag[nt], 0, 0, 0);
                    av[nt] = z;
                    if (l > 0) av[nt] = __builtin_amdgcn_mfma_f32_16x16x32_f16(A4, *(const LAS h16x8*)(br + 128), z, 0, 0, 0);
                }
            }
#pragma unroll
            for (int rp = 0; rp < 2; ++rp) {
            h16 lr[8], lk[8], lv[8], lpr[8], lpk[8], lpv[8], lvf[8];
#pragma unroll
            for (int r2 = 0; r2 < 2; ++r2) {
                const int t = t0 + tokb + 4 * g + rp * 2 + r2;
                const h16* row = proj + (size_t)t * NP + hh * 64 + c16;
#pragma unroll
                for (int nt = 0; nt < 4; ++nt) {
                    const int q = r2 * 4 + nt;
                    lr[q] = row[C_R + nt * 16]; lk[q] = row[C_K + nt * 16]; lv[q] = row[C_V + nt * 16];
                    lpr[q] = (h16)0.f; lpk[q] = (h16)0.f; lpv[q] = (h16)0.f; lvf[q] = (h16)0.f;
                    if (t & (SEQ_ - 1)) { lpr[q] = row[C_R + nt * 16 - NP]; lpk[q] = row[C_K + nt * 16 - NP]; lpv[q] = row[C_V + nt * 16 - NP]; }
                    if (l > 0) lvf[q] = vfirst[(size_t)t * 256 + hh * 64 + nt * 16 + c16];
                }
            }
#pragma unroll
            for (int r2 = 0; r2 < 2; ++r2) {
                const int rg = rp * 2 + r2;
                const int t = t0 + tokb + 4 * g + rg;
                float rr[4], kp[4], vv[4], kkr[4], aS[4], ee[4];
                float n2 = 0.f, bn = 0.f;
#pragma unroll
                for (int nt = 0; nt < 4; ++nt) {
                    const int q = r2 * 4 + nt;
                    float r = (float)lr[q], k = (float)lk[q], v = (float)lv[q];
                    r += ((float)lpr[q] - r) * mu_r[nt]; k += ((float)lpk[q] - k) * mu_k[nt]; v += ((float)lpv[q] - v) * mu_v[nt];
                    const float wl = w0[nt] + aw[nt][rg];
                    ee[nt] = __expf(-softplusf_(-wl) - 0.5f);
                    const float a = sigmoidf_(a0[nt] + aa[nt][rg]);
                    if (l == 0) vfirst[(size_t)t * 256 + hh * 64 + nt * 16 + c16] = (h16)v;
                    else v += ((float)lvf[q] - v) * sigmoidf_(v0[nt] + av[nt][rg]);
                    kkr[nt] = k * k_k[nt];
                    kp[nt] = k * (1.0f + (a - 1.0f) * k_a[nt]);
                    rr[nt] = r; vv[nt] = v; aS[nt] = a;
                    n2 += kkr[nt] * kkr[nt]; bn += r * kp[nt] * r_k[nt];
                }
                n2 = sum16(n2); bn = sum16(bn);
                const float rn = __builtin_amdgcn_rsqf(fmaxf(n2, 1e-24f));
#pragma unroll
                for (int nt = 0; nt < 4; ++nt) {
                    const float kk = kkr[nt] * rn, gg = ag[nt][rg];
                    h16* o = prep + (size_t)t * 2048 + hh * 64 + nt * 16 + c16;
                    o[0] = (h16)rr[nt]; o[256] = (h16)ee[nt]; o[512] = (h16)kp[nt]; o[768] = (h16)kk; o[1024] = (h16)(kk * aS[nt]); o[1280] = (h16)vv[nt];
                    o[1536] = (h16)(lnw[nt] * gg); o[1792] = (h16)((lnb[nt] + bn * vv[nt]) * gg);
                }
            }
            }
        }
    }
    __syncthreads();
}

constexpr int CH = 32;

__device__ __forceinline__ float dot4(f32x4 a, f32x4 b) { f32x2 p = (f32x2){a[0], a[1]} * (f32x2){b[0], b[1]}; p = __builtin_elementwise_fma((f32x2){a[2], a[3]}, (f32x2){b[2], b[3]}, p); return p[0] + p[1]; }
template <int R> __device__ __forceinline__ void plain_write_y(h16* mix, int t0, int col, LAS unsigned char* ybuf, int lt) {
    if (lt >= 128 * R) return;
    const int tok = lt / (4 * R), r8 = lt & (4 * R - 1);
    const f32x4 y = *(const LAS f32x4*)(ybuf + (tok * 32 + r8 * 4) * 4);
    *(h16x4*)(mix + (size_t)(t0 + tok) * DM + col + r8 * 4) = f4h(y);
}

constexpr int RW_SH = 0, RW_VB = CH * 16 * 20 * 4, RW_YB = RW_VB + CH * 32 * 4, RW_STRIDE = RW_YB + CH * 32 * 4;
template <int R> __device__ __forceinline__ void rwkv_load(const h16* prep, int t0, int h, int rowbase, LAS unsigned char* buf, int lt) {
    LAS float* sh = (LAS float*)(buf + RW_SH);
    h16x4 raw[10];
#pragma unroll
    for (int i = 0; i < 10; ++i) {
        const int e = i * 256 + lt, tok = e / 80, rem = e - tok * 80, vec = rem >> 4, sub = rem & 15;
        const int pv = (vec == 0) ? 3 : (vec == 1) ? 1 : (vec == 2) ? 4 : (vec == 3) ? 2 : 0;
        raw[i] = *(const h16x4*)(prep + (size_t)(t0 + tok) * 2048 + pv * 256 + h * 64 + sub * 4);
    }
    const int tokv = lt / (4 * R), r8 = lt & (4 * R - 1);
    h16x4 rv = {(h16)0.f, (h16)0.f, (h16)0.f, (h16)0.f};
    if (lt < 128 * R) rv = *(const h16x4*)(prep + (size_t)(t0 + tokv) * 2048 + 5 * 256 + rowbase + r8 * 4);
#pragma unroll
    for (int i = 0; i < 10; ++i) {
        const int e = i * 256 + lt, tok = e / 80, rem = e - tok * 80, vec = rem >> 4, sub = rem & 15;
        f32x4 f = h4f(raw[i]);
        if (vec == 1) { f[0] = __expf(-f[0]); f[1] = __expf(-f[1]); f[2] = __expf(-f[2]); f[3] = __expf(-f[3]); }
        *(LAS f32x4*)(sh + ((tok * 16 + sub) * 5 + vec) * 4) = f;
    }
    if (lt < 128 * R) *(LAS f32x4*)(buf + RW_VB + (tokv * 32 + r8 * 4) * 4) = h4f(rv);
}
template <int R> __device__ __forceinline__ void rwkv_scan(const Params& p, int item, LAS unsigned char* lds, const int tidx) {
    constexpr int NQ = 4 / R;
    const int b = item / (4 * NQ), h = (item / NQ) & 3, q2 = item % NQ;
    const int tid = tidx, wid = tid >> 6, lane = tid & 63, lt = tid - 256;
    const h16* prep = (const h16*)p.out;
    h16* mix = (h16*)(p.ws + OFF_MIX);
    const int rowbase = h * 64 + q2 * 16 * R, tb = b * SEQ_;
    const bool loader = wid >= 4;
    const int rowl = (wid & 3) * 4 + (lane >> 4), sub = lane & 15;
    LAS float* dump = (LAS float*)(lds + LDS_BYTES - 8192) + tid;
    f32x4 Sa = {0.f, 0.f, 0.f, 0.f}, Sb = {0.f, 0.f, 0.f, 0.f};
    __syncthreads();
    if (loader) rwkv_load<R>(prep, tb, h, rowbase, lds, lt);
    __syncthreads();
#pragma unroll 1
    for (int c = 0; c < SEQ_ / CH; ++c) {
        LAS unsigned char* buf = lds + (c & 1) * RW_STRIDE;
        if (loader) {
            if (c + 1 < SEQ_ / CH) rwkv_load<R>(prep, tb + (c + 1) * CH, h, rowbase, lds + ((c + 1) & 1) * RW_STRIDE, lt);
            if (c > 0) plain_write_y<R>(mix, tb + (c - 1) * CH, rowbase, lds + ((c - 1) & 1) * RW_STRIDE + RW_YB, lt);
        } else {
            const LAS float* sh = (const LAS float*)(buf + RW_SH);
            const LAS float* vb = (const LAS float*)(buf + RW_VB);
            LAS float* yb = (LAS float*)(buf + RW_YB);
            const LAS f32x4* q0 = (const LAS f32x4*)(sh + sub * 20);
            f32x4 nkk = q0[0], nw = q0[1], nbb = q0[2], nk = q0[3], nr = q0[4];
            float nva = vb[rowl], nvb = vb[rowl + 16];
#pragma unroll 4
            for (int s = 0; s < CH; ++s) {
                const f32x4 kk = nkk, w = nw, bb = nbb, k = nk, r = nr;
                const float va = nva, vbb = nvb;
                const LAS f32x4* q = (const LAS f32x4*)(sh + ((s + 1) * 16 + sub) * 20);
                nkk = q[0]; nw = q[1]; nbb = q[2]; nk = q[3]; nr = q[4];
                nva = vb[(s + 1) * 32 + rowl]; if (R == 2) nvb = vb[(s + 1) * 32 + rowl + 16];
                const float da = sum16(dot4(Sa, kk));
                Sa = Sa * w + (k * va - bb * da);
                const float ya = sum16(dot4(Sa, r));
                LAS float* wp = (sub == 0) ? (yb + s * 32 + rowl) : dump;
                wp[0] = ya;
                if (R == 2) {
                    const float db = sum16(dot4(Sb, kk));
                    Sb = Sb * w + (k * vbb - bb * db);
                    wp[16] = sum16(dot4(Sb, r));
                }
            }
        }
        __syncthreads();
    }
    if (loader) plain_write_y<R>(mix, tb + (SEQ_ / CH - 1) * CH, rowbase, lds + ((SEQ_ / CH - 1) & 1) * RW_STRIDE + RW_YB, lt);
}

constexpr int HG_SH = 0, HG_VB = CH * 16 * 12 * 4, HG_YB = HG_VB + CH * 32 * 4, HG_STRIDE = HG_YB + CH * 32 * 4;
template <int R> __device__ __forceinline__ void hgrn_load(const h16* proj, int t0, int h, int rowbase, f32x4 lb, LAS unsigned char* buf, int lt) {
    LAS float* sh = (LAS float*)(buf + HG_SH);
    h16x4 rq[2], rf[2];
#pragma unroll
    for (int i = 0; i < 2; ++i) {
        const int e = i * 256 + lt, tok = e >> 4, sub = e & 15;
        const h16* row = proj + (size_t)(t0 + tok) * NP + h * 64 + sub * 4;
        rq[i] = *(const h16x4*)(row + C_HQ); rf[i] = *(const h16x4*)(row + C_HF);
    }
    const int tokv = lt / (4 * R), r8 = lt & (4 * R - 1);
    h16x4 rv = {(h16)0.f, (h16)0.f, (h16)0.f, (h16)0.f};
    if (lt < 128 * R) rv = *(const h16x4*)(proj + (size_t)(t0 + tokv) * NP + C_HI + rowbase + r8 * 4);
#pragma unroll
    for (int i = 0; i < 2; ++i) {
        const int e = i * 256 + lt, tok = e >> 4, sub = e & 15;
        const f32x4 qv = h4f(rq[i]), fv = h4f(rf[i]);
        f32x4 fo, ko, qo;
#pragma unroll
        for (int j = 0; j < 4; ++j) { const float fg = lb[j] + (1.0f - lb[j]) * sigmoidf_(fv[j]); fo[j] = fg; ko[j] = 1.0f - fg; qo[j] = siluf_(qv[j]); }
        LAS f32x4* d = (LAS f32x4*)(sh + (tok * 16 + sub) * 12);
        d[0] = fo; d[1] = ko; d[2] = qo;
    }
    if (lt < 128 * R) *(LAS f32x4*)(buf + HG_VB + (tokv * 32 + r8 * 4) * 4) = h4f(rv);
}
template <int R> __device__ __forceinline__ void hgrn_scan(const Params& p, int l, int item, LAS unsigned char* lds, const int tidx) {
    constexpr int NQ = 4 / R;
    const int b = item / (4 * NQ), h = (item / NQ) & 3, q2 = item % NQ;
    const int tid = tidx, wid = tid >> 6, lane = tid & 63, lt = tid - 256;
    const h16* proj = (const h16*)(p.ws + OFF_BIG);
    h16* mix = (h16*)(p.ws + OFF_MIX);
    const int rowbase = h * 64 + q2 * 32, tb = b * SEQ_;
    const bool loader = wid >= 4;
    const int rowl = (wid & 3) * 4 + (lane >> 4), sub = lane & 15;
    LAS float* dump = (LAS float*)(lds + LDS_BYTES - 8192) + tid;
    f32x4 lb = {0.f, 0.f, 0.f, 0.f};
    if (l > 0) {
#pragma unroll
        for (int j = 0; j < 4; ++j) { const int ch = h * 64 + (lt & 15) * 4 + j; lb[j] = sigmoidf_(p.in[I_LB][256 + ch] - p.in[I_LB][ch]); }
    }
    f32x4 Sa = {0.f, 0.f, 0.f, 0.f}, Sb = {0.f, 0.f, 0.f, 0.f};
    __syncthreads();
    if (loader) hgrn_load<R>(proj, tb, h, rowbase, lb, lds, lt);
    __syncthreads();
#pragma unroll 1
    for (int c = 0; c < SEQ_ / CH; ++c) {
        LAS unsigned char* buf = lds + (c & 1) * HG_STRIDE;
        if (loader) {
            if (c + 1 < SEQ_ / CH) hgrn_load<R>(proj, tb + (c + 1) * CH, h, rowbase, lb, lds + ((c + 1) & 1) * HG_STRIDE, lt);
            if (c > 0) plain_write_y<R>(mix, tb + (c - 1) * CH, 768 + rowbase, lds + ((c - 1) & 1) * HG_STRIDE + HG_YB, lt);
        } else {
            const LAS float* sh = (const LAS float*)(buf + HG_SH);
            const LAS float* vb = (const LAS float*)(buf + HG_VB);
            LAS float* yb = (LAS float*)(buf + HG_YB);
            const LAS f32x4* q0 = (const LAS f32x4*)(sh + sub * 12);
            f32x4 nf = q0[0], nk = q0[1], nq = q0[2];
            float nva = vb[rowl], nvb = vb[rowl + 16];
#pragma unroll 4
            for (int s = 0; s < CH; ++s) {
                const f32x4 f = nf, k = nk, qq = nq;
                const float va = nva, vbb = nvb;
                const LAS f32x4* q = (const LAS f32x4*)(sh + ((s + 1) * 16 + sub) * 12);
                nf = q[0]; nk = q[1]; nq = q[2];
                nva = vb[(s + 1) * 32 + rowl]; if (R == 2) nvb = vb[(s + 1) * 32 + rowl + 16];
                Sa = Sa * f + k * va;
                const float ya = sum16(dot4(Sa, qq));
                LAS float* wp = (sub == 0) ? (yb + s * 32 + rowl) : dump;
                wp[0] = ya;
                if (R == 2) { Sb = Sb * f + k * vbb; wp[16] = sum16(dot4(Sb, qq)); }
            }
        }
        __syncthreads();
    }
    if (loader) plain_write_y<R>(mix, tb + (SEQ_ / CH - 1) * CH, 768 + rowbase, lds + ((SEQ_ / CH - 1) & 1) * HG_STRIDE + HG_YB, lt);
}

constexpr int SD_SH = 0, SD_XDT = CH * 16 * 16 * 4, SD_XS = SD_XDT + CH * 32 * 4, SD_AB = SD_XS + CH * 32 * 4, SD_YB = SD_AB + CH * 4, SD_STRIDE = SD_YB + CH * 32 * 4;
struct SsdW { f32x4 w[4], b; };
__device__ __forceinline__ SsdW ssd_wload(const Params& p, int l, int ch) {
    SsdW r; const float* cw = p.in[I_CW] + (size_t)l * 4 * 768 + ch;
#pragma unroll
    for (int j = 0; j < 4; ++j) r.w[j] = *(const f32x4*)(cw + j * 768);
    r.b = *(const f32x4*)(p.in[I_CB] + l * 768 + ch);
    return r;
}
__device__ __forceinline__ f32x4 silu4(f32x4 a) { f32x4 o; o[0] = siluf_(a[0]); o[1] = siluf_(a[1]); o[2] = siluf_(a[2]); o[3] = siluf_(a[3]); return o; }
template <int R> __device__ __forceinline__ void ssd_load(const h16* proj, int t0, int h, const SsdW& wbc, int chbc, const SsdW& wxs, int chxs, float dtb, float Ah, LAS unsigned char* buf, int lt) {
    LAS float* sh = (LAS float*)(buf + SD_SH);
    const int gi = lt & 63, tq = lt >> 6, vec = gi >> 5, gj = gi & 31;
    const int tA = t0 + tq * 8, posA = tA & (SEQ_ - 1);
    h16x4 rows[11];
#pragma unroll
    for (int j = 0; j < 11; ++j) rows[j] = (posA - 3 + j >= 0) ? *(const h16x4*)(proj + (size_t)(tA - 3 + j) * NP + C_SX + chbc) : (h16x4){(h16)0.f, (h16)0.f, (h16)0.f, (h16)0.f};
    const int tokx = (lt / (4 * R)) & 31, r8 = lt & (4 * R - 1), tX = t0 + tokx, posX = tX & (SEQ_ - 1);
    h16x4 rx[4];
#pragma unroll
    for (int j = 0; j < 4; ++j) rx[j] = (posX - 3 + j >= 0) ? *(const h16x4*)(proj + (size_t)(tX - 3 + j) * NP + C_SX + chxs) : (h16x4){(h16)0.f, (h16)0.f, (h16)0.f, (h16)0.f};
    const float dtraw = (float)proj[(size_t)tX * NP + C_SDT + h];
#pragma unroll
    for (int j = 0; j < 8; ++j) {
        f32x4 acc = wbc.b;
#pragma unroll
        for (int k = 0; k < 4; ++k) acc += h4f(rows[j + k]) * wbc.w[k];
        *(LAS f32x4*)(sh + ((tq * 8 + j) * 16 + (gj >> 1)) * 16 + vec * 8 + (gj & 1) * 4) = silu4(acc);
    }
    {
        f32x4 acc = wxs.b;
#pragma unroll
        for (int k = 0; k < 4; ++k) acc += h4f(rx[k]) * wxs.w[k];
        const f32x4 xs = silu4(acc);
        const float dt = softplusf_(dtraw + dtb);
        if (lt < 128 * R) {
            *(LAS f32x4*)(buf + SD_XS + (tokx * 32 + r8 * 4) * 4) = xs;
            *(LAS f32x4*)(buf + SD_XDT + (tokx * 32 + r8 * 4) * 4) = xs * dt;
            if (r8 == 0) *(LAS float*)(buf + SD_AB + tokx * 4) = __expf(dt * Ah);
        }
    }
}
template <int R> __device__ __forceinline__ void ssd_write_y(const h16* proj, h16* mix, int t0, int cc0, LAS unsigned char* ybuf, int lt) {
    if (lt >= 128 * R) return;
    const int tok = lt / (4 * R), r8 = lt & (4 * R - 1), cc = cc0 + r8 * 4;
    const f32x4 y = *(const LAS f32x4*)(ybuf + (tok * 32 + r8 * 4) * 4);
    const f32x4 z = h4f(*(const h16x4*)(proj + (size_t)(t0 + tok) * NP + C_SZ + cc));
    *(h16x4*)(mix + (size_t)(t0 + tok) * DM + 512 + cc) = f4h(y * silu4(z));
}
template <int R> __device__ __forceinline__ void ssd_scan(const Params& p, int l, int item, LAS unsigned char* lds, const int tidx) {
    constexpr int NQ = 4 / R;
    const int b = item / (4 * NQ), h = (item / NQ) & 3, q2 = item % NQ;
    const int tid = tidx, wid = tid >> 6, lane = tid & 63, lt = tid - 256;
    const h16* proj = (const h16*)(p.ws + OFF_BIG);
    h16* mix = (h16*)(p.ws + OFF_MIX);
    const int tb = b * SEQ_, cc0 = h * 64 + q2 * 16 * R;
    const bool loader = wid >= 4;
    const int rowl = (wid & 3) * 4 + (lane >> 4), sub = lane & 15;
    LAS float* dump = (LAS float*)(lds + LDS_BYTES - 8192) + tid;
    const float dtb = p.in[I_DTB][l * 4 + h], Ah = -__expf(p.in[I_ALOG][l * 4 + h]), Dh = p.in[I_SD][l * 4 + h];
    const int chbc = 256 + ((lt & 63) >> 5) * 256 + (h >> 1) * 128 + (lt & 31) * 4, chxs = cc0 + (lt & (4 * R - 1)) * 4;
    SsdW wbc, wxs;
    if (loader) { wbc = ssd_wload(p, l, chbc); wxs = ssd_wload(p, l, chxs); }
    f32x4 Sa0 = {0.f, 0.f, 0.f, 0.f}, Sa1 = Sa0, Sb0 = Sa0, Sb1 = Sa0;
    __syncthreads();
    if (loader) ssd_load<R>(proj, tb, h, wbc, chbc, wxs, chxs, dtb, Ah, lds, lt);
    __syncthreads();
#pragma unroll 1
    for (int c = 0; c < SEQ_ / CH; ++c) {
        LAS unsigned char* buf = lds + (c & 1) * SD_STRIDE;
        if (loader) {
            if (c + 1 < SEQ_ / CH) ssd_load<R>(proj, tb + (c + 1) * CH, h, wbc, chbc, wxs, chxs, dtb, Ah, lds + ((c + 1) & 1) * SD_STRIDE, lt);
            if (c > 0) ssd_write_y<R>(proj, mix, tb + (c - 1) * CH, cc0, lds + ((c - 1) & 1) * SD_STRIDE + SD_YB, lt);
        } else {
            const LAS float* sh = (const LAS float*)(buf + SD_SH);
            const LAS float* xdt = (const LAS float*)(buf + SD_XDT);
            const LAS float* xsb = (const LAS float*)(buf + SD_XS);
            const LAS float* ab = (const LAS float*)(buf + SD_AB);
            LAS float* yb = (LAS float*)(buf + SD_YB);
            const LAS f32x4* q0 = (const LAS f32x4*)(sh + sub * 16);
            f32x4 nB0 = q0[0], nB1 = q0[1], nC0 = q0[2], nC1 = q0[3];
            float na = ab[0], nxda = xdt[rowl], nxdb = xdt[rowl + 16], nxsa = xsb[rowl], nxsb = xsb[rowl + 16];
#pragma unroll 4
            for (int s = 0; s < CH; ++s) {
                const f32x4 B0 = nB0, B1 = nB1, C0 = nC0, C1 = nC1;
                const float a = na, xda = nxda, xdb = nxdb, xsa = nxsa, xsb2 = nxsb;
                const LAS f32x4* q = (const LAS f32x4*)(sh + ((s + 1) * 16 + sub) * 16);
                nB0 = q[0]; nB1 = q[1]; nC0 = q[2]; nC1 = q[3];
                na = ab[s + 1]; nxda = xdt[(s + 1) * 32 + rowl]; nxsa = xsb[(s + 1) * 32 + rowl];
                if (R == 2) { nxdb = xdt[(s + 1) * 32 + rowl + 16]; nxsb = xsb[(s + 1) * 32 + rowl + 16]; }
                Sa0 = Sa0 * a + B0 * xda; Sa1 = Sa1 * a + B1 * xda;
                const float ya = sum16(dot4(Sa0, C0) + dot4(Sa1, C1)) + Dh * xsa;
                LAS float* wp = (sub == 0) ? (yb + s * 32 + rowl) : dump;
                wp[0] = ya;
                if (R == 2) {
                    Sb0 = Sb0 * a + B0 * xdb; Sb1 = Sb1 * a + B1 * xdb;
                    wp[16] = sum16(dot4(Sb0, C0) + dot4(Sb1, C1)) + Dh * xsb2;
                }
            }
        }
        __syncthreads();
    }
    if (loader) ssd_write_y<R>(proj, mix, tb + (SEQ_ / CH - 1) * CH, cc0, lds + ((SEQ_ / CH - 1) & 1) * SD_STRIDE + SD_YB, lt);
}

__device__ __forceinline__ void attn_item(const Params& p, int item, const int tidx) {
    const int b = item / 192, rem = item - b * 192, h = rem / 48, s = rem - h * 48;
    int br, dil, r, n;
    if (s < 16) { br = 0; dil = 1; r = 0; n = s; } else if (s < 32) { br = 1; dil = 4; r = (s - 16) >> 2; n = (s - 16) & 3; } else { br = 2; dil = 16; r = s - 32; n = 0; }
    const int tid = tidx, wid = tid >> 6, lane = tid & 63, c16 = lane & 15, g = lane >> 4;
    const h16* base = (const h16*)(p.ws + OFF_BIG) + (size_t)b * SEQ_ * NP;
    const int tq = (n * 128 + 16 * wid + c16) * dil + r;
    h16x8 qf0 = *(const h16x8*)(base + (size_t)tq * NP + C_AQ + h * 64 + g * 8);
    h16x8 qf1 = *(const h16x8*)(base + (size_t)tq * NP + C_AQ + h * 64 + 32 + g * 8);
    f32x4 sc[9];
    h16x8 kf0[9], kf1[9];
    h16x4 vreg[36];
#pragma unroll
    for (int kt = 0; kt < 9; ++kt) {
        int kp = (n - 1) * 128 + 16 * wid + 16 * kt + c16; kp = kp < 0 ? 0 : kp;
        const h16* kr = base + (size_t)(kp * dil + r) * NP + C_AK + h * 64 + g * 8;
        kf0[kt] = *(const h16x8*)kr; kf1[kt] = *(const h16x8*)(kr + 32);
    }
#pragma unroll
    for (int kt = 0; kt < 9; ++kt)
#pragma unroll
        for (int rg = 0; rg < 4; ++rg) {
            int kp = (n - 1) * 128 + 16 * wid + 16 * kt + 4 * g + rg; kp = kp < 0 ? 0 : kp;
            vreg[kt * 4 + rg] = *(const h16x4*)(base + (size_t)(kp * dil + r) * NP + C_AV + h * 64 + 4 * c16);
        }
    __builtin_amdgcn_sched_barrier(0);
#pragma unroll
    for (int kt = 0; kt < 9; ++kt) {
        f32x4 a = {0.f, 0.f, 0.f, 0.f};
        a = __builtin_amdgcn_mfma_f32_16x16x32_f16(kf0[kt], qf0, a, 0, 0, 0);
        a = __builtin_amdgcn_mfma_f32_16x16x32_f16(kf1[kt], qf1, a, 0, 0, 0);
        sc[kt] = a;
    }
    const float slope = exp2f(-2.0f * (float)(h + 1)) * (float)dil;
    float m = -INFINITY;
#pragma unroll
    for (int kt = 0; kt < 9; ++kt)
#pragma unroll
        for (int rg = 0; rg < 4; ++rg) {
            const int jj = 16 * kt + 4 * g + rg, dist = 128 + c16 - jj;
            const bool valid = (dist >= 0) && (dist <= 128) && (n > 0 || (16 * wid + jj) >= 128);
            const float v = valid ? (sc[kt][rg] * 0.125f - slope * (float)dist) : -INFINITY;
            sc[kt][rg] = v; m = fmaxf(m, v);
        }
    m = fmaxf(m, __shfl_xor(m, 16)); m = fmaxf(m, __shfl_xor(m, 32));
    float lsum = 0.f;
#pragma unroll
    for (int kt = 0; kt < 9; ++kt)
#pragma unroll
        for (int rg = 0; rg < 4; ++rg) { const float e = __expf(sc[kt][rg] - m); sc[kt][rg] = e; lsum += e; }
    lsum += __shfl_xor(lsum, 16); lsum += __shfl_xor(lsum, 32);
    f32x4 o[4];
#pragma unroll
    for (int d = 0; d < 4; ++d) o[d] = (f32x4){0.f, 0.f, 0.f, 0.f};
#pragma unroll
    for (int kt = 0; kt < 9; ++kt)
#pragma unroll
        for (int rg = 0; rg < 4; ++rg) {
            const f32x4 v = h4f(vreg[kt * 4 + rg]);
#pragma unroll
            for (int d = 0; d < 4; ++d) o[d] = __builtin_amdgcn_mfma_f32_16x16x4f32(sc[kt][rg], v[d], o[d], 0, 0, 0);
        }
    h16* dst; int ld, co;
    if (br == 0) { dst = (h16*)(p.ws + OFF_MIX); ld = DM; co = 256; } else { dst = (h16*)(p.ws + (br == 1 ? OFF_O2 : OFF_O3)); ld = 256; co = 0; }
    float* lse = (float*)(p.ws + OFF_LSE) + (size_t)br * T_ * 4;
#pragma unroll
    for (int rg = 0; rg < 4; ++rg) {
        const int q = 4 * g + rg;
        const float inv = __builtin_amdgcn_rcpf(__shfl(lsum, q));
        const int t = b * SEQ_ + (n * 128 + 16 * wid + q) * dil + r;
        h16x4 ov; ov[0] = (h16)(o[0][rg] * inv); ov[1] = (h16)(o[1][rg] * inv); ov[2] = (h16)(o[2][rg] * inv); ov[3] = (h16)(o[3][rg] * inv);
        *(h16x4*)(dst + (size_t)t * ld + co + h * 64 + 4 * c16) = ov;
    }
    if (g == 0) lse[(size_t)(b * SEQ_ + tq) * 4 + h] = m + __logf(lsum);
}

__device__ __forceinline__ void mix_phase(const Params& p, int l, int cidx, int imask, LAS unsigned char* lds, const int tidx) {
    unsigned* ctr = (unsigned*)(p.ws + OFF_MISC) + cidx;
    LAS unsigned* slot = (LAS unsigned*)(lds + LDS_BYTES - 16);
    for (;;) {
        __syncthreads();
        if (tidx == 0) *slot = atomicAdd(ctr, 1u);
        __syncthreads();
        const int it = (int)*slot;
        constexpr int NA = 128 / R_RWKV, NB = 128 / R_SSD, NC = 128 / R_HGRN;
        if (it >= NA + NB + NC + 1536) break;
        int t2 = tidx; asm volatile("" : "+v"(t2));
        if (it < NA) { if (imask & 1) rwkv_scan<R_RWKV>(p, it, lds, t2); }
        else if (it < NA + NB) { if (imask & 2) ssd_scan<R_SSD>(p, l, it - NA, lds, t2); }
        else if (it < NA + NB + NC) { if (imask & 4) hgrn_scan<R_HGRN>(p, l, it - NA - NB, lds, t2); }
        else if (imask & 8) attn_item(p, it - NA - NB - NC, t2);
    }
}

__device__ __forceinline__ void post_phase(const Params& p, int l, const int tidx) {
    const int wid = tidx >> 6, lane = tidx & 63;
    h16* mix = (h16*)(p.ws + OFF_MIX);
    const h16* prep = (const h16*)p.out;
    const h16* proj = (const h16*)(p.ws + OFF_BIG);
    const h16* o2 = (const h16*)(p.ws + OFF_O2);
    const h16* o3 = (const h16*)(p.ws + OFF_O3);
    const float* lse = (const float*)(p.ws + OFF_LSE);
    const f32x4 snw = *(const f32x4*)(p.in[I_SNW] + l * 256 + 4 * lane);
    const f32x4 hnw = *(const f32x4*)(p.in[I_HNW] + l * 256 + 4 * lane);
    const int hd = lane >> 4;
    for (int t = blockIdx.x * 8 + wid; t < T_; t += gridDim.x * 8) {
        h16* mr = mix + (size_t)t * DM + 4 * lane;
        {
            const f32x4 y = h4f(*(const h16x4*)mr);
            const float mu = sum16(y[0] + y[1] + y[2] + y[3]) * (1.0f / 64.0f);
            const f32x4 d = y - mu;
            const float var = sum16(d[0] * d[0] + d[1] * d[1] + d[2] * d[2] + d[3] * d[3]) * (1.0f / 64.0f);
            const float rstd = rsqrtf(var + 64e-5f);
            const f32x4 A = h4f(*(const h16x4*)(prep + (size_t)t * 2048 + 1536 + 4 * lane));
            const f32x4 Bc = h4f(*(const h16x4*)(prep + (size_t)t * 2048 + 1792 + 4 * lane));
            *(h16x4*)mr = f4h(d * rstd * A + Bc);
        }
        {
            const f32x4 a1 = h4f(*(const h16x4*)(mr + 256));
            const f32x4 a2 = h4f(*(const h16x4*)(o2 + (size_t)t * 256 + 4 * lane));
            const f32x4 a3 = h4f(*(const h16x4*)(o3 + (size_t)t * 256 + 4 * lane));
            const float l1 = lse[(size_t)t * 4 + hd], l2 = lse[(size_t)(T_ + t) * 4 + hd], l3 = lse[(size_t)(2 * T_ + t) * 4 + hd];
            const float mx = fmaxf(l1, fmaxf(l2, l3));
            const float w1 = __expf(l1 - mx), w2 = __expf(l2 - mx), w3 = __expf(l3 - mx);
            const float inv = __builtin_amdgcn_rcpf(w1 + w2 + w3);
            *(h16x4*)(mr + 256) = f4h((a1 * w1 + a2 * w2 + a3 * w3) * inv);
        }
        {
            const f32x4 u = h4f(*(const h16x4*)(mr + 512));
            float ss = sum16(u[0] * u[0] + u[1] * u[1] + u[2] * u[2] + u[3] * u[3]);
            ss += __shfl_xor(ss, 16);
            const float rstd = rsqrtf(ss * (1.0f / 128.0f) + 1e-5f);
            *(h16x4*)(mr + 512) = f4h(u * rstd * snw);
        }
        {
            const f32x4 u = h4f(*(const h16x4*)(mr + 768));
            const float ss = sum16(u[0] * u[0] + u[1] * u[1] + u[2] * u[2] + u[3] * u[3]);
            const float rstd = rsqrtf(ss * (1.0f / 64.0f) + 1e-5f);
            const f32x4 gz = h4f(*(const h16x4*)(proj + (size_t)t * NP + C_HG + 4 * lane));
            f32x4 gt; gt[0] = siluf_(gz[0]); gt[1] = siluf_(gz[1]); gt[2] = siluf_(gz[2]); gt[3] = siluf_(gz[3]);
            *(h16x4*)(mr + 768) = f4h(u * rstd * hnw * gt);
        }
    }
}

__device__ __forceinline__ void ln_phase(const Params& p, const float* w, const float* bvec, bool final_out, const int tidx) {
    const int wid = tidx >> 6, lane = tidx & 63;
    h16* x16 = (h16*)(p.ws + OFF_X16);
    f32x4 wv[4], bv[4];
#pragma unroll
    for (int q = 0; q < 4; ++q) { wv[q] = *(const f32x4*)(w + lane * 16 + 4 * q); bv[q] = *(const f32x4*)(bvec + lane * 16 + 4 * q); }
    for (int t = blockIdx.x * 8 + wid; t < T_; t += gridDim.x * 8) {
        h16* row = x16 + (size_t)t * DM + lane * 16;
        const h16x8 v0 = *(const h16x8*)row, v1 = *(const h16x8*)(row + 8);
        float x[16];
#pragma unroll
        for (int j = 0; j < 8; ++j) { x[j] = (float)v0[j]; x[8 + j] = (float)v1[j]; }
        float s = 0.f;
#pragma unroll
        for (int j = 0; j < 16; ++j) s += x[j];
        const float mu = sum64(s) * (1.0f / 1024.0f);
        float q2 = 0.f;
#pragma unroll
        for (int j = 0; j < 16; ++j) { x[j] -= mu; q2 += x[j] * x[j]; }
        const float rstd = rsqrtf(sum64(q2) * (1.0f / 1024.0f) + 1e-5f);
#pragma unroll
        for (int j = 0; j < 16; ++j) x[j] = x[j] * rstd * wv[j >> 2][j & 3] + bv[j >> 2][j & 3];
        if (final_out) {
            float* orow = p.out + (size_t)t * DM + lane * 16;
#pragma unroll
            for (int q = 0; q < 4; ++q) *(f32x4*)(orow + 4 * q) = (f32x4){x[4 * q], x[4 * q + 1], x[4 * q + 2], x[4 * q + 3]};
        } else {
            h16x8 o0, o1;
#pragma unroll
            for (int j = 0; j < 8; ++j) { o0[j] = (h16)x[j]; o1[j] = (h16)x[8 + j]; }
            *(h16x8*)row = o0; *(h16x8*)(row + 8) = o1;
        }
    }
}

constexpr int NPHASE = 19;
__device__ __forceinline__ void run_phase(const Params& p, int ph, LAS unsigned char* lds, const int tidx, const int rep) {
    const int l = (ph == 0) ? 0 : (ph - 1) / 9, s = (ph == 0) ? -1 : (ph - 1) % 9;
    h16* x16 = (h16*)(p.ws + OFF_X16);
    h16* mix = (h16*)(p.ws + OFF_MIX);
    h16* big = (h16*)(p.ws + OFF_BIG);
    if (ph == 0) {
        if (blockIdx.x == 0) for (int i = tidx; i < 256 + 3456; i += 512) ((unsigned*)(p.ws + OFF_MISC))[i] = 0u;
        conv_x(p, tidx);
    }
    if (s == 0 || s == 4 || s == 6 || s == 7) {
        const h16* A = (s == 0 || s == 6) ? x16 : (s == 4 ? mix : big);
        const h16* Bt = (const h16*)(p.ws + (s == 0 ? OFF_WIN : s == 4 ? OFF_WOUT : s == 6 ? OFF_WUP : OFF_WDN));
        const int N = (s == 0) ? NP : (s == 6 ? DFF : DM), K = (s == 7) ? DFF : DM;
        h16* O = (s == 0 || s == 6) ? big : x16;
        run_gemm(lds, A, Bt, N, K, O, N, (s == 0) ? 0 : (s == 6 ? 1 : 2), tidx);
    }
    if (s == 1) pre_phase(p, l, lds, tidx);
    if (s == 2) mix_phase(p, l, 2 * rep + l, rep ? DUPITEMS : 15, lds, tidx);
    if (s == 3) post_phase(p, l, tidx);
    if (s == 5 || s == 8) ln_phase(p, p.in[s == 5 ? I_LN1W : I_LN2W] + l * DM, p.in[s == 5 ? I_LN1B : I_LN2B] + l * DM, s == 8 && l == 1, tidx);
    if (ph == 0 || (s == 8 && l == 0)) conv_weights(p, ph == 0 ? 0 : 1, lds, tidx);
}

__global__ void __launch_bounds__(512, 2) k_phase(Params p, int ph) {
    extern __shared__ __attribute__((aligned(16))) unsigned char shm[];
    const int tidx = threadIdx.x;
    run_phase(p, ph, (LAS unsigned char*)shm, tidx, 0);
}

#define XB_TMO      128
#define XB_XCNT(j)  (256  + 64 * (j))
#define XB_XSUB(j)  (1280 + 64 * (j))
#define XB_XGEN(j)  (2304 + 64 * (j))
#define XB_TOP      3328
#define XB_TOPGEN   3392
#define XCD_BAR_WORDS 3456
#define XB_SPIN_CAP (1u << 18)

__device__ __forceinline__ unsigned xb_ld(unsigned* p)              { return __hip_atomic_load(p, __ATOMIC_RELAXED, __HIP_MEMORY_SCOPE_AGENT); }
__device__ __forceinline__ unsigned xb_add(unsigned* p, unsigned v) { return __hip_atomic_fetch_add(p, v, __ATOMIC_RELAXED, __HIP_MEMORY_SCOPE_AGENT); }
__device__ __forceinline__ unsigned xb_xcc_id() { return (unsigned)__builtin_amdgcn_s_getreg((3 << 11) | 20) & 0xFu; }
#define XB_SPIN(cond, bar) do { unsigned _sp = 0; while (cond) { __builtin_amdgcn_s_sleep(1); \
    if ((++_sp & 255u) == 0u) { if (xb_ld(&(bar)[XB_TMO])) break; if (_sp > XB_SPIN_CAP) { atomicAdd(&(bar)[XB_TMO], 1u); break; } } } } while (0)

struct XcdBarrier {
    unsigned* bar; unsigned x;
    volatile LAS unsigned* st;
};

__device__ __forceinline__ XcdBarrier xcd_barrier_post(unsigned* bar, volatile LAS unsigned* st) {
    XcdBarrier b; b.bar = bar; b.x = xb_xcc_id(); b.st = st;
    if (threadIdx.x == 0) (void)xb_add(&bar[XB_XCNT(b.x)], 1u);
    return b;
}
__device__ __forceinline__ void xcd_barrier_complete(unsigned* bar, unsigned x, unsigned& nloc, unsigned& nx) {
    const unsigned G = gridDim.x * gridDim.y * gridDim.z;
    unsigned sum, cnt, mine, sp = 0u;
    for (;;) {
        sum = 0u; cnt = 0u; mine = 0u;
#pragma unroll
        for (unsigned j = 0; j < 16; ++j) { const unsigned c = xb_ld(&bar[XB_XCNT(j)]); sum += c; cnt += (c > 0u) ? 1u : 0u; mine = (j == x) ? c : mine; }
        if (sum == G) break;
        __builtin_amdgcn_s_sleep(1);
        if ((++sp & 255u) == 0u) { if (xb_ld(&bar[XB_TMO])) break; if (sp > XB_SPIN_CAP) { atomicAdd(&bar[XB_TMO], 1u); break; } }
    }
    nloc = mine > 0u ? mine : 1u; nx = cnt > 0u ? cnt : 1u;
}

__device__ __forceinline__ void xcd_barrier(const XcdBarrier& b) {
    asm volatile("s_waitcnt vmcnt(0)" ::: "memory");
    __syncthreads();
    if (threadIdx.x == 0) {
        unsigned* bar = b.bar;
        __builtin_amdgcn_s_waitcnt(0);
        unsigned nloc = b.st[0], nx = b.st[1];
        if (nloc == 0u) { xcd_barrier_complete(bar, b.x, nloc, nx); b.st[0] = nloc; b.st[1] = nx; }
        const unsigned old = xb_add(&bar[XB_XSUB(b.x)], 1u);
        const unsigned gen = old / nloc;
        if (old + 1u == (gen + 1u) * nloc) {
            __builtin_amdgcn_fence(__ATOMIC_RELEASE, "agent");
            asm volatile("s_waitcnt vmcnt(0)" ::: "memory");
            const unsigned og = xb_add(&bar[XB_TOP], 1u);
            const unsigned tg = og / nx;
            if (og + 1u == (tg + 1u) * nx) xb_add(&bar[XB_TOPGEN], 1u);
            else XB_SPIN(xb_ld(&bar[XB_TOPGEN]) == tg, bar);
            __builtin_amdgcn_fence(__ATOMIC_ACQUIRE, "agent");
            xb_add(&bar[XB_XGEN(b.x)], 1u);
            asm volatile("s_waitcnt vmcnt(0)" ::: "memory");
        } else {
            XB_SPIN(xb_ld(&bar[XB_XGEN(b.x)]) == gen, bar);
            __builtin_amdgcn_fence(__ATOMIC_ACQUIRE, "agent");
            asm volatile("s_waitcnt vmcnt(0)" ::: "memory");
        }
    }
    __syncthreads();
}


#ifndef DUPITEMS
#define DUPITEMS 15
#endif
#ifndef DUPMASK
#define DUPMASK 0
#endif
#if COOP
__global__ void __launch_bounds__(512, 2) k_mega(Params p) {
    extern __shared__ __attribute__((aligned(16))) unsigned char shm[];
    cg::grid_group grid = cg::this_grid();
    unsigned* barw = (unsigned*)(p.ws + OFF_MISC + 1024);
    volatile LAS unsigned* xst = (volatile LAS unsigned*)((LAS unsigned char*)shm + LDS_BYTES);
    if (threadIdx.x < 4) xst[threadIdx.x] = 0u;
    XcdBarrier xb; xb.bar = barw; xb.x = 0; xb.st = xst;
#pragma unroll 1
    for (int ph = 0; ph < NPHASE; ++ph) {
        const int nrep = ((DUPMASK >> ph) & 1) ? 2 : 1;
#pragma unroll 1
        for (int rep = 0; rep < nrep; ++rep) {
            int tidx = threadIdx.x; asm volatile("" : "+v"(tidx));
            run_phase(p, ph, (LAS unsigned char*)shm, tidx, rep);
            if (ph == 0) { grid.sync(); xb = xcd_barrier_post(barw, xst); }
            else if (ph + 1 < NPHASE) xcd_barrier(xb);
        }
#ifdef EXTRA_SYNCS
        if (ph == 1) for (int i = 0; i < EXTRA_SYNCS; ++i) xcd_barrier(xb);
#endif
    }
}
#endif

extern "C" void kernel_launch(void* const* d_in, const int* in_sizes, int n_in, void* d_out, int out_size, void* d_ws, size_t ws_size, hipStream_t stream) {
    static int grid_blocks = 0;
    if (!grid_blocks) {
        int dev = 0, cus = 0, per_cu = 0;
        hipGetDevice(&dev);
        hipDeviceGetAttribute(&cus, hipDeviceAttributeMultiprocessorCount, dev);
        hipFuncSetAttribute((const void*)k_phase, hipFuncAttributeMaxDynamicSharedMemorySize, LDS_TOTAL);
#if COOP
        hipFuncSetAttribute((const void*)k_mega, hipFuncAttributeMaxDynamicSharedMemorySize, LDS_TOTAL);
        hipOccupancyMaxActiveBlocksPerMultiprocessor(&per_cu, (const void*)k_mega, 512, LDS_TOTAL);
#endif
        if (per_cu < 1) per_cu = 1;
        grid_blocks = cus * 1;
        (void)hipGetLastError();
    }
    Params p{};
    for (int i = 0; i < 32; ++i) p.in[i] = (const float*)d_in[i];
    p.out = (float*)d_out; p.ws = (unsigned char*)d_ws;
#if COOP
    void* args[] = {&p};
    hipError_t e = hipLaunchCooperativeKernel((const void*)k_mega, dim3(grid_blocks), dim3(512), args, LDS_TOTAL, stream);
    if (e != hipSuccess) fprintf(stderr, "cooperative launch failed: %s (grid %d)\n", hipGetErrorString(e), grid_blocks);
#else
    for (int ph = 0; ph < NPHASE; ++ph) k_phase<<<dim3(grid_blocks), dim3(512), LDS_TOTAL, stream>>>(p, ph);
#endif
}
```

```cpp
#include <hip/hip_runtime.h>
#include <hip/hip_cooperative_groups.h>
#include <cstdio>
namespace cg = cooperative_groups;

#ifndef COOP
#define COOP 1
#endif
#ifndef DUPITEMS
#define DUPITEMS 15
#endif
#ifndef R_RWKV
#define R_RWKV 2
#endif
#ifndef R_SSD
#define R_SSD 2
#endif
#ifndef R_HGRN
#define R_HGRN 2
#endif

#define LAS __attribute__((address_space(3)))
typedef _Float16 h16;
typedef _Float16 h16x4 __attribute__((ext_vector_type(4)));
typedef _Float16 h16x8 __attribute__((ext_vector_type(8)));
typedef float f32x2 __attribute__((ext_vector_type(2)));
typedef float f32x4 __attribute__((ext_vector_type(4)));

constexpr int T_ = 16384, SEQ_ = 2048, DM = 1024, NP = 3840, DFF = 4096, INC = 3716;
constexpr int C_R = 0, C_K = 256, C_V = 512, C_FW = 768, C_VR = 896, C_AQ = 928, C_AK = 1184, C_AV = 1440;
constexpr int C_SZ = 1696, C_SX = 1952, C_SDT = 2720, C_HQ = 2728, C_HF = 2984, C_HI = 3240, C_HG = 3496;
constexpr float ALPHA_ = 1.41421356237f;
constexpr size_t OFF_WIN = 0, OFF_WOUT = 7864320, OFF_WUP = OFF_WOUT + 2097152, OFF_WDN = OFF_WUP + 8388608;
constexpr size_t OFF_X16 = 26738688, OFF_MIX = OFF_X16 + 33554432, OFF_BIG = OFF_MIX + 33554432;
constexpr size_t OFF_VF = OFF_BIG + 134217728, OFF_O2 = OFF_VF + 8388608, OFF_O3 = OFF_O2 + 8388608, OFF_LSE = OFF_O3 + 8388608;
constexpr size_t OFF_MISC = OFF_LSE + 786432;
constexpr int LDS_BYTES = 131072, LDS_TOTAL = 131072 + 64;

struct Params { const float* in[32]; float* out; unsigned char* ws; };

enum { I_X = 0, I_LB, I_WIN, I_WINV, I_MU, I_MUV, I_W0, I_W2, I_A0, I_A2, I_G2, I_KK, I_KA, I_RK, I_LNW, I_LNB, I_V0, I_V2,
       I_CW, I_CB, I_DTB, I_ALOG, I_SD, I_SNW, I_HNW, I_WOUT, I_LN1W, I_LN1B, I_WUP, I_WDN, I_LN2W, I_LN2B };

template <int CTRL> __device__ __forceinline__ float dpp_f(float x) {
    return __builtin_bit_cast(float, __builtin_amdgcn_update_dpp(0, __builtin_bit_cast(int, x), CTRL, 0xF, 0xF, true));
}
__device__ __forceinline__ float sum16(float x) {
    x += dpp_f<0xB1>(x);
    x += dpp_f<0x4E>(x);
    x += dpp_f<0x141>(x);
    x += dpp_f<0x140>(x);
    return x;
}
__device__ __forceinline__ float sum64(float x) { x = sum16(x); x += __shfl_xor(x, 16); x += __shfl_xor(x, 32); return x; }
__device__ __forceinline__ float sigmoidf_(float x) { return __builtin_amdgcn_rcpf(1.0f + __expf(-x)); }
__device__ __forceinline__ float siluf_(float x) { return x * __builtin_amdgcn_rcpf(1.0f + __expf(-x)); }
__device__ __forceinline__ float softplusf_(float x) { return fmaxf(x, 0.f) + __logf(1.0f + __expf(-fabsf(x))); }
__device__ __forceinline__ f32x4 h4f(h16x4 v) { return (f32x4){(float)v[0], (float)v[1], (float)v[2], (float)v[3]}; }
__device__ __forceinline__ h16x4 f4h(f32x4 v) { return (h16x4){(h16)v[0], (h16)v[1], (h16)v[2], (h16)v[3]}; }

namespace pg8 {
constexpr int BM = 256, BK = 64, HALF = 128, HTB = HALF * BK * 2, STAGE_BYTES = 8 * HTB, NXCD = 8, WGM = 8;
__host__ __device__ __forceinline__ int lds_byte(int r, int c) { const int st = (r >> 4) * 2 + (c >> 5), rr = r & 15, cc = c & 31, ob = rr * 64 + cc * 2; return st * 1024 + (ob ^ (((ob >> 9) & 1) << 5)); }
__host__ __device__ __forceinline__ void stage_rc(int b, int& R, int& C) { const int st = b / 1024, sb = b % 1024, swz = sb ^ (((sb >> 9) & 1) << 5); R = (st >> 1) * 16 + swz / 64; C = (st & 1) * 32 + (swz % 64) / 2; }
__host__ __device__ __forceinline__ int perm32(int rho) { const int n = rho >> 4, i = rho & 15; return 8 * (i >> 2) + 4 * n + (i & 3); }
struct Unit { int pm, pn; };
struct Gemm { const h16* A; const h16* Bt; int M, N, K; };
struct StaticOrder {
    int nM, nN, nwg, G, c;
    __device__ void init(int M, int N, int G_, int c_) { nM = M / BM; nN = N / BM; nwg = nM * nN; G = G_; c = c_; }
    __device__ bool next(int i, Unit& u) const {
        const long L = (long)i * G + c; if (L >= nwg) return false;
        int wgid = (int)L; { const int q = nwg / NXCD, r = nwg % NXCD, xcd = wgid % NXCD, off = wgid / NXCD; wgid = (xcd < r ? xcd * (q + 1) : r * (q + 1) + (xcd - r) * q) + off; }
        const int nig = WGM * nN, gid = wgid / nig, fm = gid * WGM, gsz = (nM - fm) < WGM ? (nM - fm) : WGM;
        u.pm = fm + ((wgid % nig) % gsz); u.pn = (wgid % nig) / gsz; return true;
    }
};
struct EpiH {
    h16* O; int ldc; int MODE;
    __device__ __forceinline__ void operator()(const f32x4 (&acc)[2][2][4][2], const Unit& u, int wr, int wc, int fr, int fq) const {
        const int row0 = u.pm * BM + wr * 64 + fr, col0 = u.pn * BM + wc * 32 + 8 * fq;
#pragma unroll
        for (int ai = 0; ai < 2; ++ai)
#pragma unroll
            for (int m = 0; m < 4; ++m) { h16* rowp = O + (size_t)(row0 + ai * HALF + m * 16) * ldc + col0;
#pragma unroll
                for (int bj = 0; bj < 2; ++bj) { f32x4 v0 = acc[ai][bj][m][0], v1 = acc[ai][bj][m][1];
                    if (MODE == 1) {
#pragma unroll
                        for (int j = 0; j < 4; ++j) { float a = fmaxf(v0[j], 0.f), b = fmaxf(v1[j], 0.f); v0[j] = a * a; v1[j] = b * b; } }
                    if (MODE == 2) { const h16x8 x = *(const h16x8*)(rowp + bj * HALF);
#pragma unroll
                        for (int j = 0; j < 4; ++j) { v0[j] += ALPHA_ * (float)x[j]; v1[j] += ALPHA_ * (float)x[4 + j]; } }
                    h16x8 w;
#pragma unroll
                    for (int j = 0; j < 4; ++j) { w[j] = (h16)v0[j]; w[4 + j] = (h16)v1[j]; }
                    *(h16x8*)(rowp + bj * HALF) = w; } }
    }
};

template <class Epi>
__device__ __forceinline__ void gemm_phase(LAS unsigned char* lds, const Gemm g, const StaticOrder& S, const Epi& E, const int tidx) {
    const int tid = tidx, wid = __builtin_amdgcn_readfirstlane(tid >> 6), lane = tid & 63, wr = wid >> 2, wc = wid & 3, fr = lane & 15, fq = lane >> 4;
    const int K = g.K, nt = K / BK;
    unsigned voffA[2], voffB[2];
#pragma unroll
    for (int i = 0; i < 2; ++i) { int R, C; stage_rc(tid * 16 + i * 8192, R, C); const int Rb = (R & ~31) + perm32(R & 31);
        voffA[i] = (unsigned)(R * K + C) * 2u; voffB[i] = (unsigned)(Rb * K + C) * 2u; }
    const size_t kstep = (size_t)(BK * 2);
    const size_t hstep = (size_t)HALF * K * 2;
    const size_t tstep = 2 * hstep;
    const unsigned ldsw = (unsigned)wid * 1024u;
    const int aoff = lds_byte(wr * 64 + fr, fq * 8), boff = lds_byte(wc * 32 + fr, fq * 8);
#define PG8_SA(b, h) (((b) * 2 + (h)) * HTB)
#define PG8_SB(b, h) ((4 + (b) * 2 + (h)) * HTB)
#define PG8_STAGE(bufoff, gbase, voff) do { _Pragma("unroll") for (int _i = 0; _i < 2; ++_i) \
        __builtin_amdgcn_global_load_lds((const unsigned*)((const char*)(gbase) + (voff)[_i]), (LAS unsigned*)(lds + (bufoff) + ldsw + _i * 8192), 16, 0, 0); } while (0)
#define PG8_LDA(dst, b, h) do { _Pragma("unroll") for (int m = 0; m < 4; ++m) _Pragma("unroll") for (int k = 0; k < 2; ++k) dst[m][k] = *(const LAS h16x8*)(lds + PG8_SA(b, h) + aoff + m * 2048 + k * 1024); } while (0)
#define PG8_LDB(dst, b, h) do { _Pragma("unroll") for (int n = 0; n < 2; ++n) _Pragma("unroll") for (int k = 0; k < 2; ++k) dst[n][k] = *(const LAS h16x8*)(lds + PG8_SB(b, h) + boff + n * 2048 + k * 1024); } while (0)
#define PG8_MMA(ai, bj, At, Bt) do { __builtin_amdgcn_s_setprio(1); _Pragma("unroll") for (int m = 0; m < 4; ++m) _Pragma("unroll") for (int n = 0; n < 2; ++n) _Pragma("unroll") for (int k = 0; k < 2; ++k) \
        acc[ai][bj][m][n] = __builtin_amdgcn_mfma_f32_16x16x32_f16(Bt[n][k], At[m][k], acc[ai][bj][m][n], 0, 0, 0); __builtin_amdgcn_s_setprio(0); } while (0)
#define PG8_WAIT_V(n) asm volatile("s_waitcnt vmcnt(" #n ")" ::: "memory")
#define PG8_WAIT_L(n) asm volatile("s_waitcnt lgkmcnt(" #n ")" ::: "memory")
#define PG8_BAR __builtin_amdgcn_s_barrier()
#define PG8_SCHED __builtin_amdgcn_sched_barrier(0)
    Unit cur, nxt; int ui = 0;
    if (!S.next(0, cur)) return;
    f32x4 acc[2][2][4][2];
#pragma unroll
    for (int a = 0; a < 2; ++a)
#pragma unroll
        for (int b = 0; b < 2; ++b)
#pragma unroll
            for (int m = 0; m < 4; ++m)
#pragma unroll
                for (int n = 0; n < 2; ++n) acc[a][b][m][n] = (f32x4){0.f, 0.f, 0.f, 0.f};
    h16x8 At[4][2], B0[2][2], B1[2][2];
    const char* cA = (const char*)g.A + (size_t)cur.pm * tstep; const char* cB = (const char*)g.Bt + (size_t)cur.pn * tstep;
    PG8_STAGE(PG8_SB(0, 0), cB, voffB); PG8_STAGE(PG8_SA(0, 0), cA, voffA); PG8_STAGE(PG8_SB(0, 1), cB + hstep, voffB); PG8_STAGE(PG8_SA(0, 1), cA + hstep, voffA);
    if (wr == 1) PG8_BAR;
    PG8_WAIT_V(4); PG8_BAR;
    PG8_STAGE(PG8_SB(1, 0), cB + kstep, voffB); PG8_STAGE(PG8_SA(1, 0), cA + kstep, voffA); PG8_STAGE(PG8_SB(1, 1), cB + hstep + kstep, voffB);
    PG8_WAIT_V(6); PG8_BAR;
    for (;;) {
        const bool has_next = S.next(ui + 1, nxt);
        const char* nA = has_next ? (const char*)g.A + (size_t)nxt.pm * tstep : cA; const char* nB = has_next ? (const char*)g.Bt + (size_t)nxt.pn * tstep : cB;
        for (int t = 0; t < nt; t += 2) {
            const bool last = (t == nt - 2);
            const char* a1 = cA + (size_t)(t + 1) * kstep;
            const char* a2 = last ? nA : cA + (size_t)(t + 2) * kstep; const char* b2 = last ? nB : cB + (size_t)(t + 2) * kstep;
            const char* a3 = a2 + kstep; const char* b3 = b2 + kstep;
            PG8_LDB(B0, 0, 0); PG8_SCHED; PG8_LDA(At, 0, 0); PG8_STAGE(PG8_SA(1, 1), a1 + hstep, voffA);
            PG8_WAIT_L(8); PG8_BAR; PG8_WAIT_L(0); PG8_MMA(0, 0, At, B0); PG8_BAR; PG8_SCHED;
            PG8_LDB(B1, 0, 1); PG8_STAGE(PG8_SB(0, 0), b2, voffB);
            PG8_BAR; PG8_WAIT_L(0); PG8_MMA(0, 1, At, B1); PG8_BAR;
            PG8_LDA(At, 0, 1); PG8_STAGE(PG8_SA(0, 0), a2, voffA);
            PG8_BAR; PG8_WAIT_L(0); PG8_MMA(1, 0, At, B0); PG8_BAR; PG8_SCHED;
            PG8_STAGE(PG8_SB(0, 1), b2 + hstep, voffB);
            PG8_WAIT_V(6); PG8_BAR; PG8_MMA(1, 1, At, B1); PG8_BAR;
            PG8_LDB(B0, 1, 0); PG8_SCHED; PG8_LDA(At, 1, 0); PG8_STAGE(PG8_SA(0, 1), a2 + hstep, voffA);
            PG8_WAIT_L(8); PG8_BAR; PG8_WAIT_L(0); PG8_MMA(0, 0, At, B0); PG8_BAR; PG8_SCHED;
            PG8_LDB(B1, 1, 1); PG8_STAGE(PG8_SB(1, 0), b3, voffB);
            PG8_BAR; PG8_WAIT_L(0); PG8_MMA(0, 1, At, B1); PG8_BAR;
            PG8_LDA(At, 1, 1); PG8_STAGE(PG8_SA(1, 0), a3, voffA);
            PG8_BAR; PG8_WAIT_L(0); PG8_MMA(1, 0, At, B0); PG8_BAR; PG8_SCHED;
            PG8_STAGE(PG8_SB(1, 1), b3 + hstep, voffB);
            PG8_WAIT_V(6); PG8_BAR; PG8_MMA(1, 1, At, B1); PG8_BAR;
        }
        E(acc, cur, wr, wc, fr, fq);
        if (!has_next) break;
#pragma unroll
        for (int a = 0; a < 2; ++a)
#pragma unroll
            for (int b = 0; b < 2; ++b)
#pragma unroll
                for (int m = 0; m < 4; ++m)
#pragma unroll
                    for (int n = 0; n < 2; ++n) acc[a][b][m][n] = (f32x4){0.f, 0.f, 0.f, 0.f};
        cur = nxt; cA = nA; cB = nB; ++ui;
    }
    PG8_WAIT_V(0);
    if (wr == 0) PG8_BAR;
    PG8_BAR;
#undef PG8_SA
#undef PG8_SB
#undef PG8_STAGE
#undef PG8_LDA
#undef PG8_LDB
#undef PG8_MMA
#undef PG8_WAIT_V
#undef PG8_WAIT_L
#undef PG8_BAR
#undef PG8_SCHED
}
}

__device__ __forceinline__ void run_gemm(LAS unsigned char* lds, const h16* A, const h16* Bt, int N, int K, h16* O, int ldc, int mode, const int tidx) {
    pg8::Gemm g; g.A = A; g.Bt = Bt; g.M = T_; g.N = N; g.K = K;
    pg8::StaticOrder S; S.init(T_, N, (int)gridDim.x, (int)blockIdx.x);
    pg8::EpiH E; E.O = O; E.ldc = ldc; E.MODE = mode;
    pg8::gemm_phase(lds, g, S, E, tidx);
}

__device__ __forceinline__ void conv_weights(const Params& p, int l, LAS unsigned char* lds, const int tidx) {
    LAS float* tile = (LAS float*)lds;
    const int tid = tidx;
    for (int id = blockIdx.x; id < 3264; id += gridDim.x) {
        int mat, tl;
        if (id < 960) { mat = 0; tl = id; } else if (id < 1216) { mat = 1; tl = id - 960; } else if (id < 2240) { mat = 2; tl = id - 1216; } else { mat = 3; tl = id - 2240; }
        const int K = (mat == 3) ? 4096 : 1024;
        const int nkt = K / 64;
        const int n0 = (tl / nkt) * 64, k0 = (tl % nkt) * 64;
        h16* dst = (h16*)(p.ws + (mat == 0 ? OFF_WIN : mat == 1 ? OFF_WOUT : mat == 2 ? OFF_WUP : OFF_WDN));
        __syncthreads();
        {
            const int nj = tid & 63, n = n0 + nj;
            const float* src = nullptr; int sstride = 0;
            if (mat == 0) {
                if (n < 896) { src = p.in[I_WIN] + (size_t)l * DM * INC + n; sstride = INC; }
                else if (n < 928) { if (l > 0) { src = p.in[I_WINV] + (size_t)(l - 1) * DM * 32 + (n - 896); sstride = 32; } }
                else if (n < 2724) { src = p.in[I_WIN] + (size_t)l * DM * INC + (n - 32); sstride = INC; }
                else if (n < 2728) { }
                else if (n < 3752) { src = p.in[I_WIN] + (size_t)l * DM * INC + (n - 36); sstride = INC; }
            } else if (mat == 1) { src = p.in[I_WOUT] + (size_t)l * 1024 * 1024 + n; sstride = 1024; }
            else if (mat == 2) { src = p.in[I_WUP] + (size_t)l * 1024 * 4096 + n; sstride = 4096; }
            else { src = p.in[I_WDN] + (size_t)l * 4096 * 1024 + n; sstride = 1024; }
#pragma unroll
            for (int i = 0; i < 8; ++i) { const int ki = (tid >> 6) + 8 * i; tile[ki * 65 + nj] = src ? src[(size_t)(k0 + ki) * sstride] : 0.f; }
        }
        __syncthreads();
        {
            const int ki = tid & 63;
#pragma unroll
            for (int i = 0; i < 8; ++i) { const int nj = (tid >> 6) + 8 * i; dst[(size_t)(n0 + nj) * K + k0 + ki] = (h16)tile[ki * 65 + nj]; }
        }
    }
    __syncthreads();
}

__device__ __forceinline__ void conv_x(const Params& p, const int tidx) {
    const f32x4* src = (const f32x4*)p.in[I_X]; h16x4* dst = (h16x4*)(p.ws + OFF_X16);
    for (size_t i = (size_t)blockIdx.x * 512 + tidx; i < (size_t)T_ * DM / 4; i += (size_t)gridDim.x * 512) dst[i] = f4h(src[i]);
}

__device__ __forceinline__ void pre_phase(const Params& p, int l, LAS unsigned char* lds, const int tidx) {
    constexpr int RS = 168;
    LAS h16* A16 = (LAS h16*)lds;
    LAS h16* W16 = (LAS h16*)(lds + 64 * RS * 2);
    const h16* proj = (const h16*)(p.ws + OFF_BIG);
    h16* prep = (h16*)p.out;
    h16* vfirst = (h16*)(p.ws + OFF_VF);
    const int tid = tidx, wid = tid >> 6, lane = tid & 63, c16 = lane & 15, g = lane >> 4, hh = wid & 3, mh = wid >> 2;
    const int nact = (l == 0) ? 128 : 160;
    __syncthreads();
#pragma unroll 1
    for (int e0 = 0; e0 < nact * 256; e0 += 512 * 16) {
        float wv16[16];
#pragma unroll
        for (int u = 0; u < 16; ++u) {
            const int e = e0 + u * 512 + tid, i = e >> 8, cc = e & 255;
            const float* sp;
            if (i < 32) sp = p.in[I_W2] + (size_t)(l * 32 + i) * 256 + cc;
            else if (i < 64) sp = p.in[I_A2] + (size_t)(l * 32 + i - 32) * 256 + cc;
            else if (i < 128) sp = p.in[I_G2] + (size_t)(l * 64 + i - 64) * 256 + cc;
            else sp = p.in[I_V2] + (size_t)((l - 1) * 32 + i - 128) * 256 + cc;
            wv16[u] = *sp;
        }
#pragma unroll
        for (int u = 0; u < 16; ++u) { const int e = e0 + u * 512 + tid; W16[(e & 255) * RS + (e >> 8)] = (h16)wv16[u]; }
    }
    float mu_r[4], mu_k[4], mu_v[4], w0[4], a0[4], k_k[4], k_a[4], r_k[4], lnw[4], lnb[4], v0[4];
#pragma unroll
    for (int nt = 0; nt < 4; ++nt) {
        const int ch = hh * 64 + nt * 16 + c16;
        mu_r[nt] = p.in[I_MU][l * 896 + ch]; mu_k[nt] = p.in[I_MU][l * 896 + 256 + ch]; mu_v[nt] = p.in[I_MU][l * 896 + 512 + ch];
        w0[nt] = p.in[I_W0][l * 256 + ch]; a0[nt] = p.in[I_A0][l * 256 + ch]; k_k[nt] = p.in[I_KK][l * 256 + ch]; k_a[nt] = p.in[I_KA][l * 256 + ch];
        r_k[nt] = p.in[I_RK][l * 256 + ch]; lnw[nt] = p.in[I_LNW][l * 256 + ch]; lnb[nt] = p.in[I_LNB][l * 256 + ch];
        v0[nt] = (l > 0) ? p.in[I_V0][(l - 1) * 256 + ch] : 0.f;
    }
    for (int tt = blockIdx.x; tt < T_ / 64; tt += gridDim.x) {
        const int t0 = tt * 64;
        __syncthreads();
#pragma unroll 1
        for (int eb = 0; eb < 20; eb += 10) {
            float curv[10], prvv[10];
#pragma unroll
            for (int u = 0; u < 10; ++u) {
                const int e = (eb + u) * 512 + tid, tok = e / 160, i = e - tok * 160, t = t0 + tok;
                curv[u] = 0.f; prvv[u] = 0.f;
                if (i < nact) {
                    curv[u] = (float)proj[(size_t)t * NP + C_FW + i];
                    if (t & (SEQ_ - 1)) prvv[u] = (float)proj[(size_t)(t - 1) * NP + C_FW + i];
                }
            }
#pragma unroll
            for (int u = 0; u < 10; ++u) {
                const int e = (eb + u) * 512 + tid, tok = e / 160, i = e - tok * 160;
                if (i < nact) {
                    const float mu = (i < 128) ? p.in[I_MU][l * 896 + 768 + i] : p.in[I_MUV][(l - 1) * 32 + (i - 128)];
                    const float f = curv[u] + (prvv[u] - curv[u]) * mu;
                    float a = f;
                    if (i < 32) { const float e2 = __expf(-2.0f * fabsf(f)); const float th = (1.0f - e2) * __builtin_amdgcn_rcpf(1.0f + e2); a = f < 0.f ? -th : th; } else if (i >= 64 && i < 128) a = sigmoidf_(f);
                    A16[tok * RS + i] = (h16)a;
                }
            }
        }
        __syncthreads();
#pragma unroll 1
        for (int mt = 0; mt < 2; ++mt) {
            const int tokb = mh * 32 + mt * 16;
            f32x4 aw[4], aa[4], ag[4], av[4];
            {
                const LAS h16* ar = A16 + (tokb + c16) * RS + 8 * g;
                const h16x8 A0 = *(const LAS h16x8*)(ar), A1 = *(const LAS h16x8*)(ar + 32), A2 = *(const LAS h16x8*)(ar + 64), A3 = *(const LAS h16x8*)(ar + 96);
                h16x8 A4 = A0; if (l > 0) A4 = *(const LAS h16x8*)(ar + 128);
#pragma unroll
                for (int nt = 0; nt < 4; ++nt) {
                    const LAS h16* br = W16 + (hh * 64 + nt * 16 + c16) * RS + 8 * g;
                    const f32x4 z = {0.f, 0.f, 0.f, 0.f};
                    aw[nt] = __builtin_amdgcn_mfma_f32_16x16x32_f16(A0, *(const LAS h16x8*)(br), z, 0, 0, 0);
                    aa[nt] = __builtin_amdgcn_mfma_f32_16x16x32_f16(A1, *(const LAS h16x8*)(br + 32), z, 0, 0, 0);
                    ag[nt] = __builtin_amdgcn_mfma_f32_16x16x32_f16(A2, *(const LAS h16x8*)(br + 64), z, 0, 0, 0);
                    ag[nt] = __builtin_amdgcn_mfma_f32_16x16x32_f16(A3, *(const LAS h16x8*)(br + 96), ag[nt], 0, 0, 0);
                    av[nt] = z;
                    if (l > 0) av[nt] = __builtin_amdgcn_mfma_f32_16x16x32_f16(A4, *(const LAS h16x8*)(br + 128), z, 0, 0, 0);
                }
            }
#pragma unroll
            for (int rp = 0; rp < 2; ++rp) {
            h16 lr[8], lk[8], lv[8], lpr[8], lpk[8], lpv[8], lvf[8];
#pragma unroll
            for (int r2 = 0; r2 < 2; ++r2) {
                const int t = t0 + tokb + 4 * g + rp * 2 + r2;
                const h16* row = proj + (size_t)t * NP + hh * 64 + c16;
#pragma unroll
                for (int nt = 0; nt < 4; ++nt) {
                    const int q = r2 * 4 + nt;
                    lr[q] = row[C_R + nt * 16]; lk[q] = row[C_K + nt * 16]; lv[q] = row[C_V + nt * 16];
                    lpr[q] = (h16)0.f; lpk[q] = (h16)0.f; lpv[q] = (h16)0.f; lvf[q] = (h16)0.f;
                    if (t & (SEQ_ - 1)) { lpr[q] = row[C_R + nt * 16 - NP]; lpk[q] = row[C_K + nt * 16 - NP]; lpv[q] = row[C_V + nt * 16 - NP]; }
                    if (l > 0) lvf[q] = vfirst[(size_t)t * 256 + hh * 64 + nt * 16 + c16];
                }
            }
#pragma unroll
            for (int r2 = 0; r2 < 2; ++r2) {
                const int rg = rp * 2 + r2;
                const int t = t0 + tokb + 4 * g + rg;
                float rr[4], kp[4], vv[4], kkr[4], aS[4], ee[4];
                float n2 = 0.f, bn = 0.f;
#pragma unroll
                for (int nt = 0; nt < 4; ++nt) {
                    const int q = r2 * 4 + nt;
                    float r = (float)lr[q], k = (float)lk[q], v = (float)lv[q];
                    r += ((float)lpr[q] - r) * mu_r[nt]; k += ((float)lpk[q] - k) * mu_k[nt]; v += ((float)lpv[q] - v) * mu_v[nt];
                    const float wl = w0[nt] + aw[nt][rg];
                    ee[nt] = __expf(-softplusf_(-wl) - 0.5f);
                    const float a = sigmoidf_(a0[nt] + aa[nt][rg]);
                    if (l == 0) vfirst[(size_t)t * 256 + hh * 64 + nt * 16 + c16] = (h16)v;
                    else v += ((float)lvf[q] - v) * sigmoidf_(v0[nt] + av[nt][rg]);
                    kkr[nt] = k * k_k[nt];
                    kp[nt] = k * (1.0f + (a - 1.0f) * k_a[nt]);
                    rr[nt] = r; vv[nt] = v; aS[nt] = a;
                    n2 += kkr[nt] * kkr[nt]; bn += r * kp[nt] * r_k[nt];
                }
                n2 = sum16(n2); bn = sum16(bn);
                const float rn = __builtin_amdgcn_rsqf(fmaxf(n2, 1e-24f));
#pragma unroll
                for (int nt = 0; nt < 4; ++nt) {
                    const float kk = kkr[nt] * rn, gg = ag[nt][rg];
                    h16* o = prep + (size_t)t * 2048 + hh * 64 + nt * 16 + c16;
                    o[0] = (h16)rr[nt]; o[256] = (h16)ee[nt]; o[512] = (h16)kp[nt]; o[768] = (h16)kk; o[1024] = (h16)(kk * aS[nt]); o[1280] = (h16)vv[nt];
                    o[1536] = (h16)(lnw[nt] * gg); o[1792] = (h16)((lnb[nt] + bn * vv[nt]) * gg);
                }
            }
            }
        }
    }
    __syncthreads();
}

constexpr int CH = 32;

__device__ __forceinline__ float dot4(f32x4 a, f32x4 b) { f32x2 p = (f32x2){a[0], a[1]} * (f32x2){b[0], b[1]}; p = __builtin_elementwise_fma((f32x2){a[2], a[3]}, (f32x2){b[2], b[3]}, p); return p[0] + p[1]; }
template <int R> __device__ __forceinline__ void plain_write_y(h16* mix, int t0, int col, LAS unsigned char* ybuf, int lt) {
    if (lt >= 128 * R) return;
    const int tok = lt / (4 * R), r8 = lt & (4 * R - 1);
    const f32x4 y = *(const LAS f32x4*)(ybuf + (tok * 32 + r8 * 4) * 4);
    *(h16x4*)(mix + (size_t)(t0 + tok) * DM + col + r8 * 4) = f4h(y);
}

constexpr int RW_SH = 0, RW_VB = CH * 16 * 20 * 4, RW_YB = RW_VB + CH * 32 * 4, RW_STRIDE = RW_YB + CH * 32 * 4;
template <int R> __device__ __forceinline__ void rwkv_load(const h16* prep, int t0, int h, int rowbase, LAS unsigned char* buf, int lt) {
    LAS float* sh = (LAS float*)(buf + RW_SH);
    h16x4 raw[10];
#pragma unroll
    for (int i = 0; i < 10; ++i) {
        const int e = i * 256 + lt, tok = e / 80, rem = e - tok * 80, vec = rem >> 4, sub = rem & 15;
        const int pv = (vec == 0) ? 3 : (vec == 1) ? 1 : (vec == 2) ? 4 : (vec == 3) ? 2 : 0;
        raw[i] = *(const h16x4*)(prep + (size_t)(t0 + tok) * 2048 + pv * 256 + h * 64 + sub * 4);
    }
    const int tokv = lt / (4 * R), r8 = lt & (4 * R - 1);
    h16x4 rv = {(h16)0.f, (h16)0.f, (h16)0.f, (h16)0.f};
    if (lt < 128 * R) rv = *(const h16x4*)(prep + (size_t)(t0 + tokv) * 2048 + 5 * 256 + rowbase + r8 * 4);
#pragma unroll
    for (int i = 0; i < 10; ++i) {
        const int e = i * 256 + lt, tok = e / 80, rem = e - tok * 80, vec = rem >> 4, sub = rem & 15;
        f32x4 f = h4f(raw[i]);
        if (vec == 1) { f[0] = __expf(-f[0]); f[1] = __expf(-f[1]); f[2] = __expf(-f[2]); f[3] = __expf(-f[3]); }
        *(LAS f32x4*)(sh + ((tok * 16 + sub) * 5 + vec) * 4) = f;
    }
    if (lt < 128 * R) *(LAS f32x4*)(buf + RW_VB + (tokv * 32 + r8 * 4) * 4) = h4f(rv);
}
template <int R> __device__ __forceinline__ void rwkv_scan(const Params& p, int item, LAS unsigned char* lds, const int tidx) {
    constexpr int NQ = 4 / R;
    const int b = item / (4 * NQ), h = (item / NQ) & 3, q2 = item % NQ;
    const int tid = tidx, wid = tid >> 6, lane = tid & 63, lt = tid - 256;
    const h16* prep = (const h16*)p.out;
    h16* mix = (h16*)(p.ws + OFF_MIX);
    const int rowbase = h * 64 + q2 * 16 * R, tb = b * SEQ_;
    const bool loader = wid >= 4;
    const int rowl = (wid & 3) * 4 + (lane >> 4), sub = lane & 15;
    LAS float* dump = (LAS float*)(lds + LDS_BYTES - 8192) + tid;
    f32x4 Sa = {0.f, 0.f, 0.f, 0.f}, Sb = {0.f, 0.f, 0.f, 0.f};
    __syncthreads();
    if (loader) rwkv_load<R>(prep, tb, h, rowbase, lds, lt);
    __syncthreads();
#pragma unroll 1
    for (int c = 0; c < SEQ_ / CH; ++c) {
        LAS unsigned char* buf = lds + (c & 1) * RW_STRIDE;
        if (loader) {
            if (c + 1 < SEQ_ / CH) rwkv_load<R>(prep, tb + (c + 1) * CH, h, rowbase, lds + ((c + 1) & 1) * RW_STRIDE, lt);
            if (c > 0) plain_write_y<R>(mix, tb + (c - 1) * CH, rowbase, lds + ((c - 1) & 1) * RW_STRIDE + RW_YB, lt);
        } else {
            const LAS float* sh = (const LAS float*)(buf + RW_SH);
            const LAS float* vb = (const LAS float*)(buf + RW_VB);
            LAS float* yb = (LAS float*)(buf + RW_YB);
            const LAS f32x4* q0 = (const LAS f32x4*)(sh + sub * 20);
            f32x4 nkk = q0[0], nw = q0[1], nbb = q0[2], nk = q0[3], nr = q0[4];
            float nva = vb[rowl], nvb = vb[rowl + 16];
#pragma unroll 4
            for (int s = 0; s < CH; ++s) {
                const f32x4 kk = nkk, w = nw, bb = nbb, k = nk, r = nr;
                const float va = nva, vbb = nvb;
                const LAS f32x4* q = (const LAS f32x4*)(sh + ((s + 1) * 16 + sub) * 20);
                nkk = q[0]; nw = q[1]; nbb = q[2]; nk = q[3]; nr = q[4];
                nva = vb[(s + 1) * 32 + rowl]; if (R == 2) nvb = vb[(s + 1) * 32 + rowl + 16];
                const float da = sum16(dot4(Sa, kk));
                Sa = Sa * w + (k * va - bb * da);
                const float ya = sum16(dot4(Sa, r));
                LAS float* wp = (sub == 0) ? (yb + s * 32 + rowl) : dump;
                wp[0] = ya;
                if (R == 2) {
                    const float db = sum16(dot4(Sb, kk));
                    Sb = Sb * w + (k * vbb - bb * db);
                    wp[16] = sum16(dot4(Sb, r));
                }
            }
        }
        __syncthreads();
    }
    if (loader) plain_write_y<R>(mix, tb + (SEQ_ / CH - 1) * CH, rowbase, lds + ((SEQ_ / CH - 1) & 1) * RW_STRIDE + RW_YB, lt);
}

constexpr int HG_SH = 0, HG_VB = CH * 16 * 12 * 4, HG_YB = HG_VB + CH * 32 * 4, HG_STRIDE = HG_YB + CH * 32 * 4;
template <int R> __device__ __forceinline__ void hgrn_load(const h16* proj, int t0, int h, int rowbase, f32x4 lb, LAS unsigned char* buf, int lt) {
    LAS float* sh = (LAS float*)(buf + HG_SH);
    h16x4 rq[2], rf[2];
#pragma unroll
    for (int i = 0; i < 2; ++i) {
        const int e = i * 256 + lt, tok = e >> 4, sub = e & 15;
        const h16* row = proj + (size_t)(t0 + tok) * NP + h * 64 + sub * 4;
        rq[i] = *(const h16x4*)(row + C_HQ); rf[i] = *(const h16x4*)(row + C_HF);
    }
    const int tokv = lt / (4 * R), r8 = lt & (4 * R - 1);
    h16x4 rv = {(h16)0.f, (h16)0.f, (h16)0.f, (h16)0.f};
    if (lt < 128 * R) rv = *(const h16x4*)(proj + (size_t)(t0 + tokv) * NP + C_HI + rowbase + r8 * 4);
#pragma unroll
    for (int i = 0; i < 2; ++i) {
        const int e = i * 256 + lt, tok = e >> 4, sub = e & 15;
        const f32x4 qv = h4f(rq[i]), fv = h4f(rf[i]);
        f32x4 fo, ko, qo;
#pragma unroll
        for (int j = 0; j < 4; ++j) { const float fg = lb[j] + (1.0f - lb[j]) * sigmoidf_(fv[j]); fo[j] = fg; ko[j] = 1.0f - fg; qo[j] = siluf_(qv[j]); }
        LAS f32x4* d = (LAS f32x4*)(sh + (tok * 16 + sub) * 12);
        d[0] = fo; d[1] = ko; d[2] = qo;
    }
    if (lt < 128 * R) *(LAS f32x4*)(buf + HG_VB + (tokv * 32 + r8 * 4) * 4) = h4f(rv);
}
template <int R> __device__ __forceinline__ void hgrn_scan(const Params& p, int l, int item, LAS unsigned char* lds, const int tidx) {
    constexpr int NQ = 4 / R;
    const int b = item / (4 * NQ), h = (item / NQ) & 3, q2 = item % NQ;
    const int tid = tidx, wid = tid >> 6, lane = tid & 63, lt = tid - 256;
    const h16* proj = (const h16*)(p.ws + OFF_BIG);
    h16* mix = (h16*)(p.ws + OFF_MIX);
    const int rowbase = h * 64 + q2 * 32, tb = b * SEQ_;
    const bool loader = wid >= 4;
    const int rowl = (wid & 3) * 4 + (lane >> 4), sub = lane & 15;
    LAS float* dump = (LAS float*)(lds + LDS_BYTES - 8192) + tid;
    f32x4 lb = {0.f, 0.f, 0.f, 0.f};
    if (l > 0) {
#pragma unroll
        for (int j = 0; j < 4; ++j) { const int ch = h * 64 + (lt & 15) * 4 + j; lb[j] = sigmoidf_(p.in[I_LB][256 + ch] - p.in[I_LB][ch]); }
    }
    f32x4 Sa = {0.f, 0.f, 0.f, 0.f}, Sb = {0.f, 0.f, 0.f, 0.f};
    __syncthreads();
    if (loader) hgrn_load<R>(proj, tb, h, rowbase, lb, lds, lt);
    __syncthreads();
#pragma unroll 1
    for (int c = 0; c < SEQ_ / CH; ++c) {
        LAS unsigned char* buf = lds + (c & 1) * HG_STRIDE;
        if (loader) {
            if (c + 1 < SEQ_ / CH) hgrn_load<R>(proj, tb + (c + 1) * CH, h, rowbase, lb, lds + ((c + 1) & 1) * HG_STRIDE, lt);
            if (c > 0) plain_write_y<R>(mix, tb + (c - 1) * CH, 768 + rowbase, lds + ((c - 1) & 1) * HG_STRIDE + HG_YB, lt);
        } else {
            const LAS float* sh = (const LAS float*)(buf + HG_SH);
            const LAS float* vb = (const LAS float*)(buf + HG_VB);
            LAS float* yb = (LAS float*)(buf + HG_YB);
            const LAS f32x4* q0 = (const LAS f32x4*)(sh + sub * 12);
            f32x4 nf = q0[0], nk = q0[1], nq = q0[2];
            float nva = vb[rowl], nvb = vb[rowl + 16];
#pragma unroll 4
            for (int s = 0; s < CH; ++s) {
                const f32x4 f = nf, k = nk, qq = nq;
                const float va = nva, vbb = nvb;
                const LAS f32x4* q = (const LAS f32x4*)(sh + ((s + 1) * 16 + sub) * 12);
                nf = q[0]; nk = q[1]; nq = q[2];
                nva = vb[(s + 1) * 32 + rowl]; if (R == 2) nvb = vb[(s + 1) * 32 + rowl + 16];
                Sa = Sa * f + k * va;
                const float ya = sum16(dot4(Sa, qq));
                LAS float* wp = (sub == 0) ? (yb + s * 32 + rowl) : dump;
                wp[0] = ya;
                if (R == 2) { Sb = Sb * f + k * vbb; wp[16] = sum16(dot4(Sb, qq)); }
            }
        }
        __syncthreads();
    }
    if (loader) plain_write_y<R>(mix, tb + (SEQ_ / CH - 1) * CH, 768 + rowbase, lds + ((SEQ_ / CH - 1) & 1) * HG_STRIDE + HG_YB, lt);
}

constexpr int SD_SH = 0, SD_XDT = CH * 16 * 20 * 4, SD_XS = SD_XDT + CH * 32 * 4, SD_AB = SD_XS + CH * 32 * 4, SD_YB = SD_AB + CH * 4, SD_STRIDE = SD_YB + CH * 32 * 4;
struct SsdW { f32x4 w[4], b; };
__device__ __forceinline__ SsdW ssd_wload(const Params& p, int l, int ch) {
    SsdW r; const float* cw = p.in[I_CW] + (size_t)l * 4 * 768 + ch;
#pragma unroll
    for (int j = 0; j < 4; ++j) r.w[j] = *(const f32x4*)(cw + j * 768);
    r.b = *(const f32x4*)(p.in[I_CB] + l * 768 + ch);
    return r;
}
__device__ __forceinline__ f32x4 silu4(f32x4 a) { f32x4 o; o[0] = siluf_(a[0]); o[1] = siluf_(a[1]); o[2] = siluf_(a[2]); o[3] = siluf_(a[3]); return o; }
struct SsdRaw { h16x4 rows[11]; h16x4 rx[4]; float dtraw; };
template <int R> __device__ __forceinline__ void ssd_issue(SsdRaw& rw, const h16* proj, int t0, int h, int chbc, int chxs, int lt) {
    const int tq = lt >> 6;
    const int tA = t0 + tq * 8, posA = tA & (SEQ_ - 1);
    const h16x4 hz = {(h16)0.f, (h16)0.f, (h16)0.f, (h16)0.f};
#pragma unroll
    for (int j = 0; j < 11; ++j) rw.rows[j] = (posA - 3 + j >= 0) ? *(const h16x4*)(proj + (size_t)(tA - 3 + j) * NP + C_SX + chbc) : hz;
    const int tokx = (lt / (4 * R)) & 31, tX = t0 + tokx, posX = tX & (SEQ_ - 1);
#pragma unroll
    for (int j = 0; j < 4; ++j) rw.rx[j] = (posX - 3 + j >= 0) ? *(const h16x4*)(proj + (size_t)(tX - 3 + j) * NP + C_SX + chxs) : hz;
    rw.dtraw = (float)proj[(size_t)tX * NP + C_SDT + h];
}
template <int R> __device__ __forceinline__ void ssd_commit(const SsdRaw& rw, const SsdW& wbc, const SsdW& wxs, float dtb, float Ah, LAS unsigned char* buf, int lt) {
    LAS float* sh = (LAS float*)(buf + SD_SH);
    const int gi = lt & 63, tq = lt >> 6, vec = gi >> 5, gj = gi & 31;
    const int tokx = (lt / (4 * R)) & 31, r8 = lt & (4 * R - 1);
#pragma unroll
    for (int j = 0; j < 8; ++j) {
        f32x4 acc = wbc.b;
#pragma unroll
        for (int k = 0; k < 4; ++k) acc += h4f(rw.rows[j + k]) * wbc.w[k];
        *(LAS f32x4*)(sh + ((tq * 8 + j) * 16 + (gj >> 1)) * 20 + vec * 8 + (gj & 1) * 4) = silu4(acc);
    }
    {
        f32x4 acc = wxs.b;
#pragma unroll
        for (int k = 0; k < 4; ++k) acc += h4f(rw.rx[k]) * wxs.w[k];
        const f32x4 xs = silu4(acc);
        const float dt = softplusf_(rw.dtraw + dtb);
        if (lt < 128 * R) {
            *(LAS f32x4*)(buf + SD_XS + (tokx * 32 + r8 * 4) * 4) = xs;
            *(LAS f32x4*)(buf + SD_XDT + (tokx * 32 + r8 * 4) * 4) = xs * dt;
            if (r8 == 0) *(LAS float*)(buf + SD_AB + tokx * 4) = __expf(dt * Ah);
        }
    }
}
template <int R> __device__ __forceinline__ void ssd_write_y(const h16* proj, h16* mix, int t0, int cc0, LAS unsigned char* ybuf, int lt) {
    if (lt >= 128 * R) return;
    const int tok = lt / (4 * R), r8 = lt & (4 * R - 1), cc = cc0 + r8 * 4;
    const f32x4 y = *(const LAS f32x4*)(ybuf + (tok * 32 + r8 * 4) * 4);
    const f32x4 z = h4f(*(const h16x4*)(proj + (size_t)(t0 + tok) * NP + C_SZ + cc));
    *(h16x4*)(mix + (size_t)(t0 + tok) * DM + 512 + cc) = f4h(y * silu4(z));
}
template <int R> __device__ __forceinline__ void ssd_scan(const Params& p, int l, int item, LAS unsigned char* lds, const int tidx) {
    constexpr int NQ = 4 / R;
    const int b = item / (4 * NQ), h = (item / NQ) & 3, q2 = item % NQ;
    const int tid = tidx, wid = tid >> 6, lane = tid & 63, lt = tid - 256;
    const h16* proj = (const h16*)(p.ws + OFF_BIG);
    h16* mix = (h16*)(p.ws + OFF_MIX);
    const int tb = b * SEQ_, cc0 = h * 64 + q2 * 16 * R;
    const bool loader = wid >= 4;
    const int rowl = (wid & 3) * 4 + (lane >> 4), sub = lane & 15;
    LAS float* dump = (LAS float*)(lds + LDS_BYTES - 8192) + tid;
    const float dtb = p.in[I_DTB][l * 4 + h], Ah = -__expf(p.in[I_ALOG][l * 4 + h]), Dh = p.in[I_SD][l * 4 + h];
    const int chbc = 256 + ((lt & 63) >> 5) * 256 + (h >> 1) * 128 + (lt & 31) * 4, chxs = cc0 + (lt & (4 * R - 1)) * 4;
    SsdW wbc, wxs;
    if (loader) { wbc = ssd_wload(p, l, chbc); wxs = ssd_wload(p, l, chxs); }
    f32x4 Sa0 = {0.f, 0.f, 0.f, 0.f}, Sa1 = Sa0, Sb0 = Sa0, Sb1 = Sa0;
    __syncthreads();
    SsdRaw rw;
    if (loader) { ssd_issue<R>(rw, proj, tb, h, chbc, chxs, lt); ssd_commit<R>(rw, wbc, wxs, dtb, Ah, lds, lt); ssd_issue<R>(rw, proj, tb + CH, h, chbc, chxs, lt); }
    __syncthreads();
#pragma unroll 1
    for (int c = 0; c < SEQ_ / CH; ++c) {
        LAS unsigned char* buf = lds + (c & 1) * SD_STRIDE;
        if (loader) {
            if (c + 1 < SEQ_ / CH) ssd_commit<R>(rw, wbc, wxs, dtb, Ah, lds + ((c + 1) & 1) * SD_STRIDE, lt);
            if (c + 2 < SEQ_ / CH) ssd_issue<R>(rw, proj, tb + (c + 2) * CH, h, chbc, chxs, lt);
            if (c > 0) ssd_write_y<R>(proj, mix, tb + (c - 1) * CH, cc0, lds + ((c - 1) & 1) * SD_STRIDE + SD_YB, lt);
        } else {
            const LAS float* sh = (const LAS float*)(buf + SD_SH);
            const LAS float* xdt = (const LAS float*)(buf + SD_XDT);
            const LAS float* xsb = (const LAS float*)(buf + SD_XS);
            const LAS float* ab = (const LAS float*)(buf + SD_AB);
            LAS float* yb = (LAS float*)(buf + SD_YB);
            const LAS f32x4* q0 = (const LAS f32x4*)(sh + sub * 20);
            f32x4 nB0 = q0[0], nB1 = q0[1], nC0 = q0[2], nC1 = q0[3];
            float na = ab[0], nxda = xdt[rowl], nxdb = xdt[rowl + 16], nxsa = xsb[rowl], nxsb = xsb[rowl + 16];
#pragma unroll 4
            for (int s = 0; s < CH; ++s) {
                const f32x4 B0 = nB0, B1 = nB1, C0 = nC0, C1 = nC1;
                const float a = na, xda = nxda, xdb = nxdb, xsa = nxsa, xsb2 = nxsb;
                const LAS f32x4* q = (const LAS f32x4*)(sh + ((s + 1) * 16 + sub) * 20);
                nB0 = q[0]; nB1 = q[1]; nC0 = q[2]; nC1 = q[3];
                na = ab[s + 1]; nxda = xdt[(s + 1) * 32 + rowl]; nxsa = xsb[(s + 1) * 32 + rowl];
                if (R == 2) { nxdb = xdt[(s + 1) * 32 + rowl + 16]; nxsb = xsb[(s + 1) * 32 + rowl + 16]; }
                Sa0 = Sa0 * a + B0 * xda; Sa1 = Sa1 * a + B1 * xda;
                const float ya = sum16(dot4(Sa0, C0) + dot4(Sa1, C1)) + Dh * xsa;
                LAS float* wp = (sub == 0) ? (yb + s * 32 + rowl) : dump;
                wp[0] = ya;
                if (R == 2) {
                    Sb0 = Sb0 * a + B0 * xdb; Sb1 = Sb1 * a + B1 * xdb;
                    wp[16] = sum16(dot4(Sb0, C0) + dot4(Sb1, C1)) + Dh * xsb2;
                }
            }
        }
        __syncthreads();
    }
    if (loader) ssd_write_y<R>(proj, mix, tb + (SEQ_ / CH - 1) * CH, cc0, lds + ((SEQ_ / CH - 1) & 1) * SD_STRIDE + SD_YB, lt);
}

__device__ __forceinline__ void attn_item(const Params& p, int item, int wid, const int tidx) {
    const int b = item / 192, rem = item - b * 192, h = rem / 48, s = rem - h * 48;
    int br, dil, r, n;
    if (s < 16) { br = 0; dil = 1; r = 0; n = s; } else if (s < 32) { br = 1; dil = 4; r = (s - 16) >> 2; n = (s - 16) & 3; } else { br = 2; dil = 16; r = s - 32; n = 0; }
    const int lane = tidx & 63, c16 = lane & 15, g = lane >> 4;
    const h16* base = (const h16*)(p.ws + OFF_BIG) + (size_t)b * SEQ_ * NP;
    const int tq = (n * 128 + 16 * wid + c16) * dil + r;
    h16x8 qf0 = *(const h16x8*)(base + (size_t)tq * NP + C_AQ + h * 64 + g * 8);
    h16x8 qf1 = *(const h16x8*)(base + (size_t)tq * NP + C_AQ + h * 64 + 32 + g * 8);
    f32x4 sc[9];
    h16x8 kf0[9], kf1[9];
    h16x4 vreg[36];
#pragma unroll
    for (int kt = 0; kt < 9; ++kt) {
        int kp = (n - 1) * 128 + 16 * wid + 16 * kt + c16; kp = kp < 0 ? 0 : kp;
        const h16* kr = base + (size_t)(kp * dil + r) * NP + C_AK + h * 64 + g * 8;
        kf0[kt] = *(const h16x8*)kr; kf1[kt] = *(const h16x8*)(kr + 32);
    }
#pragma unroll
    for (int kt = 0; kt < 9; ++kt)
#pragma unroll
        for (int rg = 0; rg < 4; ++rg) {
            int kp = (n - 1) * 128 + 16 * wid + 16 * kt + 4 * g + rg; kp = kp < 0 ? 0 : kp;
            vreg[kt * 4 + rg] = *(const h16x4*)(base + (size_t)(kp * dil + r) * NP + C_AV + h * 64 + 4 * c16);
        }
    __builtin_amdgcn_sched_barrier(0);
#pragma unroll
    for (int kt = 0; kt < 9; ++kt) {
        f32x4 a = {0.f, 0.f, 0.f, 0.f};
        a = __builtin_amdgcn_mfma_f32_16x16x32_f16(kf0[kt], qf0, a, 0, 0, 0);
        a = __builtin_amdgcn_mfma_f32_16x16x32_f16(kf1[kt], qf1, a, 0, 0, 0);
        sc[kt] = a;
    }
    const float slope = exp2f(-2.0f * (float)(h + 1)) * (float)dil;
    float m = -INFINITY;
#pragma unroll
    for (int kt = 0; kt < 9; ++kt)
#pragma unroll
        for (int rg = 0; rg < 4; ++rg) {
            const int jj = 16 * kt + 4 * g + rg, dist = 128 + c16 - jj;
            const bool valid = (dist >= 0) && (dist <= 128) && (n > 0 || (16 * wid + jj) >= 128);
            const float v = valid ? (sc[kt][rg] * 0.125f - slope * (float)dist) : -INFINITY;
            sc[kt][rg] = v; m = fmaxf(m, v);
        }
    m = fmaxf(m, __shfl_xor(m, 16)); m = fmaxf(m, __shfl_xor(m, 32));
    float lsum = 0.f;
#pragma unroll
    for (int kt = 0; kt < 9; ++kt)
#pragma unroll
        for (int rg = 0; rg < 4; ++rg) { const float e = __expf(sc[kt][rg] - m); sc[kt][rg] = e; lsum += e; }
    lsum += __shfl_xor(lsum, 16); lsum += __shfl_xor(lsum, 32);
    f32x4 o[4];
#pragma unroll
    for (int d = 0; d < 4; ++d) o[d] = (f32x4){0.f, 0.f, 0.f, 0.f};
#pragma unroll
    for (int kt = 0; kt < 9; ++kt)
#pragma unroll
        for (int rg = 0; rg < 4; ++rg) {
            const f32x4 v = h4f(vreg[kt * 4 + rg]);
#pragma unroll
            for (int d = 0; d < 4; ++d) o[d] = __builtin_amdgcn_mfma_f32_16x16x4f32(sc[kt][rg], v[d], o[d], 0, 0, 0);
        }
    h16* dst; int ld, co;
    if (br == 0) { dst = (h16*)(p.ws + OFF_MIX); ld = DM; co = 256; } else { dst = (h16*)(p.ws + (br == 1 ? OFF_O2 : OFF_O3)); ld = 256; co = 0; }
    float* lse = (float*)(p.ws + OFF_LSE) + (size_t)br * T_ * 4;
#pragma unroll
    for (int rg = 0; rg < 4; ++rg) {
        const int q = 4 * g + rg;
        const float inv = __builtin_amdgcn_rcpf(__shfl(lsum, q));
        const int t = b * SEQ_ + (n * 128 + 16 * wid + q) * dil + r;
        h16x4 ov; ov[0] = (h16)(o[0][rg] * inv); ov[1] = (h16)(o[1][rg] * inv); ov[2] = (h16)(o[2][rg] * inv); ov[3] = (h16)(o[3][rg] * inv);
        *(h16x4*)(dst + (size_t)t * ld + co + h * 64 + 4 * c16) = ov;
    }
    if (g == 0) lse[(size_t)(b * SEQ_ + tq) * 4 + h] = m + __logf(lsum);
}

__device__ __forceinline__ void mix_phase(const Params& p, int l, int cidx, int imask, LAS unsigned char* lds, const int tidx) {
    unsigned* ctr = (unsigned*)(p.ws + OFF_MISC) + cidx;
    unsigned* actr = (unsigned*)(p.ws + OFF_MISC) + 8 + cidx;
    LAS unsigned* slot = (LAS unsigned*)(lds + LDS_BYTES - 16);
    constexpr int NA = 128 / R_RWKV, NB = 128 / R_SSD, NC = 128 / R_HGRN;
    for (;;) {
        __syncthreads();
        if (tidx == 0) *slot = atomicAdd(ctr, 1u);
        __syncthreads();
        const int it = (int)*slot;
        if (it >= NA + NB + NC) break;
        int t2 = tidx; asm volatile("" : "+v"(t2));
        if (it < NA) { if (imask & 1) rwkv_scan<R_RWKV>(p, it, lds, t2); }
        else if (it < NA + NB) { if (imask & 2) ssd_scan<R_SSD>(p, l, it - NA, lds, t2); }
        else { if (imask & 4) hgrn_scan<R_HGRN>(p, l, it - NA - NB, lds, t2); }
    }
    if (imask & 8) {
        for (;;) {
            unsigned w = 0;
            if ((tidx & 63) == 0) w = atomicAdd(actr, 1u);
            w = (unsigned)__builtin_amdgcn_readfirstlane((int)w);
            if (w >= 1536u * 8u) break;
            int t2 = tidx; asm volatile("" : "+v"(t2));
            attn_item(p, (int)(w >> 3), (int)(w & 7u), t2);
        }
    }
}

__device__ __forceinline__ void post_phase(const Params& p, int l, const int tidx) {
    const int wid = tidx >> 6, lane = tidx & 63;
    h16* mix = (h16*)(p.ws + OFF_MIX);
    const h16* prep = (const h16*)p.out;
    const h16* proj = (const h16*)(p.ws + OFF_BIG);
    const h16* o2 = (const h16*)(p.ws + OFF_O2);
    const h16* o3 = (const h16*)(p.ws + OFF_O3);
    const float* lse = (const float*)(p.ws + OFF_LSE);
    const f32x4 snw = *(const f32x4*)(p.in[I_SNW] + l * 256 + 4 * lane);
    const f32x4 hnw = *(const f32x4*)(p.in[I_HNW] + l * 256 + 4 * lane);
    const int hd = lane >> 4;
    for (int t = blockIdx.x * 8 + wid; t < T_; t += gridDim.x * 8) {
        h16* mr = mix + (size_t)t * DM + 4 * lane;
        {
            const f32x4 y = h4f(*(const h16x4*)mr);
            const float mu = sum16(y[0] + y[1] + y[2] + y[3]) * (1.0f / 64.0f);
            const f32x4 d = y - mu;
            const float var = sum16(d[0] * d[0] + d[1] * d[1] + d[2] * d[2] + d[3] * d[3]) * (1.0f / 64.0f);
            const float rstd = rsqrtf(var + 64e-5f);
            const f32x4 A = h4f(*(const h16x4*)(prep + (size_t)t * 2048 + 1536 + 4 * lane));
            const f32x4 Bc = h4f(*(const h16x4*)(prep + (size_t)t * 2048 + 1792 + 4 * lane));
            *(h16x4*)mr = f4h(d * rstd * A + Bc);
        }
        {
            const f32x4 a1 = h4f(*(const h16x4*)(mr + 256));
            const f32x4 a2 = h4f(*(const h16x4*)(o2 + (size_t)t * 256 + 4 * lane));
            const f32x4 a3 = h4f(*(const h16x4*)(o3 + (size_t)t * 256 + 4 * lane));
            const float l1 = lse[(size_t)t * 4 + hd], l2 = lse[(size_t)(T_ + t) * 4 + hd], l3 = lse[(size_t)(2 * T_ + t) * 4 + hd];
            const float mx = fmaxf(l1, fmaxf(l2, l3));
            const float w1 = __expf(l1 - mx), w2 = __expf(l2 - mx), w3 = __expf(l3 - mx);
            const float inv = __builtin_amdgcn_rcpf(w1 + w2 + w3);
            *(h16x4*)(mr + 256) = f4h((a1 * w1 + a2 * w2 + a3 * w3) * inv);
        }
        {
            const f32x4 u = h4f(*(const h16x4*)(mr + 512));
            float ss = sum16(u[0] * u[0] + u[1] * u[1] + u[2] * u[2] + u[3] * u[3]);
            ss += __shfl_xor(ss, 16);
            const float rstd = rsqrtf(ss * (1.0f / 128.0f) + 1e-5f);
            *(h16x4*)(mr + 512) = f4h(u * rstd * snw);
        }
        {
            const f32x4 u = h4f(*(const h16x4*)(mr + 768));
            const float ss = sum16(u[0] * u[0] + u[1] * u[1] + u[2] * u[2] + u[3] * u[3]);
            const float rstd = rsqrtf(ss * (1.0f / 64.0f) + 1e-5f);
            const f32x4 gz = h4f(*(const h16x4*)(proj + (size_t)t * NP + C_HG + 4 * lane));
            f32x4 gt; gt[0] = siluf_(gz[0]); gt[1] = siluf_(gz[1]); gt[2] = siluf_(gz[2]); gt[3] = siluf_(gz[3]);
            *(h16x4*)(mr + 768) = f4h(u * rstd * hnw * gt);
        }
    }
}

__device__ __forceinline__ void ln_phase(const Params& p, const float* w, const float* bvec, bool final_out, const int tidx) {
    const int wid = tidx >> 6, lane = tidx & 63;
    h16* x16 = (h16*)(p.ws + OFF_X16);
    f32x4 wv[4], bv[4];
#pragma unroll
    for (int q = 0; q < 4; ++q) { wv[q] = *(const f32x4*)(w + lane * 16 + 4 * q); bv[q] = *(const f32x4*)(bvec + lane * 16 + 4 * q); }
    for (int t = blockIdx.x * 8 + wid; t < T_; t += gridDim.x * 8) {
        h16* row = x16 + (size_t)t * DM + lane * 16;
        const h16x8 v0 = *(const h16x8*)row, v1 = *(const h16x8*)(row + 8);
        float x[16];
#pragma unroll
        for (int j = 0; j < 8; ++j) { x[j] = (float)v0[j]; x[8 + j] = (float)v1[j]; }
        float s = 0.f;
#pragma unroll
        for (int j = 0; j < 16; ++j) s += x[j];
        const float mu = sum64(s) * (1.0f / 1024.0f);
        float q2 = 0.f;
#pragma unroll
        for (int j = 0; j < 16; ++j) { x[j] -= mu; q2 += x[j] * x[j]; }
        const float rstd = rsqrtf(sum64(q2) * (1.0f / 1024.0f) + 1e-5f);
#pragma unroll
        for (int j = 0; j < 16; ++j) x[j] = x[j] * rstd * wv[j >> 2][j & 3] + bv[j >> 2][j & 3];
        if (final_out) {
            float* orow = p.out + (size_t)t * DM + lane * 16;
#pragma unroll
            for (int q = 0; q < 4; ++q) *(f32x4*)(orow + 4 * q) = (f32x4){x[4 * q], x[4 * q + 1], x[4 * q + 2], x[4 * q + 3]};
        } else {
            h16x8 o0, o1;
#pragma unroll
            for (int j = 0; j < 8; ++j) { o0[j] = (h16)x[j]; o1[j] = (h16)x[8 + j]; }
            *(h16x8*)row = o0; *(h16x8*)(row + 8) = o1;
        }
    }
}

constexpr int NPHASE = 19;
__device__ __forceinline__ void run_phase(const Params& p, int ph, LAS unsigned char* lds, const int tidx, const int rep) {
    const int l = (ph == 0) ? 0 : (ph - 1) / 9, s = (ph == 0) ? -1 : (ph - 1) % 9;
    h16* x16 = (h16*)(p.ws + OFF_X16);
    h16* mix = (h16*)(p.ws + OFF_MIX);
    h16* big = (h16*)(p.ws + OFF_BIG);
    if (ph == 0) {
        if (blockIdx.x == 0) for (int i = tidx; i < 256 + 3456; i += 512) ((unsigned*)(p.ws + OFF_MISC))[i] = 0u;
        conv_x(p, tidx);
    }
    if (s == 0 || s == 4 || s == 6 || s == 7) {
        const h16* A = (s == 0 || s == 6) ? x16 : (s == 4 ? mix : big);
        const h16* Bt = (const h16*)(p.ws + (s == 0 ? OFF_WIN : s == 4 ? OFF_WOUT : s == 6 ? OFF_WUP : OFF_WDN));
        const int N = (s == 0) ? NP : (s == 6 ? DFF : DM), K = (s == 7) ? DFF : DM;
        h16* O = (s == 0 || s == 6) ? big : x16;
        run_gemm(lds, A, Bt, N, K, O, N, (s == 0) ? 0 : (s == 6 ? 1 : 2), tidx);
    }
    if (s == 1) pre_phase(p, l, lds, tidx);
    if (s == 2) mix_phase(p, l, 2 * rep + l, rep ? DUPITEMS : 15, lds, tidx);
    if (s == 3) post_phase(p, l, tidx);
    if (s == 5 || s == 8) ln_phase(p, p.in[s == 5 ? I_LN1W : I_LN2W] + l * DM, p.in[s == 5 ? I_LN1B : I_LN2B] + l * DM, s == 8 && l == 1, tidx);
    if (ph == 0 || (s == 8 && l == 0)) conv_weights(p, ph == 0 ? 0 : 1, lds, tidx);
}

__global__ void __launch_bounds__(512, 2) k_phase(Params p, int ph) {
    extern __shared__ __attribute__((aligned(16))) unsigned char shm[];
    const int tidx = threadIdx.x;
    run_phase(p, ph, (LAS unsigned char*)shm, tidx, 0);
}

#define XB_TMO      128
#define XB_XCNT(j)  (256  + 64 * (j))
#define XB_XSUB(j)  (1280 + 64 * (j))
#define XB_XGEN(j)  (2304 + 64 * (j))
#define XB_TOP      3328
#define XB_TOPGEN   3392
#define XCD_BAR_WORDS 3456
#define XB_SPIN_CAP (1u << 18)

__device__ __forceinline__ unsigned xb_ld(unsigned* p)              { return __hip_atomic_load(p, __ATOMIC_RELAXED, __HIP_MEMORY_SCOPE_AGENT); }
__device__ __forceinline__ unsigned xb_add(unsigned* p, unsigned v) { return __hip_atomic_fetch_add(p, v, __ATOMIC_RELAXED, __HIP_MEMORY_SCOPE_AGENT); }
__device__ __forceinline__ unsigned xb_xcc_id() { return (unsigned)__builtin_amdgcn_s_getreg((3 << 11) | 20) & 0xFu; }
#define XB_SPIN(cond, bar) do { unsigned _sp = 0; while (cond) { __builtin_amdgcn_s_sleep(1); \
    if ((++_sp & 255u) == 0u) { if (xb_ld(&(bar)[XB_TMO])) break; if (_sp > XB_SPIN_CAP) { atomicAdd(&(bar)[XB_TMO], 1u); break; } } } } while (0)

struct XcdBarrier {
    unsigned* bar; unsigned x;
    volatile LAS unsigned* st;
};

__device__ __forceinline__ XcdBarrier xcd_barrier_post(unsigned* bar, volatile LAS unsigned* st) {
    XcdBarrier b; b.bar = bar; b.x = xb_xcc_id(); b.st = st;
    if (threadIdx.x == 0) (void)xb_add(&bar[XB_XCNT(b.x)], 1u);
    return b;
}
__device__ __forceinline__ void xcd_barrier_complete(unsigned* bar, unsigned x, unsigned& nloc, unsigned& nx) {
    const unsigned G = gridDim.x * gridDim.y * gridDim.z;
    unsigned sum, cnt, mine, sp = 0u;
    for (;;) {
        sum = 0u; cnt = 0u; mine = 0u;
#pragma unroll
        for (unsigned j = 0; j < 16; ++j) { const unsigned c = xb_ld(&bar[XB_XCNT(j)]); sum += c; cnt += (c > 0u) ? 1u : 0u; mine = (j == x) ? c : mine; }
        if (sum == G) break;
        __builtin_amdgcn_s_sleep(1);
        if ((++sp & 255u) == 0u) { if (xb_ld(&bar[XB_TMO])) break; if (sp > XB_SPIN_CAP) { atomicAdd(&bar[XB_TMO], 1u); break; } }
    }
    nloc = mine > 0u ? mine : 1u; nx = cnt > 0u ? cnt : 1u;
}

__device__ __forceinline__ void xcd_barrier(const XcdBarrier& b) {
    asm volatile("s_waitcnt vmcnt(0)" ::: "memory");
    __syncthreads();
    if (threadIdx.x == 0) {
        unsigned* bar = b.bar;
        __builtin_amdgcn_s_waitcnt(0);
        unsigned nloc = b.st[0], nx = b.st[1];
        if (nloc == 0u) { xcd_barrier_complete(bar, b.x, nloc, nx); b.st[0] = nloc; b.st[1] = nx; }
        const unsigned old = xb_add(&bar[XB_XSUB(b.x)], 1u);
        const unsigned gen = old / nloc;
        if (old + 1u == (gen + 1u) * nloc) {
            __builtin_amdgcn_fence(__ATOMIC_RELEASE, "agent");
            asm volatile("s_waitcnt vmcnt(0)" ::: "memory");
            const unsigned og = xb_add(&bar[XB_TOP], 1u);
            const unsigned tg = og / nx;
            if (og + 1u == (tg + 1u) * nx) xb_add(&bar[XB_TOPGEN], 1u);
            else XB_SPIN(xb_ld(&bar[XB_TOPGEN]) == tg, bar);
            __builtin_amdgcn_fence(__ATOMIC_ACQUIRE, "agent");
            xb_add(&bar[XB_XGEN(b.x)], 1u);
            asm volatile("s_waitcnt vmcnt(0)" ::: "memory");
        } else {
            XB_SPIN(xb_ld(&bar[XB_XGEN(b.x)]) == gen, bar);
            __builtin_amdgcn_fence(__ATOMIC_ACQUIRE, "agent");
            asm volatile("s_waitcnt vmcnt(0)" ::: "memory");
        }
    }
    __syncthreads();
}


#ifndef DUPITEMS
#define DUPITEMS 15
#endif
#ifndef DUPMASK
#define DUPMASK 0
#endif
#if COOP
__global__ void __launch_bounds__(512, 2) k_mega(Params p) {
    extern __shared__ __attribute__((aligned(16))) unsigned char shm[];
    cg::grid_group grid = cg::this_grid();
    unsigned* barw = (unsigned*)(p.ws + OFF_MISC + 1024);
    volatile LAS unsigned* xst = (volatile LAS unsigned*)((LAS unsigned char*)shm + LDS_BYTES);
    if (threadIdx.x < 4) xst[threadIdx.x] = 0u;
    XcdBarrier xb; xb.bar = barw; xb.x = 0; xb.st = xst;
#pragma unroll 1
    for (int ph = 0; ph < NPHASE; ++ph) {
        const int nrep = ((DUPMASK >> ph) & 1) ? 2 : 1;
#pragma unroll 1
        for (int rep = 0; rep < nrep; ++rep) {
            int tidx = threadIdx.x; asm volatile("" : "+v"(tidx));
            run_phase(p, ph, (LAS unsigned char*)shm, tidx, rep);
            if (ph == 0) { grid.sync(); xb = xcd_barrier_post(barw, xst); }
            else if (ph + 1 < NPHASE) xcd_barrier(xb);
        }
#ifdef EXTRA_SYNCS
        if (ph == 1) for (int i = 0; i < EXTRA_SYNCS; ++i) xcd_barrier(xb);
#endif
    }
}
#endif

extern "C" void kernel_launch(void* const* d_in, const int* in_sizes, int n_in, void* d_out, int out_size, void* d_ws, size_t ws_size, hipStream_t stream) {
    static int grid_blocks = 0;
    if (!grid_blocks) {
        int dev = 0, cus = 0, per_cu = 0;
        hipGetDevice(&dev);
        hipDeviceGetAttribute(&cus, hipDeviceAttributeMultiprocessorCount, dev);
        hipFuncSetAttribute((const void*)k_phase, hipFuncAttributeMaxDynamicSharedMemorySize, LDS_TOTAL);
#if COOP
        hipFuncSetAttribute((const void*)k_mega, hipFuncAttributeMaxDynamicSharedMemorySize, LDS_TOTAL);
        hipOccupancyMaxActiveBlocksPerMultiprocessor(&per_cu, (const void*)k_mega, 512, LDS_TOTAL);
#endif
        if (per_cu < 1) per_cu = 1;
        grid_blocks = cus * 1;
        (void)hipGetLastError();
    }
    Params p{};
    for (int i = 0; i < 32; ++i) p.in[i] = (const float*)d_in[i];
    p.out = (float*)d_out; p.ws = (unsigned char*)d_ws;
#if COOP
    void* args[] = {&p};
    hipError_t e = hipLaunchCooperativeKernel((const void*)k_mega, dim3(grid_blocks), dim3(512), args, LDS_TOTAL, stream);
    if (e != hipSuccess) fprintf(stderr, "cooperative launch failed: %s (grid %d)\n", hipGetErrorString(e), grid_blocks);
#else
    for (int ph = 0; ph < NPHASE; ++ph) k_phase<<<dim3(grid_blocks), dim3(512), LDS_TOTAL, stream>>>(p, ph);
#endif
}
```

```cpp
#include <hip/hip_runtime.h>
#include <hip/hip_cooperative_groups.h>
#include <cstdio>
namespace cg = cooperative_groups;

#ifndef COOP
#define COOP 1
#endif
#ifndef DUPITEMS
#define DUPITEMS 15
#endif
#ifndef R_RWKV
#define R_RWKV 2
#endif
#ifndef R_SSD
#define R_SSD 2
#endif
#ifndef R_HGRN
#define R_HGRN 2
#endif

#define LAS __attribute__((address_space(3)))
typedef _Float16 h16;
typedef _Float16 h16x4 __attribute__((ext_vector_type(4)));
typedef _Float16 h16x8 __attribute__((ext_vector_type(8)));
typedef float f32x2 __attribute__((ext_vector_type(2)));
typedef float f32x4 __attribute__((ext_vector_type(4)));

constexpr int T_ = 16384, SEQ_ = 2048, DM = 1024, NP = 3840, DFF = 4096, INC = 3716;
constexpr int C_R = 0, C_K = 256, C_V = 512, C_FW = 768, C_VR = 896, C_AQ = 928, C_AK = 1184, C_AV = 1440;
constexpr int C_SZ = 1696, C_SX = 1952, C_SDT = 2720, C_HQ = 2728, C_HF = 2984, C_HI = 3240, C_HG = 3496;
constexpr float ALPHA_ = 1.41421356237f;
constexpr size_t OFF_WIN = 0, OFF_WOUT = 7864320, OFF_WUP = OFF_WOUT + 2097152, OFF_WDN = OFF_WUP + 8388608;
constexpr size_t OFF_X16 = 26738688, OFF_MIX = OFF_X16 + 33554432, OFF_BIG = OFF_MIX + 33554432;
constexpr size_t OFF_VF = OFF_BIG + 134217728, OFF_O2 = OFF_VF + 8388608, OFF_O3 = OFF_O2 + 8388608, OFF_LSE = OFF_O3 + 8388608;
constexpr size_t OFF_MISC = OFF_LSE + 786432;
constexpr int LDS_BYTES = 131072, LDS_TOTAL = 131072 + 64;

struct Params { const float* in[32]; float* out; unsigned char* ws; };

enum { I_X = 0, I_LB, I_WIN, I_WINV, I_MU, I_MUV, I_W0, I_W2, I_A0, I_A2, I_G2, I_KK, I_KA, I_RK, I_LNW, I_LNB, I_V0, I_V2,
       I_CW, I_CB, I_DTB, I_ALOG, I_SD, I_SNW, I_HNW, I_WOUT, I_LN1W, I_LN1B, I_WUP, I_WDN, I_LN2W, I_LN2B };

template <int CTRL> __device__ __forceinline__ float dpp_f(float x) {
    return __builtin_bit_cast(float, __builtin_amdgcn_update_dpp(0, __builtin_bit_cast(int, x), CTRL, 0xF, 0xF, true));
}
__device__ __forceinline__ float sum16(float x) {
    x += dpp_f<0xB1>(x);
    x += dpp_f<0x4E>(x);
    x += dpp_f<0x141>(x);
    x += dpp_f<0x140>(x);
    return x;
}
__device__ __forceinline__ float sum64(float x) { x = sum16(x); x += __shfl_xor(x, 16); x += __shfl_xor(x, 32); return x; }
__device__ __forceinline__ float sigmoidf_(float x) { return __builtin_amdgcn_rcpf(1.0f + __expf(-x)); }
__device__ __forceinline__ float siluf_(float x) { return x * __builtin_amdgcn_rcpf(1.0f + __expf(-x)); }
__device__ __forceinline__ float softplusf_(float x) { return fmaxf(x, 0.f) + __logf(1.0f + __expf(-fabsf(x))); }
__device__ __forceinline__ f32x4 h4f(h16x4 v) { return (f32x4){(float)v[0], (float)v[1], (float)v[2], (float)v[3]}; }
__device__ __forceinline__ h16x4 f4h(f32x4 v) { return (h16x4){(h16)v[0], (h16)v[1], (h16)v[2], (h16)v[3]}; }

namespace pg8 {
constexpr int BM = 256, BK = 64, HALF = 128, HTB = HALF * BK * 2, STAGE_BYTES = 8 * HTB, NXCD = 8, WGM = 8;
__host__ __device__ __forceinline__ int lds_byte(int r, int c) { const int st = (r >> 4) * 2 + (c >> 5), rr = r & 15, cc = c & 31, ob = rr * 64 + cc * 2; return st * 1024 + (ob ^ (((ob >> 9) & 1) << 5)); }
__host__ __device__ __forceinline__ void stage_rc(int b, int& R, int& C) { const int st = b / 1024, sb = b % 1024, swz = sb ^ (((sb >> 9) & 1) << 5); R = (st >> 1) * 16 + swz / 64; C = (st & 1) * 32 + (swz % 64) / 2; }
__host__ __device__ __forceinline__ int perm32(int rho) { const int n = rho >> 4, i = rho & 15; return 8 * (i >> 2) + 4 * n + (i & 3); }
struct Unit { int pm, pn; };
struct Gemm { const h16* A; const h16* Bt; int M, N, K; };
struct StaticOrder {
    int nM, nN, nwg, G, c;
    __device__ void init(int M, int N, int G_, int c_) { nM = M / BM; nN = N / BM; nwg = nM * nN; G = G_; c = c_; }
    __device__ bool next(int i, Unit& u) const {
        const long L = (long)i * G + c; if (L >= nwg) return false;
        int wgid = (int)L; { const int q = nwg / NXCD, r = nwg % NXCD, xcd = wgid % NXCD, off = wgid / NXCD; wgid = (xcd < r ? xcd * (q + 1) : r * (q + 1) + (xcd - r) * q) + off; }
        const int nig = WGM * nN, gid = wgid / nig, fm = gid * WGM, gsz = (nM - fm) < WGM ? (nM - fm) : WGM;
        u.pm = fm + ((wgid % nig) % gsz); u.pn = (wgid % nig) / gsz; return true;
    }
};
struct EpiH {
    h16* O; int ldc; int MODE;
    __device__ __forceinline__ void operator()(const f32x4 (&acc)[2][2][4][2], const Unit& u, int wr, int wc, int fr, int fq) const {
        const int row0 = u.pm * BM + wr * 64 + fr, col0 = u.pn * BM + wc * 32 + 8 * fq;
#pragma unroll
        for (int ai = 0; ai < 2; ++ai)
#pragma unroll
            for (int m = 0; m < 4; ++m) { h16* rowp = O + (size_t)(row0 + ai * HALF + m * 16) * ldc + col0;
#pragma unroll
                for (int bj = 0; bj < 2; ++bj) { f32x4 v0 = acc[ai][bj][m][0], v1 = acc[ai][bj][m][1];
                    if (MODE == 1) {
#pragma unroll
                        for (int j = 0; j < 4; ++j) { float a = fmaxf(v0[j], 0.f), b = fmaxf(v1[j], 0.f); v0[j] = a * a; v1[j] = b * b; } }
                    if (MODE == 2) { const h16x8 x = *(const h16x8*)(rowp + bj * HALF);
#pragma unroll
                        for (int j = 0; j < 4; ++j) { v0[j] += ALPHA_ * (float)x[j]; v1[j] += ALPHA_ * (float)x[4 + j]; } }
                    h16x8 w;
#pragma unroll
                    for (int j = 0; j < 4; ++j) { w[j] = (h16)v0[j]; w[4 + j] = (h16)v1[j]; }
                    *(h16x8*)(rowp + bj * HALF) = w; } }
    }
};

template <class Epi>
__device__ __forceinline__ void gemm_phase(LAS unsigned char* lds, const Gemm g, const StaticOrder& S, const Epi& E, const int tidx) {
    const int tid = tidx, wid = __builtin_amdgcn_readfirstlane(tid >> 6), lane = tid & 63, wr = wid >> 2, wc = wid & 3, fr = lane & 15, fq = lane >> 4;
    const int K = g.K, nt = K / BK;
    unsigned voffA[2], voffB[2];
#pragma unroll
    for (int i = 0; i < 2; ++i) { int R, C; stage_rc(tid * 16 + i * 8192, R, C); const int Rb = (R & ~31) + perm32(R & 31);
        voffA[i] = (unsigned)(R * K + C) * 2u; voffB[i] = (unsigned)(Rb * K + C) * 2u; }
    const size_t kstep = (size_t)(BK * 2);
    const size_t hstep = (size_t)HALF * K * 2;
    const size_t tstep = 2 * hstep;
    const unsigned ldsw = (unsigned)wid * 1024u;
    const int aoff = lds_byte(wr * 64 + fr, fq * 8), boff = lds_byte(wc * 32 + fr, fq * 8);
#define PG8_SA(b, h) (((b) * 2 + (h)) * HTB)
#define PG8_SB(b, h) ((4 + (b) * 2 + (h)) * HTB)
#define PG8_STAGE(bufoff, gbase, voff) do { _Pragma("unroll") for (int _i = 0; _i < 2; ++_i) \
        __builtin_amdgcn_global_load_lds((const unsigned*)((const char*)(gbase) + (voff)[_i]), (LAS unsigned*)(lds + (bufoff) + ldsw + _i * 8192), 16, 0, 0); } while (0)
#define PG8_LDA(dst, b, h) do { _Pragma("unroll") for (int m = 0; m < 4; ++m) _Pragma("unroll") for (int k = 0; k < 2; ++k) dst[m][k] = *(const LAS h16x8*)(lds + PG8_SA(b, h) + aoff + m * 2048 + k * 1024); } while (0)
#define PG8_LDB(dst, b, h) do { _Pragma("unroll") for (int n = 0; n < 2; ++n) _Pragma("unroll") for (int k = 0; k < 2; ++k) dst[n][k] = *(const LAS h16x8*)(lds + PG8_SB(b, h) + boff + n * 2048 + k * 1024); } while (0)
#define PG8_MMA(ai, bj, At, Bt) do { __builtin_amdgcn_s_setprio(1); _Pragma("unroll") for (int m = 0; m < 4; ++m) _Pragma("unroll") for (int n = 0; n < 2; ++n) _Pragma("unroll") for (int k = 0; k < 2; ++k) \
        acc[ai][bj][m][n] = __builtin_amdgcn_mfma_f32_16x16x32_f16(Bt[n][k], At[m][k], acc[ai][bj][m][n], 0, 0, 0); __builtin_amdgcn_s_setprio(0); } while (0)
#define PG8_WAIT_V(n) asm volatile("s_waitcnt vmcnt(" #n ")" ::: "memory")
#define PG8_WAIT_L(n) asm volatile("s_waitcnt lgkmcnt(" #n ")" ::: "memory")
#define PG8_BAR __builtin_amdgcn_s_barrier()
#define PG8_SCHED __builtin_amdgcn_sched_barrier(0)
    Unit cur, nxt; int ui = 0;
    if (!S.next(0, cur)) return;
    f32x4 acc[2][2][4][2];
#pragma unroll
    for (int a = 0; a < 2; ++a)
#pragma unroll
        for (int b = 0; b < 2; ++b)
#pragma unroll
            for (int m = 0; m < 4; ++m)
#pragma unroll
                for (int n = 0; n < 2; ++n) acc[a][b][m][n] = (f32x4){0.f, 0.f, 0.f, 0.f};
    h16x8 At[4][2], B0[2][2], B1[2][2];
    const char* cA = (const char*)g.A + (size_t)cur.pm * tstep; const char* cB = (const char*)g.Bt + (size_t)cur.pn * tstep;
    PG8_STAGE(PG8_SB(0, 0), cB, voffB); PG8_STAGE(PG8_SA(0, 0), cA, voffA); PG8_STAGE(PG8_SB(0, 1), cB + hstep, voffB); PG8_STAGE(PG8_SA(0, 1), cA + hstep, voffA);
    if (wr == 1) PG8_BAR;
    PG8_WAIT_V(4); PG8_BAR;
    PG8_STAGE(PG8_SB(1, 0), cB + kstep, voffB); PG8_STAGE(PG8_SA(1, 0), cA + kstep, voffA); PG8_STAGE(PG8_SB(1, 1), cB + hstep + kstep, voffB);
    PG8_WAIT_V(6); PG8_BAR;
    for (;;) {
        const bool has_next = S.next(ui + 1, nxt);
        const char* nA = has_next ? (const char*)g.A + (size_t)nxt.pm * tstep : cA; const char* nB = has_next ? (const char*)g.Bt + (size_t)nxt.pn * tstep : cB;
        for (int t = 0; t < nt; t += 2) {
            const bool last = (t == nt - 2);
            const char* a1 = cA + (size_t)(t + 1) * kstep;
            const char* a2 = last ? nA : cA + (size_t)(t + 2) * kstep; const char* b2 = last ? nB : cB + (size_t)(t + 2) * kstep;
            const char* a3 = a2 + kstep; const char* b3 = b2 + kstep;
            PG8_LDB(B0, 0, 0); PG8_SCHED; PG8_LDA(At, 0, 0); PG8_STAGE(PG8_SA(1, 1), a1 + hstep, voffA);
            PG8_WAIT_L(8); PG8_BAR; PG8_WAIT_L(0); PG8_MMA(0, 0, At, B0); PG8_BAR; PG8_SCHED;
            PG8_LDB(B1, 0, 1); PG8_STAGE(PG8_SB(0, 0), b2, voffB);
            PG8_BAR; PG8_WAIT_L(0); PG8_MMA(0, 1, At, B1); PG8_BAR;
            PG8_LDA(At, 0, 1); PG8_STAGE(PG8_SA(0, 0), a2, voffA);
            PG8_BAR; PG8_WAIT_L(0); PG8_MMA(1, 0, At, B0); PG8_BAR; PG8_SCHED;
            PG8_STAGE(PG8_SB(0, 1), b2 + hstep, voffB);
            PG8_WAIT_V(6); PG8_BAR; PG8_MMA(1, 1, At, B1); PG8_BAR;
            PG8_LDB(B0, 1, 0); PG8_SCHED; PG8_LDA(At, 1, 0); PG8_STAGE(PG8_SA(0, 1), a2 + hstep, voffA);
            PG8_WAIT_L(8); PG8_BAR; PG8_WAIT_L(0); PG8_MMA(0, 0, At, B0); PG8_BAR; PG8_SCHED;
            PG8_LDB(B1, 1, 1); PG8_STAGE(PG8_SB(1, 0), b3, voffB);
            PG8_BAR; PG8_WAIT_L(0); PG8_MMA(0, 1, At, B1); PG8_BAR;
            PG8_LDA(At, 1, 1); PG8_STAGE(PG8_SA(1, 0), a3, voffA);
            PG8_BAR; PG8_WAIT_L(0); PG8_MMA(1, 0, At, B0); PG8_BAR; PG8_SCHED;
            PG8_STAGE(PG8_SB(1, 1), b3 + hstep, voffB);
            PG8_WAIT_V(6); PG8_BAR; PG8_MMA(1, 1, At, B1); PG8_BAR;
        }
        E(acc, cur, wr, wc, fr, fq);
        if (!has_next) break;
#pragma unroll
        for (int a = 0; a < 2; ++a)
#pragma unroll
            for (int b = 0; b < 2; ++b)
#pragma unroll
                for (int m = 0; m < 4; ++m)
#pragma unroll
                    for (int n = 0; n < 2; ++n) acc[a][b][m][n] = (f32x4){0.f, 0.f, 0.f, 0.f};
        cur = nxt; cA = nA; cB = nB; ++ui;
    }
    PG8_WAIT_V(0);
    if (wr == 0) PG8_BAR;
    PG8_BAR;
#undef PG8_SA
#undef PG8_SB
#undef PG8_STAGE
#undef PG8_LDA
#undef PG8_LDB
#undef PG8_MMA
#undef PG8_WAIT_V
#undef PG8_WAIT_L
#undef PG8_BAR
#undef PG8_SCHED
}
}

__device__ __forceinline__ void run_gemm(LAS unsigned char* lds, const h16* A, const h16* Bt, int N, int K, h16* O, int ldc, int mode, const int tidx) {
    pg8::Gemm g; g.A = A; g.Bt = Bt; g.M = T_; g.N = N; g.K = K;
    pg8::StaticOrder S; S.init(T_, N, (int)gridDim.x, (int)blockIdx.x);
    pg8::EpiH E; E.O = O; E.ldc = ldc; E.MODE = mode;
    pg8::gemm_phase(lds, g, S, E, tidx);
}

__device__ __forceinline__ void cw_decode(int id, int& mat, int& K, int& n0, int& k0) {
    int tl;
    if (id < 960) { mat = 0; tl = id; } else if (id < 1216) { mat = 1; tl = id - 960; } else if (id < 2240) { mat = 2; tl = id - 1216; } else { mat = 3; tl = id - 2240; }
    K = (mat == 3) ? 4096 : 1024;
    const int nkt = K / 64;
    n0 = (tl / nkt) * 64; k0 = (tl % nkt) * 64;
}
__device__ __forceinline__ void cw_load(const Params& p, int l, int id, LAS float* tile, int tid) {
    int mat, K, n0, k0; cw_decode(id, mat, K, n0, k0);
    const int nj = tid & 63, n = n0 + nj;
    const float* src = nullptr; int sstride = 0;
    if (mat == 0) {
        if (n < 896) { src = p.in[I_WIN] + (size_t)l * DM * INC + n; sstride = INC; }
        else if (n < 928) { if (l > 0) { src = p.in[I_WINV] + (size_t)(l - 1) * DM * 32 + (n - 896); sstride = 32; } }
        else if (n < 2724) { src = p.in[I_WIN] + (size_t)l * DM * INC + (n - 32); sstride = INC; }
        else if (n < 2728) { }
        else if (n < 3752) { src = p.in[I_WIN] + (size_t)l * DM * INC + (n - 36); sstride = INC; }
    } else if (mat == 1) { src = p.in[I_WOUT] + (size_t)l * 1024 * 1024 + n; sstride = 1024; }
    else if (mat == 2) { src = p.in[I_WUP] + (size_t)l * 1024 * 4096 + n; sstride = 4096; }
    else { src = p.in[I_WDN] + (size_t)l * 4096 * 1024 + n; sstride = 1024; }
    float v[8];
#pragma unroll
    for (int i = 0; i < 8; ++i) { const int ki = (tid >> 6) + 8 * i; v[i] = src ? src[(size_t)(k0 + ki) * sstride] : 0.f; }
#pragma unroll
    for (int i = 0; i < 8; ++i) { const int ki = (tid >> 6) + 8 * i; tile[ki * 65 + nj] = v[i]; }
}
__device__ __forceinline__ void cw_store(const Params& p, int id, const LAS float* tile, int tid) {
    int mat, K, n0, k0; cw_decode(id, mat, K, n0, k0);
    h16* dst = (h16*)(p.ws + (mat == 0 ? OFF_WIN : mat == 1 ? OFF_WOUT : mat == 2 ? OFF_WUP : OFF_WDN));
    const int ki = tid & 63;
#pragma unroll
    for (int i = 0; i < 8; ++i) { const int nj = (tid >> 6) + 8 * i; dst[(size_t)(n0 + nj) * K + k0 + ki] = (h16)tile[ki * 65 + nj]; }
}
__device__ __forceinline__ void conv_weights(const Params& p, int l, LAS unsigned char* lds, const int tidx) {
    LAS float* tile = (LAS float*)lds;
    const int tid = tidx;
    for (int id = blockIdx.x * 4; id < 3264; id += gridDim.x * 4) {
        __syncthreads();
#pragma unroll
        for (int u = 0; u < 4; ++u) if (id + u < 3264) cw_load(p, l, id + u, tile + u * 4224, tid);
        __syncthreads();
#pragma unroll
        for (int u = 0; u < 4; ++u) if (id + u < 3264) cw_store(p, id + u, tile + u * 4224, tid);
    }
    __syncthreads();
}

__device__ __forceinline__ void conv_x(const Params& p, const int tidx) {
    const f32x4* src = (const f32x4*)p.in[I_X]; h16x4* dst = (h16x4*)(p.ws + OFF_X16);
    for (size_t i = (size_t)blockIdx.x * 512 + tidx; i < (size_t)T_ * DM / 4; i += (size_t)gridDim.x * 512) dst[i] = f4h(src[i]);
}

__device__ __forceinline__ void pre_phase(const Params& p, int l, LAS unsigned char* lds, const int tidx) {
    constexpr int RS = 168;
    LAS h16* A16 = (LAS h16*)lds;
    LAS h16* W16 = (LAS h16*)(lds + 64 * RS * 2);
    const h16* proj = (const h16*)(p.ws + OFF_BIG);
    h16* prep = (h16*)p.out;
    h16* vfirst = (h16*)(p.ws + OFF_VF);
    const int tid = tidx, wid = tid >> 6, lane = tid & 63, c16 = lane & 15, g = lane >> 4, hh = wid & 3, mh = wid >> 2;
    const int nact = (l == 0) ? 128 : 160;
    __syncthreads();
#pragma unroll 1
    for (int e0 = 0; e0 < nact * 256; e0 += 512 * 16) {
        float wv16[16];
#pragma unroll
        for (int u = 0; u < 16; ++u) {
            const int e = e0 + u * 512 + tid, i = e >> 8, cc = e & 255;
            const float* sp;
            if (i < 32) sp = p.in[I_W2] + (size_t)(l * 32 + i) * 256 + cc;
            else if (i < 64) sp = p.in[I_A2] + (size_t)(l * 32 + i - 32) * 256 + cc;
            else if (i < 128) sp = p.in[I_G2] + (size_t)(l * 64 + i - 64) * 256 + cc;
            else sp = p.in[I_V2] + (size_t)((l - 1) * 32 + i - 128) * 256 + cc;
            wv16[u] = *sp;
        }
#pragma unroll
        for (int u = 0; u < 16; ++u) { const int e = e0 + u * 512 + tid; W16[(e & 255) * RS + (e >> 8)] = (h16)wv16[u]; }
    }
    float mu_r[4], mu_k[4], mu_v[4], w0[4], a0[4], k_k[4], k_a[4], r_k[4], lnw[4], lnb[4], v0[4];
#pragma unroll
    for (int nt = 0; nt < 4; ++nt) {
        const int ch = hh * 64 + nt * 16 + c16;
        mu_r[nt] = p.in[I_MU][l * 896 + ch]; mu_k[nt] = p.in[I_MU][l * 896 + 256 + ch]; mu_v[nt] = p.in[I_MU][l * 896 + 512 + ch];
        w0[nt] = p.in[I_W0][l * 256 + ch]; a0[nt] = p.in[I_A0][l * 256 + ch]; k_k[nt] = p.in[I_KK][l * 256 + ch]; k_a[nt] = p.in[I_KA][l * 256 + ch];
        r_k[nt] = p.in[I_RK][l * 256 + ch]; lnw[nt] = p.in[I_LNW][l * 256 + ch]; lnb[nt] = p.in[I_LNB][l * 256 + ch];
        v0[nt] = (l > 0) ? p.in[I_V0][(l - 1) * 256 + ch] : 0.f;
    }
    for (int tt = blockIdx.x; tt < T_ / 64; tt += gridDim.x) {
        const int t0 = tt * 64;
        __syncthreads();
#pragma unroll 1
        for (int eb = 0; eb < 20; eb += 10) {
            float curv[10], prvv[10];
#pragma unroll
            for (int u = 0; u < 10; ++u) {
                const int e = (eb + u) * 512 + tid, tok = e / 160, i = e - tok * 160, t = t0 + tok;
                curv[u] = 0.f; prvv[u] = 0.f;
                if (i < nact) {
                    curv[u] = (float)proj[(size_t)t * NP + C_FW + i];
                    if (t & (SEQ_ - 1)) prvv[u] = (float)proj[(size_t)(t - 1) * NP + C_FW + i];
                }
            }
#pragma unroll
            for (int u = 0; u < 10; ++u) {
                const int e = (eb + u) * 512 + tid, tok = e / 160, i = e - tok * 160;
                if (i < nact) {
                    const float mu = (i < 128) ? p.in[I_MU][l * 896 + 768 + i] : p.in[I_MUV][(l - 1) * 32 + (i - 128)];
                    const float f = curv[u] + (prvv[u] - curv[u]) * mu;
                    float a = f;
                    if (i < 32) { const float e2 = __expf(-2.0f * fabsf(f)); const float th = (1.0f - e2) * __builtin_amdgcn_rcpf(1.0f + e2); a = f < 0.f ? -th : th; } else if (i >= 64 && i < 128) a = sigmoidf_(f);
                    A16[tok * RS + i] = (h16)a;
                }
            }
        }
        __syncthreads();
#pragma unroll 1
        for (int mt = 0; mt < 2; ++mt) {
            const int tokb = mh * 32 + mt * 16;
            f32x4 aw[4], aa[4], ag[4], av[4];
            {
                const LAS h16* ar = A16 + (tokb + c16) * RS + 8 * g;
                const h16x8 A0 = *(const LAS h16x8*)(ar), A1 = *(const LAS h16x8*)(ar + 32), A2 = *(const LAS h16x8*)(ar + 64), A3 = *(const LAS h16x8*)(ar + 96);
                h16x8 A4 = A0; if (l > 0) A4 = *(const LAS h16x8*)(ar + 128);
#pragma unroll
                for (int nt = 0; nt < 4; ++nt) {
                    const LAS h16* br = W16 + (hh * 64 + nt * 16 + c16) * RS + 8 * g;
                    const f32x4 z = {0.f, 0.f, 0.f, 0.f};
                    aw[nt] = __builtin_amdgcn_mfma_f32_16x16x32_f16(A0, *(const LAS h16x8*)(br), z, 0, 0, 0);
                    aa[nt] = __builtin_amdgcn_mfma_f32_16x16x32_f16(A1, *(const LAS h16x8*)(br + 32), z, 0, 0, 0);
                    ag[nt] = __builtin_amdgcn_mfma_f32_16x16x32_f16(A2, *(const LAS h16x8*)(br + 64), z, 0, 0, 0);
                    ag[nt] = __builtin_amdgcn_mfma_f32_16x16x32_f16(A3, *(const LAS h16x8*)(br + 96), ag[nt], 0, 0, 0);
                    av[nt] = z;
                    if (l > 0) av[nt] = __builtin_amdgcn_mfma_f32_16x16x32_f16(A4, *(const LAS h16x8*)(br + 128), z, 0, 0, 0);
                }
            }
#pragma unroll
            for (int rp = 0; rp < 2; ++rp) {
            h16 lr[8], lk[8], lv[8], lpr[8], lpk[8], lpv[8], lvf[8];
#pragma unroll
            for (int r2 = 0; r2 < 2; ++r2) {
                const int t = t0 + tokb + 4 * g + rp * 2 + r2;
                const h16* row = proj + (size_t)t * NP + hh * 64 + c16;
#pragma unroll
                for (int nt = 0; nt < 4; ++nt) {
                    const int q = r2 * 4 + nt;
                    lr[q] = row[C_R + nt * 16]; lk[q] = row[C_K + nt * 16]; lv[q] = row[C_V + nt * 16];
                    lpr[q] = (h16)0.f; lpk[q] = (h16)0.f; lpv[q] = (h16)0.f; lvf[q] = (h16)0.f;
                    if (t & (SEQ_ - 1)) { lpr[q] = row[C_R + nt * 16 - NP]; lpk[q] = row[C_K + nt * 16 - NP]; lpv[q] = row[C_V + nt * 16 - NP]; }
                    if (l > 0) lvf[q] = vfirst[(size_t)t * 256 + hh * 64 + nt * 16 + c16];
                }
            }
#pragma unroll
            for (int r2 = 0; r2 < 2; ++r2) {
                const int rg = rp * 2 + r2;
                const int t = t0 + tokb + 4 * g + rg;
                float rr[4], kp[4], vv[4], kkr[4], aS[4], ee[4];
                float n2 = 0.f, bn = 0.f;
#pragma unroll
                for (int nt = 0; nt < 4; ++nt) {
                    const int q = r2 * 4 + nt;
                    float r = (float)lr[q], k = (float)lk[q], v = (float)lv[q];
                    r += ((float)lpr[q] - r) * mu_r[nt]; k += ((float)lpk[q] - k) * mu_k[nt]; v += ((float)lpv[q] - v) * mu_v[nt];
                    const float wl = w0[nt] + aw[nt][rg];
                    ee[nt] = __expf(-softplusf_(-wl) - 0.5f);
                    const float a = sigmoidf_(a0[nt] + aa[nt][rg]);
                    if (l == 0) vfirst[(size_t)t * 256 + hh * 64 + nt * 16 + c16] = (h16)v;
                    else v += ((float)lvf[q] - v) * sigmoidf_(v0[nt] + av[nt][rg]);
                    kkr[nt] = k * k_k[nt];
                    kp[nt] = k * (1.0f + (a - 1.0f) * k_a[nt]);
                    rr[nt] = r; vv[nt] = v; aS[nt] = a;
                    n2 += kkr[nt] * kkr[nt]; bn += r * kp[nt] * r_k[nt];
                }
                n2 = sum16(n2); bn = sum16(bn);
                const float rn = __builtin_amdgcn_rsqf(fmaxf(n2, 1e-24f));
#pragma unroll
                for (int nt = 0; nt < 4; ++nt) {
                    const float kk = kkr[nt] * rn, gg = ag[nt][rg];
                    h16* o = prep + (size_t)t * 2048 + hh * 64 + nt * 16 + c16;
                    o[0] = (h16)rr[nt]; o[256] = (h16)ee[nt]; o[512] = (h16)kp[nt]; o[768] = (h16)kk; o[1024] = (h16)(kk * aS[nt]); o[1280] = (h16)vv[nt];
                    o[1536] = (h16)(lnw[nt] * gg); o[1792] = (h16)((lnb[nt] + bn * vv[nt]) * gg);
                }
            }
            }
        }
    }
    __syncthreads();
}

constexpr int CH = 32;

__device__ __forceinline__ float dot4(f32x4 a, f32x4 b) { f32x2 p = (f32x2){a[0], a[1]} * (f32x2){b[0], b[1]}; p = __builtin_elementwise_fma((f32x2){a[2], a[3]}, (f32x2){b[2], b[3]}, p); return p[0] + p[1]; }
template <int R> __device__ __forceinline__ void plain_write_y(h16* mix, int t0, int col, LAS unsigned char* ybuf, int lt) {
    if (lt >= 128 * R) return;
    const int tok = lt / (4 * R), r8 = lt & (4 * R - 1);
    const f32x4 y = *(const LAS f32x4*)(ybuf + (tok * 32 + r8 * 4) * 4);
    *(h16x4*)(mix + (size_t)(t0 + tok) * DM + col + r8 * 4) = f4h(y);
}

constexpr int RW_SH = 0, RW_VB = CH * 16 * 20 * 4, RW_YB = RW_VB + CH * 32 * 4, RW_STRIDE = RW_YB + CH * 32 * 4;
template <int R> __device__ __forceinline__ void rwkv_load(const h16* prep, int t0, int h, int rowbase, LAS unsigned char* buf, int lt) {
    LAS float* sh = (LAS float*)(buf + RW_SH);
    h16x4 raw[10];
#pragma unroll
    for (int i = 0; i < 10; ++i) {
        const int e = i * 256 + lt, tok = e / 80, rem = e - tok * 80, vec = rem >> 4, sub = rem & 15;
        const int pv = (vec == 0) ? 3 : (vec == 1) ? 1 : (vec == 2) ? 4 : (vec == 3) ? 2 : 0;
        raw[i] = *(const h16x4*)(prep + (size_t)(t0 + tok) * 2048 + pv * 256 + h * 64 + sub * 4);
    }
    const int tokv = lt / (4 * R), r8 = lt & (4 * R - 1);
    h16x4 rv = {(h16)0.f, (h16)0.f, (h16)0.f, (h16)0.f};
    if (lt < 128 * R) rv = *(const h16x4*)(prep + (size_t)(t0 + tokv) * 2048 + 5 * 256 + rowbase + r8 * 4);
#pragma unroll
    for (int i = 0; i < 10; ++i) {
        const int e = i * 256 + lt, tok = e / 80, rem = e - tok * 80, vec = rem >> 4, sub = rem & 15;
        f32x4 f = h4f(raw[i]);
        if (vec == 1) { f[0] = __expf(-f[0]); f[1] = __expf(-f[1]); f[2] = __expf(-f[2]); f[3] = __expf(-f[3]); }
        *(LAS f32x4*)(sh + ((tok * 16 + sub) * 5 + vec) * 4) = f;
    }
    if (lt < 128 * R) *(LAS f32x4*)(buf + RW_VB + (tokv * 32 + r8 * 4) * 4) = h4f(rv);
}
template <int R> __device__ __forceinline__ void rwkv_scan(const Params& p, int item, LAS unsigned char* lds, const int tidx) {
    constexpr int NQ = 4 / R;
    const int b = item / (4 * NQ), h = (item / NQ) & 3, q2 = item % NQ;
    const int tid = tidx, wid = tid >> 6, lane = tid & 63, lt = tid - 256;
    const h16* prep = (const h16*)p.out;
    h16* mix = (h16*)(p.ws + OFF_MIX);
    const int rowbase = h * 64 + q2 * 16 * R, tb = b * SEQ_;
    const bool loader = wid >= 4;
    const int rowl = (wid & 3) * 4 + (lane >> 4), sub = lane & 15;
    LAS float* dump = (LAS float*)(lds + LDS_BYTES - 8192) + tid;
    f32x4 Sa = {0.f, 0.f, 0.f, 0.f}, Sb = {0.f, 0.f, 0.f, 0.f};
    __syncthreads();
    if (loader) rwkv_load<R>(prep, tb, h, rowbase, lds, lt);
    __syncthreads();
#pragma unroll 1
    for (int c = 0; c < SEQ_ / CH; ++c) {
        LAS unsigned char* buf = lds + (c & 1) * RW_STRIDE;
        if (loader) {
            if (c + 1 < SEQ_ / CH) rwkv_load<R>(prep, tb + (c + 1) * CH, h, rowbase, lds + ((c + 1) & 1) * RW_STRIDE, lt);
            if (c > 0) plain_write_y<R>(mix, tb + (c - 1) * CH, rowbase, lds + ((c - 1) & 1) * RW_STRIDE + RW_YB, lt);
        } else {
            const LAS float* sh = (const LAS float*)(buf + RW_SH);
            const LAS float* vb = (const LAS float*)(buf + RW_VB);
            LAS float* yb = (LAS float*)(buf + RW_YB);
            const LAS f32x4* q0 = (const LAS f32x4*)(sh + sub * 20);
            f32x4 nkk = q0[0], nw = q0[1], nbb = q0[2], nk = q0[3], nr = q0[4];
            float nva = vb[rowl], nvb = vb[rowl + 16];
#pragma unroll 4
            for (int s = 0; s < CH; ++s) {
                const f32x4 kk = nkk, w = nw, bb = nbb, k = nk, r = nr;
                const float va = nva, vbb = nvb;
                const LAS f32x4* q = (const LAS f32x4*)(sh + ((s + 1) * 16 + sub) * 20);
                nkk = q[0]; nw = q[1]; nbb = q[2]; nk = q[3]; nr = q[4];
                nva = vb[(s + 1) * 32 + rowl]; if (R == 2) nvb = vb[(s + 1) * 32 + rowl + 16];
                const float da = sum16(dot4(Sa, kk));
                Sa = Sa * w + (k * va - bb * da);
                const float ya = sum16(dot4(Sa, r));
                LAS float* wp = (sub == 0) ? (yb + s * 32 + rowl) : dump;
                wp[0] = ya;
                if (R == 2) {
                    const float db = sum16(dot4(Sb, kk));
                    Sb = Sb * w + (k * vbb - bb * db);
                    wp[16] = sum16(dot4(Sb, r));
                }
            }
        }
        __syncthreads();
    }
    if (loader) plain_write_y<R>(mix, tb + (SEQ_ / CH - 1) * CH, rowbase, lds + ((SEQ_ / CH - 1) & 1) * RW_STRIDE + RW_YB, lt);
}

constexpr int HG_SH = 0, HG_VB = CH * 16 * 12 * 4, HG_YB = HG_VB + CH * 32 * 4, HG_STRIDE = HG_YB + CH * 32 * 4;
template <int R> __device__ __forceinline__ void hgrn_load(const h16* proj, int t0, int h, int rowbase, f32x4 lb, LAS unsigned char* buf, int lt) {
    LAS float* sh = (LAS float*)(buf + HG_SH);
    h16x4 rq[2], rf[2];
#pragma unroll
    for (int i = 0; i < 2; ++i) {
        const int e = i * 256 + lt, tok = e >> 4, sub = e & 15;
        const h16* row = proj + (size_t)(t0 + tok) * NP + h * 64 + sub * 4;
        rq[i] = *(const h16x4*)(row + C_HQ); rf[i] = *(const h16x4*)(row + C_HF);
    }
    const int tokv = lt / (4 * R), r8 = lt & (4 * R - 1);
    h16x4 rv = {(h16)0.f, (h16)0.f, (h16)0.f, (h16)0.f};
    if (lt < 128 * R) rv = *(const h16x4*)(proj + (size_t)(t0 + tokv) * NP + C_HI + rowbase + r8 * 4);
#pragma unroll
    for (int i = 0; i < 2; ++i) {
        const int e = i * 256 + lt, tok = e >> 4, sub = e & 15;
        const f32x4 qv = h4f(rq[i]), fv = h4f(rf[i]);
        f32x4 fo, ko, qo;
#pragma unroll
        for (int j = 0; j < 4; ++j) { const float fg = lb[j] + (1.0f - lb[j]) * sigmoidf_(fv[j]); fo[j] = fg; ko[j] = 1.0f - fg; qo[j] = siluf_(qv[j]); }
        LAS f32x4* d = (LAS f32x4*)(sh + (tok * 16 + sub) * 12);
        d[0] = fo; d[1] = ko; d[2] = qo;
    }
    if (lt < 128 * R) *(LAS f32x4*)(buf + HG_VB + (tokv * 32 + r8 * 4) * 4) = h4f(rv);
}
template <int R> __device__ __forceinline__ void hgrn_scan(const Params& p, int l, int item, LAS unsigned char* lds, const int tidx) {
    constexpr int NQ = 4 / R;
    const int b = item / (4 * NQ), h = (item / NQ) & 3, q2 = item % NQ;
    const int tid = tidx, wid = tid >> 6, lane = tid & 63, lt = tid - 256;
    const h16* proj = (const h16*)(p.ws + OFF_BIG);
    h16* mix = (h16*)(p.ws + OFF_MIX);
    const int rowbase = h * 64 + q2 * 32, tb = b * SEQ_;
    const bool loader = wid >= 4;
    const int rowl = (wid & 3) * 4 + (lane >> 4), sub = lane & 15;
    LAS float* dump = (LAS float*)(lds + LDS_BYTES - 8192) + tid;
    f32x4 lb = {0.f, 0.f, 0.f, 0.f};
    if (l > 0) {
#pragma unroll
        for (int j = 0; j < 4; ++j) { const int ch = h * 64 + (lt & 15) * 4 + j; lb[j] = sigmoidf_(p.in[I_LB][256 + ch] - p.in[I_LB][ch]); }
    }
    f32x4 Sa = {0.f, 0.f, 0.f, 0.f}, Sb = {0.f, 0.f, 0.f, 0.f};
    __syncthreads();
    if (loader) hgrn_load<R>(proj, tb, h, rowbase, lb, lds, lt);
    __syncthreads();
#pragma unroll 1
    for (int c = 0; c < SEQ_ / CH; ++c) {
        LAS unsigned char* buf = lds + (c & 1) * HG_STRIDE;
        if (loader) {
            if (c + 1 < SEQ_ / CH) hgrn_load<R>(proj, tb + (c + 1) * CH, h, rowbase, lb, lds + ((c + 1) & 1) * HG_STRIDE, lt);
            if (c > 0) plain_write_y<R>(mix, tb + (c - 1) * CH, 768 + rowbase, lds + ((c - 1) & 1) * HG_STRIDE + HG_YB, lt);
        } else {
            const LAS float* sh = (const LAS float*)(buf + HG_SH);
            const LAS float* vb = (const LAS float*)(buf + HG_VB);
            LAS float* yb = (LAS float*)(buf + HG_YB);
            const LAS f32x4* q0 = (const LAS f32x4*)(sh + sub * 12);
            f32x4 nf = q0[0], nk = q0[1], nq = q0[2];
            float nva = vb[rowl], nvb = vb[rowl + 16];
#pragma unroll 4
            for (int s = 0; s < CH; ++s) {
                const f32x4 f = nf, k = nk, qq = nq;
                const float va = nva, vbb = nvb;
                const LAS f32x4* q = (const LAS f32x4*)(sh + ((s + 1) * 16 + sub) * 12);
                nf = q[0]; nk = q[1]; nq = q[2];
                nva = vb[(s + 1) * 32 + rowl]; if (R == 2) nvb = vb[(s + 1) * 32 + rowl + 16];
                Sa = Sa * f + k * va;
                const float ya = sum16(dot4(Sa, qq));
                LAS float* wp = (sub == 0) ? (yb + s * 32 + rowl) : dump;
                wp[0] = ya;
                if (R == 2) { Sb = Sb * f + k * vbb; wp[16] = sum16(dot4(Sb, qq)); }
            }
        }
        __syncthreads();
    }
    if (loader) plain_write_y<R>(mix, tb + (SEQ_ / CH - 1) * CH, 768 + rowbase, lds + ((SEQ_ / CH - 1) & 1) * HG_STRIDE + HG_YB, lt);
}

constexpr int SD_SH = 0, SD_XDT = CH * 16 * 20 * 4, SD_XS = SD_XDT + CH * 32 * 4, SD_AB = SD_XS + CH * 32 * 4, SD_YB = SD_AB + CH * 4, SD_STRIDE = SD_YB + CH * 32 * 4;
struct SsdW { f32x4 w[4], b; };
__device__ __forceinline__ SsdW ssd_wload(const Params& p, int l, int ch) {
    SsdW r; const float* cw = p.in[I_CW] + (size_t)l * 4 * 768 + ch;
#pragma unroll
    for (int j = 0; j < 4; ++j) r.w[j] = *(const f32x4*)(cw + j * 768);
    r.b = *(const f32x4*)(p.in[I_CB] + l * 768 + ch);
    return r;
}
__device__ __forceinline__ f32x4 silu4(f32x4 a) { f32x4 o; o[0] = siluf_(a[0]); o[1] = siluf_(a[1]); o[2] = siluf_(a[2]); o[3] = siluf_(a[3]); return o; }
struct SsdRaw { h16x4 rows[11]; h16x4 rx[4]; float dtraw; };
template <int R> __device__ __forceinline__ void ssd_issue(SsdRaw& rw, const h16* proj, int t0, int h, int chbc, int chxs, int lt) {
    const int tq = lt >> 6;
    const int tA = t0 + tq * 8, posA = tA & (SEQ_ - 1);
    const h16x4 hz = {(h16)0.f, (h16)0.f, (h16)0.f, (h16)0.f};
#pragma unroll
    for (int j = 0; j < 11; ++j) rw.rows[j] = (posA - 3 + j >= 0) ? *(const h16x4*)(proj + (size_t)(tA - 3 + j) * NP + C_SX + chbc) : hz;
    const int tokx = (lt / (4 * R)) & 31, tX = t0 + tokx, posX = tX & (SEQ_ - 1);
#pragma unroll
    for (int j = 0; j < 4; ++j) rw.rx[j] = (posX - 3 + j >= 0) ? *(const h16x4*)(proj + (size_t)(tX - 3 + j) * NP + C_SX + chxs) : hz;
    rw.dtraw = (float)proj[(size_t)tX * NP + C_SDT + h];
}
template <int R> __device__ __forceinline__ void ssd_commit(const SsdRaw& rw, const SsdW& wbc, const SsdW& wxs, float dtb, float Ah, LAS unsigned char* buf, int lt) {
    LAS float* sh = (LAS float*)(buf + SD_SH);
    const int gi = lt & 63, tq = lt >> 6, vec = gi >> 5, gj = gi & 31;
    const int tokx = (lt / (4 * R)) & 31, r8 = lt & (4 * R - 1);
#pragma unroll
    for (int j = 0; j < 8; ++j) {
        f32x4 acc = wbc.b;
#pragma unroll
        for (int k = 0; k < 4; ++k) acc += h4f(rw.rows[j + k]) * wbc.w[k];
        *(LAS f32x4*)(sh + ((tq * 8 + j) * 16 + (gj >> 1)) * 20 + vec * 8 + (gj & 1) * 4) = silu4(acc);
    }
    {
        f32x4 acc = wxs.b;
#pragma unroll
        for (int k = 0; k < 4; ++k) acc += h4f(rw.rx[k]) * wxs.w[k];
        const f32x4 xs = silu4(acc);
        const float dt = softplusf_(rw.dtraw + dtb);
        if (lt < 128 * R) {
            *(LAS f32x4*)(buf + SD_XS + (tokx * 32 + r8 * 4) * 4) = xs;
            *(LAS f32x4*)(buf + SD_XDT + (tokx * 32 + r8 * 4) * 4) = xs * dt;
            if (r8 == 0) *(LAS float*)(buf + SD_AB + tokx * 4) = __expf(dt * Ah);
        }
    }
}
template <int R> __device__ __forceinline__ void ssd_write_y(const h16* proj, h16* mix, int t0, int cc0, LAS unsigned char* ybuf, int lt) {
    if (lt >= 128 * R) return;
    const int tok = lt / (4 * R), r8 = lt & (4 * R - 1), cc = cc0 + r8 * 4;
    const f32x4 y = *(const LAS f32x4*)(ybuf + (tok * 32 + r8 * 4) * 4);
    const f32x4 z = h4f(*(const h16x4*)(proj + (size_t)(t0 + tok) * NP + C_SZ + cc));
    *(h16x4*)(mix + (size_t)(t0 + tok) * DM + 512 + cc) = f4h(y * silu4(z));
}
template <int R> __device__ __forceinline__ void ssd_scan(const Params& p, int l, int item, LAS unsigned char* lds, const int tidx) {
    constexpr int NQ = 4 / R;
    const int b = item / (4 * NQ), h = (item / NQ) & 3, q2 = item % NQ;
    const int tid = tidx, wid = tid >> 6, lane = tid & 63, lt = tid - 256;
    const h16* proj = (const h16*)(p.ws + OFF_BIG);
    h16* mix = (h16*)(p.ws + OFF_MIX);
    const int tb = b * SEQ_, cc0 = h * 64 + q2 * 16 * R;
    const bool loader = wid >= 4;
    const int rowl = (wid & 3) * 4 + (lane >> 4), sub = lane & 15;
    LAS float* dump = (LAS float*)(lds + LDS_BYTES - 8192) + tid;
    const float dtb = p.in[I_DTB][l * 4 + h], Ah = -__expf(p.in[I_ALOG][l * 4 + h]), Dh = p.in[I_SD][l * 4 + h];
    const int chbc = 256 + ((lt & 63) >> 5) * 256 + (h >> 1) * 128 + (lt & 31) * 4, chxs = cc0 + (lt & (4 * R - 1)) * 4;
    SsdW wbc, wxs;
    if (loader) { wbc = ssd_wload(p, l, chbc); wxs = ssd_wload(p, l, chxs); }
    f32x4 Sa0 = {0.f, 0.f, 0.f, 0.f}, Sa1 = Sa0, Sb0 = Sa0, Sb1 = Sa0;
    __syncthreads();
    SsdRaw rw;
    if (loader) { ssd_issue<R>(rw, proj, tb, h, chbc, chxs, lt); ssd_commit<R>(rw, wbc, wxs, dtb, Ah, lds, lt); ssd_issue<R>(rw, proj, tb + CH, h, chbc, chxs, lt); }
    __syncthreads();
#pragma unroll 1
    for (int c = 0; c < SEQ_ / CH; ++c) {
        LAS unsigned char* buf = lds + (c & 1) * SD_STRIDE;
        if (loader) {
            if (c + 1 < SEQ_ / CH) ssd_commit<R>(rw, wbc, wxs, dtb, Ah, lds + ((c + 1) & 1) * SD_STRIDE, lt);
            if (c + 2 < SEQ_ / CH) ssd_issue<R>(rw, proj, tb + (c + 2) * CH, h, chbc, chxs, lt);
            if (c > 0) ssd_write_y<R>(proj, mix, tb + (c - 1) * CH, cc0, lds + ((c - 1) & 1) * SD_STRIDE + SD_YB, lt);
        } else {
            const LAS float* sh = (const LAS float*)(buf + SD_SH);
            const LAS float* xdt = (const LAS float*)(buf + SD_XDT);
            const LAS float* xsb = (const LAS float*)(buf + SD_XS);
            const LAS float* ab = (const LAS float*)(buf + SD_AB);
            LAS float* yb = (LAS float*)(buf + SD_YB);
            const LAS f32x4* q0 = (const LAS f32x4*)(sh + sub * 20);
            f32x4 nB0 = q0[0], nB1 = q0[1], nC0 = q0[2], nC1 = q0[3];
            float na = ab[0], nxda = xdt[rowl], nxdb = xdt[rowl + 16], nxsa = xsb[rowl], nxsb = xsb[rowl + 16];
#pragma unroll 4
            for (int s = 0; s < CH; ++s) {
                const f32x4 B0 = nB0, B1 = nB1, C0 = nC0, C1 = nC1;
                const float a = na, xda = nxda, xdb = nxdb, xsa = nxsa, xsb2 = nxsb;
                const LAS f32x4* q = (const LAS f32x4*)(sh + ((s + 1) * 16 + sub) * 20);
                nB0 = q[0]; nB1 = q[1]; nC0 = q[2]; nC1 = q[3];
                na = ab[s + 1]; nxda = xdt[(s + 1) * 32 + rowl]; nxsa = xsb[(s + 1) * 32 + rowl];
                if (R == 2) { nxdb = xdt[(s + 1) * 32 + rowl + 16]; nxsb = xsb[(s + 1) * 32 + rowl + 16]; }
                Sa0 = Sa0 * a + B0 * xda; Sa1 = Sa1 * a + B1 * xda;
                const float ya = sum16(dot4(Sa0, C0) + dot4(Sa1, C1)) + Dh * xsa;
                LAS float* wp = (sub == 0) ? (yb + s * 32 + rowl) : dump;
                wp[0] = ya;
                if (R == 2) {
                    Sb0 = Sb0 * a + B0 * xdb; Sb1 = Sb1 * a + B1 * xdb;
                    wp[16] = sum16(dot4(Sb0, C0) + dot4(Sb1, C1)) + Dh * xsb2;
                }
            }
        }
        __syncthreads();
    }
    if (loader) ssd_write_y<R>(proj, mix, tb + (SEQ_ / CH - 1) * CH, cc0, lds + ((SEQ_ / CH - 1) & 1) * SD_STRIDE + SD_YB, lt);
}

__device__ __forceinline__ void attn_item(const Params& p, int item, int wid, const int tidx) {
    const int b = item / 192, rem = item - b * 192, h = rem / 48, s = rem - h * 48;
    int br, dil, r, n;
    if (s < 16) { br = 0; dil = 1; r = 0; n = s; } else if (s < 32) { br = 1; dil = 4; r = (s - 16) >> 2; n = (s - 16) & 3; } else { br = 2; dil = 16; r = s - 32; n = 0; }
    const int lane = tidx & 63, c16 = lane & 15, g = lane >> 4;
    const h16* base = (const h16*)(p.ws + OFF_BIG) + (size_t)b * SEQ_ * NP;
    const int tq = (n * 128 + 16 * wid + c16) * dil + r;
    h16x8 qf0 = *(const h16x8*)(base + (size_t)tq * NP + C_AQ + h * 64 + g * 8);
    h16x8 qf1 = *(const h16x8*)(base + (size_t)tq * NP + C_AQ + h * 64 + 32 + g * 8);
    f32x4 sc[9];
    h16x8 kf0[9], kf1[9];
    h16x4 vreg[36];
#pragma unroll
    for (int kt = 0; kt < 9; ++kt) {
        int kp = (n - 1) * 128 + 16 * wid + 16 * kt + c16; kp = kp < 0 ? 0 : kp;
        const h16* kr = base + (size_t)(kp * dil + r) * NP + C_AK + h * 64 + g * 8;
        kf0[kt] = *(const h16x8*)kr; kf1[kt] = *(const h16x8*)(kr + 32);
    }
#pragma unroll
    for (int kt = 0; kt < 9; ++kt)
#pragma unroll
        for (int rg = 0; rg < 4; ++rg) {
            int kp = (n - 1) * 128 + 16 * wid + 16 * kt + 4 * g + rg; kp = kp < 0 ? 0 : kp;
            vreg[kt * 4 + rg] = *(const h16x4*)(base + (size_t)(kp * dil + r) * NP + C_AV + h * 64 + 4 * c16);
        }
    __builtin_amdgcn_sched_barrier(0);
#pragma unroll
    for (int kt = 0; kt < 9; ++kt) {
        f32x4 a = {0.f, 0.f, 0.f, 0.f};
        a = __builtin_amdgcn_mfma_f32_16x16x32_f16(kf0[kt], qf0, a, 0, 0, 0);
        a = __builtin_amdgcn_mfma_f32_16x16x32_f16(kf1[kt], qf1, a, 0, 0, 0);
        sc[kt] = a;
    }
    const float slope = exp2f(-2.0f * (float)(h + 1)) * (float)dil;
    float m = -INFINITY;
#pragma unroll
    for (int kt = 0; kt < 9; ++kt)
#pragma unroll
        for (int rg = 0; rg < 4; ++rg) {
            const int jj = 16 * kt + 4 * g + rg, dist = 128 + c16 - jj;
            const bool valid = (dist >= 0) && (dist <= 128) && (n > 0 || (16 * wid + jj) >= 128);
            const float v = valid ? (sc[kt][rg] * 0.125f - slope * (float)dist) : -INFINITY;
            sc[kt][rg] = v; m = fmaxf(m, v);
        }
    m = fmaxf(m, __shfl_xor(m, 16)); m = fmaxf(m, __shfl_xor(m, 32));
    float lsum = 0.f;
#pragma unroll
    for (int kt = 0; kt < 9; ++kt)
#pragma unroll
        for (int rg = 0; rg < 4; ++rg) { const float e = __expf(sc[kt][rg] - m); sc[kt][rg] = e; lsum += e; }
    lsum += __shfl_xor(lsum, 16); lsum += __shfl_xor(lsum, 32);
    f32x4 o[4];
#pragma unroll
    for (int d = 0; d < 4; ++d) o[d] = (f32x4){0.f, 0.f, 0.f, 0.f};
#pragma unroll
    for (int kt = 0; kt < 9; ++kt)
#pragma unroll
        for (int rg = 0; rg < 4; ++rg) {
            const f32x4 v = h4f(vreg[kt * 4 + rg]);
#pragma unroll
            for (int d = 0; d < 4; ++d) o[d] = __builtin_amdgcn_mfma_f32_16x16x4f32(sc[kt][rg], v[d], o[d], 0, 0, 0);
        }
    h16* dst; int ld, co;
    if (br == 0) { dst = (h16*)(p.ws + OFF_MIX); ld = DM; co = 256; } else { dst = (h16*)(p.ws + (br == 1 ? OFF_O2 : OFF_O3)); ld = 256; co = 0; }
    float* lse = (float*)(p.ws + OFF_LSE) + (size_t)br * T_ * 4;
#pragma unroll
    for (int rg = 0; rg < 4; ++rg) {
        const int q = 4 * g + rg;
        const float inv = __builtin_amdgcn_rcpf(__shfl(lsum, q));
        const int t = b * SEQ_ + (n * 128 + 16 * wid + q) * dil + r;
        h16x4 ov; ov[0] = (h16)(o[0][rg] * inv); ov[1] = (h16)(o[1][rg] * inv); ov[2] = (h16)(o[2][rg] * inv); ov[3] = (h16)(o[3][rg] * inv);
        *(h16x4*)(dst + (size_t)t * ld + co + h * 64 + 4 * c16) = ov;
    }
    if (g == 0) lse[(size_t)(b * SEQ_ + tq) * 4 + h] = m + __logf(lsum);
}

__device__ __forceinline__ void mix_phase(const Params& p, int l, int cidx, int imask, LAS unsigned char* lds, const int tidx) {
    unsigned* ctr = (unsigned*)(p.ws + OFF_MISC) + cidx;
    unsigned* actr = (unsigned*)(p.ws + OFF_MISC) + 8 + cidx;
    LAS unsigned* slot = (LAS unsigned*)(lds + LDS_BYTES - 16);
    constexpr int NA = 128 / R_RWKV, NB = 128 / R_SSD, NC = 128 / R_HGRN;
    for (;;) {
        __syncthreads();
        if (tidx == 0) *slot = atomicAdd(ctr, 1u);
        __syncthreads();
        const int it = (int)*slot;
        if (it >= NA + NB + NC) break;
        int t2 = tidx; asm volatile("" : "+v"(t2));
        if (it < NA) { if (imask & 1) rwkv_scan<R_RWKV>(p, it, lds, t2); }
        else if (it < NA + NB) { if (imask & 2) ssd_scan<R_SSD>(p, l, it - NA, lds, t2); }
        else { if (imask & 4) hgrn_scan<R_HGRN>(p, l, it - NA - NB, lds, t2); }
    }
    if (imask & 8) {
        for (;;) {
            unsigned w0 = 0;
            if ((tidx & 63) == 0) w0 = atomicAdd(actr, 4u);
            w0 = (unsigned)__builtin_amdgcn_readfirstlane((int)w0);
            if (w0 >= 1536u * 8u) break;
#pragma unroll 1
            for (unsigned w = w0; w < w0 + 4u; ++w) {
                int t2 = tidx; asm volatile("" : "+v"(t2));
                attn_item(p, (int)(w >> 3), (int)(w & 7u), t2);
            }
        }
    }
}

__device__ __forceinline__ void post_phase(const Params& p, int l, const int tidx) {
    const int wid = tidx >> 6, lane = tidx & 63;
    h16* mix = (h16*)(p.ws + OFF_MIX);
    const h16* prep = (const h16*)p.out;
    const h16* proj = (const h16*)(p.ws + OFF_BIG);
    const h16* o2 = (const h16*)(p.ws + OFF_O2);
    const h16* o3 = (const h16*)(p.ws + OFF_O3);
    const float* lse = (const float*)(p.ws + OFF_LSE);
    const f32x4 snw = *(const f32x4*)(p.in[I_SNW] + l * 256 + 4 * lane);
    const f32x4 hnw = *(const f32x4*)(p.in[I_HNW] + l * 256 + 4 * lane);
    const int hd = lane >> 4;
#pragma unroll 2
    for (int t = blockIdx.x * 8 + wid; t < T_; t += gridDim.x * 8) {
        h16* mr = mix + (size_t)t * DM + 4 * lane;
        {
            const f32x4 y = h4f(*(const h16x4*)mr);
            const float mu = sum16(y[0] + y[1] + y[2] + y[3]) * (1.0f / 64.0f);
            const f32x4 d = y - mu;
            const float var = sum16(d[0] * d[0] + d[1] * d[1] + d[2] * d[2] + d[3] * d[3]) * (1.0f / 64.0f);
            const float rstd = rsqrtf(var + 64e-5f);
            const f32x4 A = h4f(*(const h16x4*)(prep + (size_t)t * 2048 + 1536 + 4 * lane));
            const f32x4 Bc = h4f(*(const h16x4*)(prep + (size_t)t * 2048 + 1792 + 4 * lane));
            *(h16x4*)mr = f4h(d * rstd * A + Bc);
        }
        {
            const f32x4 a1 = h4f(*(const h16x4*)(mr + 256));
            const f32x4 a2 = h4f(*(const h16x4*)(o2 + (size_t)t * 256 + 4 * lane));
            const f32x4 a3 = h4f(*(const h16x4*)(o3 + (size_t)t * 256 + 4 * lane));
            const float l1 = lse[(size_t)t * 4 + hd], l2 = lse[(size_t)(T_ + t) * 4 + hd], l3 = lse[(size_t)(2 * T_ + t) * 4 + hd];
            const float mx = fmaxf(l1, fmaxf(l2, l3));
            const float w1 = __expf(l1 - mx), w2 = __expf(l2 - mx), w3 = __expf(l3 - mx);
            const float inv = __builtin_amdgcn_rcpf(w1 + w2 + w3);
            *(h16x4*)(mr + 256) = f4h((a1 * w1 + a2 * w2 + a3 * w3) * inv);
        }
        {
            const f32x4 u = h4f(*(const h16x4*)(mr + 512));
            float ss = sum16(u[0] * u[0] + u[1] * u[1] + u[2] * u[2] + u[3] * u[3]);
            ss += __shfl_xor(ss, 16);
            const float rstd = rsqrtf(ss * (1.0f / 128.0f) + 1e-5f);
            *(h16x4*)(mr + 512) = f4h(u * rstd * snw);
        }
        {
            const f32x4 u = h4f(*(const h16x4*)(mr + 768));
            const float ss = sum16(u[0] * u[0] + u[1] * u[1] + u[2] * u[2] + u[3] * u[3]);
            const float rstd = rsqrtf(ss * (1.0f / 64.0f) + 1e-5f);
            const f32x4 gz = h4f(*(const h16x4*)(proj + (size_t)t * NP + C_HG + 4 * lane));
            f32x4 gt; gt[0] = siluf_(gz[0]); gt[1] = siluf_(gz[1]); gt[2] = siluf_(gz[2]); gt[3] = siluf_(gz[3]);
            *(h16x4*)(mr + 768) = f4h(u * rstd * hnw * gt);
        }
    }
}

__device__ __forceinline__ void ln_phase(const Params& p, const float* w, const float* bvec, bool final_out, const int tidx) {
    const int wid = tidx >> 6, lane = tidx & 63;
    h16* x16 = (h16*)(p.ws + OFF_X16);
    f32x4 wv[4], bv[4];
#pragma unroll
    for (int q = 0; q < 4; ++q) { wv[q] = *(const f32x4*)(w + lane * 16 + 4 * q); bv[q] = *(const f32x4*)(bvec + lane * 16 + 4 * q); }
#pragma unroll 2
    for (int t = blockIdx.x * 8 + wid; t < T_; t += gridDim.x * 8) {
        h16* row = x16 + (size_t)t * DM + lane * 16;
        const h16x8 v0 = *(const h16x8*)row, v1 = *(const h16x8*)(row + 8);
        float x[16];
#pragma unroll
        for (int j = 0; j < 8; ++j) { x[j] = (float)v0[j]; x[8 + j] = (float)v1[j]; }
        float s = 0.f;
#pragma unroll
        for (int j = 0; j < 16; ++j) s += x[j];
        const float mu = sum64(s) * (1.0f / 1024.0f);
        float q2 = 0.f;
#pragma unroll
        for (int j = 0; j < 16; ++j) { x[j] -= mu; q2 += x[j] * x[j]; }
        const float rstd = rsqrtf(sum64(q2) * (1.0f / 1024.0f) + 1e-5f);
#pragma unroll
        for (int j = 0; j < 16; ++j) x[j] = x[j] * rstd * wv[j >> 2][j & 3] + bv[j >> 2][j & 3];
        if (final_out) {
            float* orow = p.out + (size_t)t * DM + lane * 16;
#pragma unroll
            for (int q = 0; q < 4; ++q) *(f32x4*)(orow + 4 * q) = (f32x4){x[4 * q], x[4 * q + 1], x[4 * q + 2], x[4 * q + 3]};
        } else {
            h16x8 o0, o1;
#pragma unroll
            for (int j = 0; j < 8; ++j) { o0[j] = (h16)x[j]; o1[j] = (h16)x[8 + j]; }
            *(h16x8*)row = o0; *(h16x8*)(row + 8) = o1;
        }
    }
}

constexpr int NPHASE = 19;
__device__ __forceinline__ void run_phase(const Params& p, int ph, LAS unsigned char* lds, const int tidx, const int rep) {
    const int l = (ph == 0) ? 0 : (ph - 1) / 9, s = (ph == 0) ? -1 : (ph - 1) % 9;
    h16* x16 = (h16*)(p.ws + OFF_X16);
    h16* mix = (h16*)(p.ws + OFF_MIX);
    h16* big = (h16*)(p.ws + OFF_BIG);
    if (ph == 0) {
        if (blockIdx.x == 0) for (int i = tidx; i < 256 + 3456; i += 512) ((unsigned*)(p.ws + OFF_MISC))[i] = 0u;
        conv_x(p, tidx);
    }
    if (s == 0 || s == 4 || s == 6 || s == 7) {
        const h16* A = (s == 0 || s == 6) ? x16 : (s == 4 ? mix : big);
        const h16* Bt = (const h16*)(p.ws + (s == 0 ? OFF_WIN : s == 4 ? OFF_WOUT : s == 6 ? OFF_WUP : OFF_WDN));
        const int N = (s == 0) ? NP : (s == 6 ? DFF : DM), K = (s == 7) ? DFF : DM;
        h16* O = (s == 0 || s == 6) ? big : x16;
        run_gemm(lds, A, Bt, N, K, O, N, (s == 0) ? 0 : (s == 6 ? 1 : 2), tidx);
    }
    if (s == 1) pre_phase(p, l, lds, tidx);
    if (s == 2) mix_phase(p, l, 2 * rep + l, rep ? DUPITEMS : 15, lds, tidx);
    if (s == 3) post_phase(p, l, tidx);
    if (s == 5 || s == 8) ln_phase(p, p.in[s == 5 ? I_LN1W : I_LN2W] + l * DM, p.in[s == 5 ? I_LN1B : I_LN2B] + l * DM, s == 8 && l == 1, tidx);
    if (ph == 0 || (s == 8 && l == 0)) conv_weights(p, ph == 0 ? 0 : 1, lds, tidx);
}

__global__ void __launch_bounds__(512, 2) k_phase(Params p, int ph) {
    extern __shared__ __attribute__((aligned(16))) unsigned char shm[];
    const int tidx = threadIdx.x;
    run_phase(p, ph, (LAS unsigned char*)shm, tidx, 0);
}

#define XB_TMO      128
#define XB_XCNT(j)  (256  + 64 * (j))
#define XB_XSUB(j)  (1280 + 64 * (j))
#define XB_XGEN(j)  (2304 + 64 * (j))
#define XB_TOP      3328
#define XB_TOPGEN   3392
#define XCD_BAR_WORDS 3456
#define XB_SPIN_CAP (1u << 18)

__device__ __forceinline__ unsigned xb_ld(unsigned* p)              { return __hip_atomic_load(p, __ATOMIC_RELAXED, __HIP_MEMORY_SCOPE_AGENT); }
__device__ __forceinline__ unsigned xb_add(unsigned* p, unsigned v) { return __hip_atomic_fetch_add(p, v, __ATOMIC_RELAXED, __HIP_MEMORY_SCOPE_AGENT); }
__device__ __forceinline__ unsigned xb_xcc_id() { return (unsigned)__builtin_amdgcn_s_getreg((3 << 11) | 20) & 0xFu; }
#define XB_SPIN(cond, bar) do { unsigned _sp = 0; while (cond) { __builtin_amdgcn_s_sleep(1); \
    if ((++_sp & 255u) == 0u) { if (xb_ld(&(bar)[XB_TMO])) break; if (_sp > XB_SPIN_CAP) { atomicAdd(&(bar)[XB_TMO], 1u); break; } } } } while (0)

struct XcdBarrier {
    unsigned* bar; unsigned x;
    volatile LAS unsigned* st;
};

__device__ __forceinline__ XcdBarrier xcd_barrier_post(unsigned* bar, volatile LAS unsigned* st) {
    XcdBarrier b; b.bar = bar; b.x = xb_xcc_id(); b.st = st;
    if (threadIdx.x == 0) (void)xb_add(&bar[XB_XCNT(b.x)], 1u);
    return b;
}
__device__ __forceinline__ void xcd_barrier_complete(unsigned* bar, unsigned x, unsigned& nloc, unsigned& nx) {
    const unsigned G = gridDim.x * gridDim.y * gridDim.z;
    unsigned sum, cnt, mine, sp = 0u;
    for (;;) {
        sum = 0u; cnt = 0u; mine = 0u;
#pragma unroll
        for (unsigned j = 0; j < 16; ++j) { const unsigned c = xb_ld(&bar[XB_XCNT(j)]); sum += c; cnt += (c > 0u) ? 1u : 0u; mine = (j == x) ? c : mine; }
        if (sum == G) break;
        __builtin_amdgcn_s_sleep(1);
        if ((++sp & 255u) == 0u) { if (xb_ld(&bar[XB_TMO])) break; if (sp > XB_SPIN_CAP) { atomicAdd(&bar[XB_TMO], 1u); break; } }
    }
    nloc = mine > 0u ? mine : 1u; nx = cnt > 0u ? cnt : 1u;
}

__device__ __forceinline__ void xcd_barrier(const XcdBarrier& b) {
    asm volatile("s_waitcnt vmcnt(0)" ::: "memory");
    __syncthreads();
    if (threadIdx.x == 0) {
        unsigned* bar = b.bar;
        __builtin_amdgcn_s_waitcnt(0);
        unsigned nloc = b.st[0], nx = b.st[1];
        if (nloc == 0u) { xcd_barrier_complete(bar, b.x, nloc, nx); b.st[0] = nloc; b.st[1] = nx; }
        const unsigned old = xb_add(&bar[XB_XSUB(b.x)], 1u);
        const unsigned gen = old / nloc;
        if (old + 1u == (gen + 1u) * nloc) {
            __builtin_amdgcn_fence(__ATOMIC_RELEASE, "agent");
            asm volatile("s_waitcnt vmcnt(0)" ::: "memory");
            const unsigned og = xb_add(&bar[XB_TOP], 1u);
            const unsigned tg = og / nx;
            if (og + 1u == (tg + 1u) * nx) xb_add(&bar[XB_TOPGEN], 1u);
            else XB_SPIN(xb_ld(&bar[XB_TOPGEN]) == tg, bar);
            __builtin_amdgcn_fence(__ATOMIC_ACQUIRE, "agent");
            xb_add(&bar[XB_XGEN(b.x)], 1u);
            asm volatile("s_waitcnt vmcnt(0)" ::: "memory");
        } else {
            XB_SPIN(xb_ld(&bar[XB_XGEN(b.x)]) == gen, bar);
            __builtin_amdgcn_fence(__ATOMIC_ACQUIRE, "agent");
            asm volatile("s_waitcnt vmcnt(0)" ::: "memory");
        }
    }
    __syncthreads();
}


#ifndef DUPITEMS
#define DUPITEMS 15
#endif
#ifndef DUPMASK
#define DUPMASK 0
#endif
#if COOP
__global__ void __launch_bounds__(512, 2) k_mega(Params p) {
    extern __shared__ __attribute__((aligned(16))) unsigned char shm[];
    cg::grid_group grid = cg::this_grid();
    unsigned* barw = (unsigned*)(p.ws + OFF_MISC + 1024);
    volatile LAS unsigned* xst = (volatile LAS unsigned*)((LAS unsigned char*)shm + LDS_BYTES);
    if (threadIdx.x < 4) xst[threadIdx.x] = 0u;
    XcdBarrier xb; xb.bar = barw; xb.x = 0; xb.st = xst;
#pragma unroll 1
    for (int ph = 0; ph < NPHASE; ++ph) {
        const int nrep = ((DUPMASK >> ph) & 1) ? 2 : 1;
#pragma unroll 1
        for (int rep = 0; rep < nrep; ++rep) {
            int tidx = threadIdx.x; asm volatile("" : "+v"(tidx));
            run_phase(p, ph, (LAS unsigned char*)shm, tidx, rep);
            if (ph == 0) { grid.sync(); xb = xcd_barrier_post(barw, xst); }
            else if (ph + 1 < NPHASE) xcd_barrier(xb);
        }
#ifdef EXTRA_SYNCS
        if (ph == 1) for (int i = 0; i < EXTRA_SYNCS; ++i) xcd_barrier(xb);
#endif
    }
}
#endif

extern "C" void kernel_launch(void* const* d_in, const int* in_sizes, int n_in, void* d_out, int out_size, void* d_ws, size_t ws_size, hipStream_t stream) {
    static int grid_blocks = 0;
    if (!grid_blocks) {
        int dev = 0, cus = 0, per_cu = 0;
        hipGetDevice(&dev);
        hipDeviceGetAttribute(&cus, hipDeviceAttributeMultiprocessorCount, dev);
        hipFuncSetAttribute((const void*)k_phase, hipFuncAttributeMaxDynamicSharedMemorySize, LDS_TOTAL);
#if COOP
        hipFuncSetAttribute((const void*)k_mega, hipFuncAttributeMaxDynamicSharedMemorySize, LDS_TOTAL);
        hipOccupancyMaxActiveBlocksPerMultiprocessor(&per_cu, (const void*)k_mega, 512, LDS_TOTAL);
#endif
        if (per_cu < 1) per_cu = 1;
        grid_blocks = cus * 1;
        (void)hipGetLastError();
    }
    Params p{};
    for (int i = 0; i < 32; ++i) p.in[i] = (const float*)d_in[i];
    p.out = (float*)d_out; p.ws = (unsigned char*)d_ws;
#if COOP
    void* args[] = {&p};
    hipError_t e = hipLaunchCooperativeKernel((const void*)k_mega, dim3(grid_blocks), dim3(512), args, LDS_TOTAL, stream);
    if (e != hipSuccess) fprintf(stderr, "cooperative launch failed: %s (grid %d)\n", hipGetErrorString(e), grid_blocks);
#else
    for (int ph = 0; ph < NPHASE; ++ph) k_phase<<<dim3(grid_blocks), dim3(512), LDS_TOTAL, stream>>>(p, ph);
#endif
}
```

```cpp
#include <hip/hip_runtime.h>
#include <hip/hip_cooperative_groups.h>
#include <cstdio>
namespace cg = cooperative_groups;

#ifndef COOP
#define COOP 1
#endif
#ifndef DUPITEMS
#define DUPITEMS 15
#endif
#ifndef R_RWKV
#define R_RWKV 2
#endif
#ifndef R_SSD
#define R_SSD 2
#endif
#ifndef R_HGRN
#define R_HGRN 2
#endif

#define LAS __attribute__((address_space(3)))
typedef _Float16 h16;
typedef _Float16 h16x4 __attribute__((ext_vector_type(4)));
typedef _Float16 h16x8 __attribute__((ext_vector_type(8)));
typedef float f32x2 __attribute__((ext_vector_type(2)));
typedef float f32x4 __attribute__((ext_vector_type(4)));

constexpr int T_ = 16384, SEQ_ = 2048, DM = 1024, NP = 3840, DFF = 4096, INC = 3716;
constexpr int C_R = 0, C_K = 256, C_V = 512, C_FW = 768, C_VR = 896, C_AQ = 928, C_AK = 1184, C_AV = 1440;
constexpr int C_SZ = 1696, C_SX = 1952, C_SDT = 2720, C_HQ = 2728, C_HF = 2984, C_HI = 3240, C_HG = 3496;
constexpr float ALPHA_ = 1.41421356237f;
constexpr size_t OFF_WIN = 0, OFF_WOUT = 7864320, OFF_WUP = OFF_WOUT + 2097152, OFF_WDN = OFF_WUP + 8388608;
constexpr size_t OFF_X16 = 26738688, OFF_MIX = OFF_X16 + 33554432, OFF_BIG = OFF_MIX + 33554432;
constexpr size_t OFF_VF = OFF_BIG + 134217728, OFF_O2 = OFF_VF + 8388608, OFF_O3 = OFF_O2 + 8388608, OFF_LSE = OFF_O3 + 8388608;
constexpr size_t OFF_MISC = OFF_LSE + 786432;
constexpr int LDS_BYTES = 131072, LDS_TOTAL = 131072 + 64;

struct Params { const float* in[32]; float* out; unsigned char* ws; };

enum { I_X = 0, I_LB, I_WIN, I_WINV, I_MU, I_MUV, I_W0, I_W2, I_A0, I_A2, I_G2, I_KK, I_KA, I_RK, I_LNW, I_LNB, I_V0, I_V2,
       I_CW, I_CB, I_DTB, I_ALOG, I_SD, I_SNW, I_HNW, I_WOUT, I_LN1W, I_LN1B, I_WUP, I_WDN, I_LN2W, I_LN2B };

template <int CTRL> __device__ __forceinline__ float dpp_f(float x) {
    return __builtin_bit_cast(float, __builtin_amdgcn_update_dpp(0, __builtin_bit_cast(int, x), CTRL, 0xF, 0xF, true));
}
__device__ __forceinline__ float sum16(float x) {
    x += dpp_f<0xB1>(x);
    x += dpp_f<0x4E>(x);
    x += dpp_f<0x141>(x);
    x += dpp_f<0x140>(x);
    return x;
}
__device__ __forceinline__ float sum64(float x) { x = sum16(x); x += __shfl_xor(x, 16); x += __shfl_xor(x, 32); return x; }
__device__ __forceinline__ float sigmoidf_(float x) { return __builtin_amdgcn_rcpf(1.0f + __expf(-x)); }
__device__ __forceinline__ float siluf_(float x) { return x * __builtin_amdgcn_rcpf(1.0f + __expf(-x)); }
__device__ __forceinline__ float softplusf_(float x) { return fmaxf(x, 0.f) + __logf(1.0f + __expf(-fabsf(x))); }
__device__ __forceinline__ f32x4 h4f(h16x4 v) { return (f32x4){(float)v[0], (float)v[1], (float)v[2], (float)v[3]}; }
__device__ __forceinline__ h16x4 f4h(f32x4 v) { return (h16x4){(h16)v[0], (h16)v[1], (h16)v[2], (h16)v[3]}; }

namespace pg8 {
constexpr int BM = 256, BK = 64, HALF = 128, HTB = HALF * BK * 2, STAGE_BYTES = 8 * HTB, NXCD = 8, WGM = 8;
__host__ __device__ __forceinline__ int lds_byte(int r, int c) { const int st = (r >> 4) * 2 + (c >> 5), rr = r & 15, cc = c & 31, ob = rr * 64 + cc * 2; return st * 1024 + (ob ^ (((ob >> 9) & 1) << 5)); }
__host__ __device__ __forceinline__ void stage_rc(int b, int& R, int& C) { const int st = b / 1024, sb = b % 1024, swz = sb ^ (((sb >> 9) & 1) << 5); R = (st >> 1) * 16 + swz / 64; C = (st & 1) * 32 + (swz % 64) / 2; }
__host__ __device__ __forceinline__ int perm32(int rho) { const int n = rho >> 4, i = rho & 15; return 8 * (i >> 2) + 4 * n + (i & 3); }
struct Unit { int pm, pn; };
struct Gemm { const h16* A; const h16* Bt; int M, N, K; };
struct StaticOrder {
    int nM, nN, nwg, G, c;
    __device__ void init(int M, int N, int G_, int c_) { nM = M / BM; nN = N / BM; nwg = nM * nN; G = G_; c = c_; }
    __device__ bool next(int i, Unit& u) const {
        const long L = (long)i * G + c; if (L >= nwg) return false;
        int wgid = (int)L; { const int q = nwg / NXCD, r = nwg % NXCD, xcd = wgid % NXCD, off = wgid / NXCD; wgid = (xcd < r ? xcd * (q + 1) : r * (q + 1) + (xcd - r) * q) + off; }
        const int nig = WGM * nN, gid = wgid / nig, fm = gid * WGM, gsz = (nM - fm) < WGM ? (nM - fm) : WGM;
        u.pm = fm + ((wgid % nig) % gsz); u.pn = (wgid % nig) / gsz; return true;
    }
};
struct EpiH {
    h16* O; int ldc; int MODE;
    __device__ __forceinline__ void operator()(const f32x4 (&acc)[2][2][4][2], const Unit& u, int wr, int wc, int fr, int fq) const {
        const int row0 = u.pm * BM + wr * 64 + fr, col0 = u.pn * BM + wc * 32 + 8 * fq;
#pragma unroll
        for (int ai = 0; ai < 2; ++ai)
#pragma unroll
            for (int m = 0; m < 4; ++m) { h16* rowp = O + (size_t)(row0 + ai * HALF + m * 16) * ldc + col0;
#pragma unroll
                for (int bj = 0; bj < 2; ++bj) { f32x4 v0 = acc[ai][bj][m][0], v1 = acc[ai][bj][m][1];
                    if (MODE == 1) {
#pragma unroll
                        for (int j = 0; j < 4; ++j) { float a = fmaxf(v0[j], 0.f), b = fmaxf(v1[j], 0.f); v0[j] = a * a; v1[j] = b * b; } }
                    if (MODE == 2) { const h16x8 x = *(const h16x8*)(rowp + bj * HALF);
#pragma unroll
                        for (int j = 0; j < 4; ++j) { v0[j] += ALPHA_ * (float)x[j]; v1[j] += ALPHA_ * (float)x[4 + j]; } }
                    h16x8 w;
#pragma unroll
                    for (int j = 0; j < 4; ++j) { w[j] = (h16)v0[j]; w[4 + j] = (h16)v1[j]; }
                    *(h16x8*)(rowp + bj * HALF) = w; } }
    }
};

template <class Epi>
__device__ __forceinline__ void gemm_phase(LAS unsigned char* lds, const Gemm g, const StaticOrder& S, const Epi& E, const int tidx) {
    const int tid = tidx, wid = __builtin_amdgcn_readfirstlane(tid >> 6), lane = tid & 63, wr = wid >> 2, wc = wid & 3, fr = lane & 15, fq = lane >> 4;
    const int K = g.K, nt = K / BK;
    unsigned voffA[2], voffB[2];
#pragma unroll
    for (int i = 0; i < 2; ++i) { int R, C; stage_rc(tid * 16 + i * 8192, R, C); const int Rb = (R & ~31) + perm32(R & 31);
        voffA[i] = (unsigned)(R * K + C) * 2u; voffB[i] = (unsigned)(Rb * K + C) * 2u; }
    const size_t kstep = (size_t)(BK * 2);
    const size_t hstep = (size_t)HALF * K * 2;
    const size_t tstep = 2 * hstep;
    const unsigned ldsw = (unsigned)wid * 1024u;
    const int aoff = lds_byte(wr * 64 + fr, fq * 8), boff = lds_byte(wc * 32 + fr, fq * 8);
#define PG8_SA(b, h) (((b) * 2 + (h)) * HTB)
#define PG8_SB(b, h) ((4 + (b) * 2 + (h)) * HTB)
#define PG8_STAGE(bufoff, gbase, voff) do { _Pragma("unroll") for (int _i = 0; _i < 2; ++_i) \
        __builtin_amdgcn_global_load_lds((const unsigned*)((const char*)(gbase) + (voff)[_i]), (LAS unsigned*)(lds + (bufoff) + ldsw + _i * 8192), 16, 0, 0); } while (0)
#define PG8_LDA(dst, b, h) do { _Pragma("unroll") for (int m = 0; m < 4; ++m) _Pragma("unroll") for (int k = 0; k < 2; ++k) dst[m][k] = *(const LAS h16x8*)(lds + PG8_SA(b, h) + aoff + m * 2048 + k * 1024); } while (0)
#define PG8_LDB(dst, b, h) do { _Pragma("unroll") for (int n = 0; n < 2; ++n) _Pragma("unroll") for (int k = 0; k < 2; ++k) dst[n][k] = *(const LAS h16x8*)(lds + PG8_SB(b, h) + boff + n * 2048 + k * 1024); } while (0)
#define PG8_MMA(ai, bj, At, Bt) do { __builtin_amdgcn_s_setprio(1); _Pragma("unroll") for (int m = 0; m < 4; ++m) _Pragma("unroll") for (int n = 0; n < 2; ++n) _Pragma("unroll") for (int k = 0; k < 2; ++k) \
        acc[ai][bj][m][n] = __builtin_amdgcn_mfma_f32_16x16x32_f16(Bt[n][k], At[m][k], acc[ai][bj][m][n], 0, 0, 0); __builtin_amdgcn_s_setprio(0); } while (0)
#define PG8_WAIT_V(n) asm volatile("s_waitcnt vmcnt(" #n ")" ::: "memory")
#define PG8_WAIT_L(n) asm volatile("s_waitcnt lgkmcnt(" #n ")" ::: "memory")
#define PG8_BAR __builtin_amdgcn_s_barrier()
#define PG8_SCHED __builtin_amdgcn_sched_barrier(0)
    Unit cur, nxt; int ui = 0;
    if (!S.next(0, cur)) return;
    f32x4 acc[2][2][4][2];
#pragma unroll
    for (int a = 0; a < 2; ++a)
#pragma unroll
        for (int b = 0; b < 2; ++b)
#pragma unroll
            for (int m = 0; m < 4; ++m)
#pragma unroll
                for (int n = 0; n < 2; ++n) acc[a][b][m][n] = (f32x4){0.f, 0.f, 0.f, 0.f};
    h16x8 At[4][2], B0[2][2], B1[2][2];
    const char* cA = (const char*)g.A + (size_t)cur.pm * tstep; const char* cB = (const char*)g.Bt + (size_t)cur.pn * tstep;
    PG8_STAGE(PG8_SB(0, 0), cB, voffB); PG8_STAGE(PG8_SA(0, 0), cA, voffA); PG8_STAGE(PG8_SB(0, 1), cB + hstep, voffB); PG8_STAGE(PG8_SA(0, 1), cA + hstep, voffA);
    if (wr == 1) PG8_BAR;
    PG8_WAIT_V(4); PG8_BAR;
    PG8_STAGE(PG8_SB(1, 0), cB + kstep, voffB); PG8_STAGE(PG8_SA(1, 0), cA + kstep, voffA); PG8_STAGE(PG8_SB(1, 1), cB + hstep + kstep, voffB);
    PG8_WAIT_V(6); PG8_BAR;
    for (;;) {
        const bool has_next = S.next(ui + 1, nxt);
        const char* nA = has_next ? (const char*)g.A + (size_t)nxt.pm * tstep : cA; const char* nB = has_next ? (const char*)g.Bt + (size_t)nxt.pn * tstep : cB;
        for (int t = 0; t < nt; t += 2) {
            const bool last = (t == nt - 2);
            const char* a1 = cA + (size_t)(t + 1) * kstep;
            const char* a2 = last ? nA : cA + (size_t)(t + 2) * kstep; const char* b2 = last ? nB : cB + (size_t)(t + 2) * kstep;
            const char* a3 = a2 + kstep; const char* b3 = b2 + kstep;
            PG8_LDB(B0, 0, 0); PG8_SCHED; PG8_LDA(At, 0, 0); PG8_STAGE(PG8_SA(1, 1), a1 + hstep, voffA);
            PG8_WAIT_L(8); PG8_BAR; PG8_WAIT_L(0); PG8_MMA(0, 0, At, B0); PG8_BAR; PG8_SCHED;
            PG8_LDB(B1, 0, 1); PG8_STAGE(PG8_SB(0, 0), b2, voffB);
            PG8_BAR; PG8_WAIT_L(0); PG8_MMA(0, 1, At, B1); PG8_BAR;
            PG8_LDA(At, 0, 1); PG8_STAGE(PG8_SA(0, 0), a2, voffA);
            PG8_BAR; PG8_WAIT_L(0); PG8_MMA(1, 0, At, B0); PG8_BAR; PG8_SCHED;
            PG8_STAGE(PG8_SB(0, 1), b2 + hstep, voffB);
            PG8_WAIT_V(6); PG8_BAR; PG8_MMA(1, 1, At, B1); PG8_BAR;
            PG8_LDB(B0, 1, 0); PG8_SCHED; PG8_LDA(At, 1, 0); PG8_STAGE(PG8_SA(0, 1), a2 + hstep, voffA);
            PG8_WAIT_L(8); PG8_BAR; PG8_WAIT_L(0); PG8_MMA(0, 0, At, B0); PG8_BAR; PG8_SCHED;
            PG8_LDB(B1, 1, 1); PG8_STAGE(PG8_SB(1, 0), b3, voffB);
            PG8_BAR; PG8_WAIT_L(0); PG8_MMA(0, 1, At, B1); PG8_BAR;
            PG8_LDA(At, 1, 1); PG8_STAGE(PG8_SA(1, 0), a3, voffA);
            PG8_BAR; PG8_WAIT_L(0); PG8_MMA(1, 0, At, B0); PG8_BAR; PG8_SCHED;
            PG8_STAGE(PG8_SB(1, 1), b3 + hstep, voffB);
            PG8_WAIT_V(6); PG8_BAR; PG8_MMA(1, 1, At, B1); PG8_BAR;
        }
        E(acc, cur, wr, wc, fr, fq);
        if (!has_next) break;
#pragma unroll
        for (int a = 0; a < 2; ++a)
#pragma unroll
            for (int b = 0; b < 2; ++b)
#pragma unroll
                for (int m = 0; m < 4; ++m)
#pragma unroll
                    for (int n = 0; n < 2; ++n) acc[a][b][m][n] = (f32x4){0.f, 0.f, 0.f, 0.f};
        cur = nxt; cA = nA; cB = nB; ++ui;
    }
    PG8_WAIT_V(0);
    if (wr == 0) PG8_BAR;
    PG8_BAR;
#undef PG8_SA
#undef PG8_SB
#undef PG8_STAGE
#undef PG8_LDA
#undef PG8_LDB
#undef PG8_MMA
#undef PG8_WAIT_V
#undef PG8_WAIT_L
#undef PG8_BAR
#undef PG8_SCHED
}
}

__device__ __forceinline__ void run_gemm(LAS unsigned char* lds, const h16* A, const h16* Bt, int N, int K, h16* O, int ldc, int mode, const int tidx) {
    pg8::Gemm g; g.A = A; g.Bt = Bt; g.M = T_; g.N = N; g.K = K;
    pg8::StaticOrder S; S.init(T_, N, (int)gridDim.x, (int)blockIdx.x);
    pg8::EpiH E; E.O = O; E.ldc = ldc; E.MODE = mode;
    pg8::gemm_phase(lds, g, S, E, tidx);
}

__device__ __forceinline__ void cw_decode(int id, int& mat, int& K, int& n0, int& k0) {
    int tl;
    if (id < 960) { mat = 0; tl = id; } else if (id < 1216) { mat = 1; tl = id - 960; } else if (id < 2240) { mat = 2; tl = id - 1216; } else { mat = 3; tl = id - 2240; }
    K = (mat == 3) ? 4096 : 1024;
    const int nkt = K / 64;
    n0 = (tl / nkt) * 64; k0 = (tl % nkt) * 64;
}
__device__ __forceinline__ void cw_load(const Params& p, int l, int id, LAS float* tile, int tid) {
    int mat, K, n0, k0; cw_decode(id, mat, K, n0, k0);
    const int nj = tid & 63, n = n0 + nj;
    const float* src = nullptr; int sstride = 0;
    if (mat == 0) {
        if (n < 896) { src = p.in[I_WIN] + (size_t)l * DM * INC + n; sstride = INC; }
        else if (n < 928) { if (l > 0) { src = p.in[I_WINV] + (size_t)(l - 1) * DM * 32 + (n - 896); sstride = 32; } }
        else if (n < 2724) { src = p.in[I_WIN] + (size_t)l * DM * INC + (n - 32); sstride = INC; }
        else if (n < 2728) { }
        else if (n < 3752) { src = p.in[I_WIN] + (size_t)l * DM * INC + (n - 36); sstride = INC; }
    } else if (mat == 1) { src = p.in[I_WOUT] + (size_t)l * 1024 * 1024 + n; sstride = 1024; }
    else if (mat == 2) { src = p.in[I_WUP] + (size_t)l * 1024 * 4096 + n; sstride = 4096; }
    else { src = p.in[I_WDN] + (size_t)l * 4096 * 1024 + n; sstride = 1024; }
    float v[8];
#pragma unroll
    for (int i = 0; i < 8; ++i) { const int ki = (tid >> 6) + 8 * i; v[i] = src ? src[(size_t)(k0 + ki) * sstride] : 0.f; }
#pragma unroll
    for (int i = 0; i < 8; ++i) { const int ki = (tid >> 6) + 8 * i; tile[ki * 65 + nj] = v[i]; }
}
__device__ __forceinline__ void cw_store(const Params& p, int id, const LAS float* tile, int tid) {
    int mat, K, n0, k0; cw_decode(id, mat, K, n0, k0);
    h16* dst = (h16*)(p.ws + (mat == 0 ? OFF_WIN : mat == 1 ? OFF_WOUT : mat == 2 ? OFF_WUP : OFF_WDN));
    const int ki = tid & 63;
#pragma unroll
    for (int i = 0; i < 8; ++i) { const int nj = (tid >> 6) + 8 * i; dst[(size_t)(n0 + nj) * K + k0 + ki] = (h16)tile[ki * 65 + nj]; }
}
__device__ __forceinline__ void conv_weights(const Params& p, int l, LAS unsigned char* lds, const int tidx) {
    LAS float* tile = (LAS float*)lds;
    const int tid = tidx;
    for (int id = blockIdx.x * 4; id < 3264; id += gridDim.x * 4) {
        __syncthreads();
#pragma unroll
        for (int u = 0; u < 4; ++u) if (id + u < 3264) cw_load(p, l, id + u, tile + u * 4224, tid);
        __syncthreads();
#pragma unroll
        for (int u = 0; u < 4; ++u) if (id + u < 3264) cw_store(p, id + u, tile + u * 4224, tid);
    }
    __syncthreads();
}

__device__ __forceinline__ void conv_x(const Params& p, const int tidx) {
    const f32x4* src = (const f32x4*)p.in[I_X]; h16x4* dst = (h16x4*)(p.ws + OFF_X16);
    for (size_t i = (size_t)blockIdx.x * 512 + tidx; i < (size_t)T_ * DM / 4; i += (size_t)gridDim.x * 512) dst[i] = f4h(src[i]);
}

__device__ __forceinline__ void pre_phase(const Params& p, int l, LAS unsigned char* lds, const int tidx) {
    constexpr int RS = 168;
    LAS h16* A16 = (LAS h16*)lds;
    LAS h16* W16 = (LAS h16*)(lds + 64 * RS * 2);
    const h16* proj = (const h16*)(p.ws + OFF_BIG);
    h16* prep = (h16*)p.out;
    h16* vfirst = (h16*)(p.ws + OFF_VF);
    const int tid = tidx, wid = tid >> 6, lane = tid & 63, c16 = lane & 15, g = lane >> 4, hh = wid & 3, mh = wid >> 2;
    const int nact = (l == 0) ? 128 : 160;
    __syncthreads();
#pragma unroll 1
    for (int e0 = 0; e0 < nact * 256; e0 += 512 * 16) {
        float wv16[16];
#pragma unroll
        for (int u = 0; u < 16; ++u) {
            const int e = e0 + u * 512 + tid, i = e >> 8, cc = e & 255;
            const float* sp;
            if (i < 32) sp = p.in[I_W2] + (size_t)(l * 32 + i) * 256 + cc;
            else if (i < 64) sp = p.in[I_A2] + (size_t)(l * 32 + i - 32) * 256 + cc;
            else if (i < 128) sp = p.in[I_G2] + (size_t)(l * 64 + i - 64) * 256 + cc;
            else sp = p.in[I_V2] + (size_t)((l - 1) * 32 + i - 128) * 256 + cc;
            wv16[u] = *sp;
        }
#pragma unroll
        for (int u = 0; u < 16; ++u) { const int e = e0 + u * 512 + tid; W16[(e & 255) * RS + (e >> 8)] = (h16)wv16[u]; }
    }
    float mu_r[4], mu_k[4], mu_v[4], w0[4], a0[4], k_k[4], k_a[4], r_k[4], lnw[4], lnb[4], v0[4];
#pragma unroll
    for (int nt = 0; nt < 4; ++nt) {
        const int ch = hh * 64 + nt * 16 + c16;
        mu_r[nt] = p.in[I_MU][l * 896 + ch]; mu_k[nt] = p.in[I_MU][l * 896 + 256 + ch]; mu_v[nt] = p.in[I_MU][l * 896 + 512 + ch];
        w0[nt] = p.in[I_W0][l * 256 + ch]; a0[nt] = p.in[I_A0][l * 256 + ch]; k_k[nt] = p.in[I_KK][l * 256 + ch]; k_a[nt] = p.in[I_KA][l * 256 + ch];
        r_k[nt] = p.in[I_RK][l * 256 + ch]; lnw[nt] = p.in[I_LNW][l * 256 + ch]; lnb[nt] = p.in[I_LNB][l * 256 + ch];
        v0[nt] = (l > 0) ? p.in[I_V0][(l - 1) * 256 + ch] : 0.f;
    }
    for (int tt = blockIdx.x; tt < T_ / 64; tt += gridDim.x) {
        const int t0 = tt * 64;
        __syncthreads();
#pragma unroll 1
        for (int eb = 0; eb < 20; eb += 10) {
            float curv[10], prvv[10];
#pragma unroll
            for (int u = 0; u < 10; ++u) {
                const int e = (eb + u) * 512 + tid, tok = e / 160, i = e - tok * 160, t = t0 + tok;
                curv[u] = 0.f; prvv[u] = 0.f;
                if (i < nact) {
                    curv[u] = (float)proj[(size_t)t * NP + C_FW + i];
                    if (t & (SEQ_ - 1)) prvv[u] = (float)proj[(size_t)(t - 1) * NP + C_FW + i];
                }
            }
#pragma unroll
            for (int u = 0; u < 10; ++u) {
                const int e = (eb + u) * 512 + tid, tok = e / 160, i = e - tok * 160;
                if (i < nact) {
                    const float mu = (i < 128) ? p.in[I_MU][l * 896 + 768 + i] : p.in[I_MUV][(l - 1) * 32 + (i - 128)];
                    const float f = curv[u] + (prvv[u] - curv[u]) * mu;
                    float a = f;
                    if (i < 32) { const float e2 = __expf(-2.0f * fabsf(f)); const float th = (1.0f - e2) * __builtin_amdgcn_rcpf(1.0f + e2); a = f < 0.f ? -th : th; } else if (i >= 64 && i < 128) a = sigmoidf_(f);
                    A16[tok * RS + i] = (h16)a;
                }
            }
        }
        __syncthreads();
#pragma unroll 1
        for (int mt = 0; mt < 2; ++mt) {
            const int tokb = mh * 32 + mt * 16;
            f32x4 aw[4], aa[4], ag[4], av[4];
            {
                const LAS h16* ar = A16 + (tokb + c16) * RS + 8 * g;
                const h16x8 A0 = *(const LAS h16x8*)(ar), A1 = *(const LAS h16x8*)(ar + 32), A2 = *(const LAS h16x8*)(ar + 64), A3 = *(const LAS h16x8*)(ar + 96);
                h16x8 A4 = A0; if (l > 0) A4 = *(const LAS h16x8*)(ar + 128);
#pragma unroll
                for (int nt = 0; nt < 4; ++nt) {
                    const LAS h16* br = W16 + (hh * 64 + nt * 16 + c16) * RS + 8 * g;
                    const f32x4 z = {0.f, 0.f, 0.f, 0.f};
                    aw[nt] = __builtin_amdgcn_mfma_f32_16x16x32_f16(A0, *(const LAS h16x8*)(br), z, 0, 0, 0);
                    aa[nt] = __builtin_amdgcn_mfma_f32_16x16x32_f16(A1, *(const LAS h16x8*)(br + 32), z, 0, 0, 0);
                    ag[nt] = __builtin_amdgcn_mfma_f32_16x16x32_f16(A2, *(const LAS h16x8*)(br + 64), z, 0, 0, 0);
                    ag[nt] = __builtin_amdgcn_mfma_f32_16x16x32_f16(A3, *(const LAS h16x8*)(br + 96), ag[nt], 0, 0, 0);
                    av[nt] = z;
                    if (l > 0) av[nt] = __builtin_amdgcn_mfma_f32_16x16x32_f16(A4, *(const LAS h16x8*)(br + 128), z, 0, 0, 0);
                }
            }
#pragma unroll
            for (int rp = 0; rp < 2; ++rp) {
            h16 lr[8], lk[8], lv[8], lpr[8], lpk[8], lpv[8], lvf[8];
#pragma unroll
            for (int r2 = 0; r2 < 2; ++r2) {
                const int t = t0 + tokb + 4 * g + rp * 2 + r2;
                const h16* row = proj + (size_t)t * NP + hh * 64 + c16;
#pragma unroll
                for (int nt = 0; nt < 4; ++nt) {
                    const int q = r2 * 4 + nt;
                    lr[q] = row[C_R + nt * 16]; lk[q] = row[C_K + nt * 16]; lv[q] = row[C_V + nt * 16];
                    lpr[q] = (h16)0.f; lpk[q] = (h16)0.f; lpv[q] = (h16)0.f; lvf[q] = (h16)0.f;
                    if (t & (SEQ_ - 1)) { lpr[q] = row[C_R + nt * 16 - NP]; lpk[q] = row[C_K + nt * 16 - NP]; lpv[q] = row[C_V + nt * 16 - NP]; }
                    if (l > 0) lvf[q] = vfirst[(size_t)t * 256 + hh * 64 + nt * 16 + c16];
                }
            }
#pragma unroll
            for (int r2 = 0; r2 < 2; ++r2) {
                const int rg = rp * 2 + r2;
                const int t = t0 + tokb + 4 * g + rg;
                float rr[4], kp[4], vv[4], kkr[4], aS[4], ee[4];
                float n2 = 0.f, bn = 0.f;
#pragma unroll
                for (int nt = 0; nt < 4; ++nt) {
                    const int q = r2 * 4 + nt;
                    float r = (float)lr[q], k = (float)lk[q], v = (float)lv[q];
                    r += ((float)lpr[q] - r) * mu_r[nt]; k += ((float)lpk[q] - k) * mu_k[nt]; v += ((float)lpv[q] - v) * mu_v[nt];
                    const float wl = w0[nt] + aw[nt][rg];
                    ee[nt] = __expf(-softplusf_(-wl) - 0.5f);
                    const float a = sigmoidf_(a0[nt] + aa[nt][rg]);
                    if (l == 0) vfirst[(size_t)t * 256 + hh * 64 + nt * 16 + c16] = (h16)v;
                    else v += ((float)lvf[q] - v) * sigmoidf_(v0[nt] + av[nt][rg]);
                    kkr[nt] = k * k_k[nt];
                    kp[nt] = k * (1.0f + (a - 1.0f) * k_a[nt]);
                    rr[nt] = r; vv[nt] = v; aS[nt] = a;
                    n2 += kkr[nt] * kkr[nt]; bn += r * kp[nt] * r_k[nt];
                }
                n2 = sum16(n2); bn = sum16(bn);
                const float rn = __builtin_amdgcn_rsqf(fmaxf(n2, 1e-24f));
#pragma unroll
                for (int nt = 0; nt < 4; ++nt) {
                    const float kk = kkr[nt] * rn, gg = ag[nt][rg];
                    h16* o = prep + (size_t)t * 2048 + hh * 64 + nt * 16 + c16;
                    o[0] = (h16)rr[nt]; o[256] = (h16)ee[nt]; o[512] = (h16)kp[nt]; o[768] = (h16)kk; o[1024] = (h16)(kk * aS[nt]); o[1280] = (h16)vv[nt];
                    o[1536] = (h16)(lnw[nt] * gg); o[1792] = (h16)((lnb[nt] + bn * vv[nt]) * gg);
                }
            }
            }
        }
    }
    __syncthreads();
}

constexpr int CH = 32;

__device__ __forceinline__ float dot4(f32x4 a, f32x4 b) { f32x2 p = (f32x2){a[0], a[1]} * (f32x2){b[0], b[1]}; p = __builtin_elementwise_fma((f32x2){a[2], a[3]}, (f32x2){b[2], b[3]}, p); return p[0] + p[1]; }
template <int R> __device__ __forceinline__ void plain_write_y(h16* mix, int t0, int col, LAS unsigned char* ybuf, int lt) {
    if (lt >= 128 * R) return;
    const int tok = lt / (4 * R), r8 = lt & (4 * R - 1);
    const f32x4 y = *(const LAS f32x4*)(ybuf + (tok * 32 + r8 * 4) * 4);
    *(h16x4*)(mix + (size_t)(t0 + tok) * DM + col + r8 * 4) = f4h(y);
}

constexpr int RW_SH = 0, RW_VB = CH * 16 * 20 * 4, RW_YB = RW_VB + CH * 32 * 4, RW_STRIDE = RW_YB + CH * 32 * 4;
template <int R> __device__ __forceinline__ void rwkv_load(const h16* prep, int t0, int h, int rowbase, LAS unsigned char* buf, int lt) {
    LAS float* sh = (LAS float*)(buf + RW_SH);
    h16x4 raw[10];
#pragma unroll
    for (int i = 0; i < 10; ++i) {
        const int e = i * 256 + lt, tok = e / 80, rem = e - tok * 80, vec = rem >> 4, sub = rem & 15;
        const int pv = (vec == 0) ? 3 : (vec == 1) ? 1 : (vec == 2) ? 4 : (vec == 3) ? 2 : 0;
        raw[i] = *(const h16x4*)(prep + (size_t)(t0 + tok) * 2048 + pv * 256 + h * 64 + sub * 4);
    }
    const int tokv = lt / (4 * R), r8 = lt & (4 * R - 1);
    h16x4 rv = {(h16)0.f, (h16)0.f, (h16)0.f, (h16)0.f};
    if (lt < 128 * R) rv = *(const h16x4*)(prep + (size_t)(t0 + tokv) * 2048 + 5 * 256 + rowbase + r8 * 4);
#pragma unroll
    for (int i = 0; i < 10; ++i) {
        const int e = i * 256 + lt, tok = e / 80, rem = e - tok * 80, vec = rem >> 4, sub = rem & 15;
        f32x4 f = h4f(raw[i]);
        if (vec == 1) { f[0] = __expf(-f[0]); f[1] = __expf(-f[1]); f[2] = __expf(-f[2]); f[3] = __expf(-f[3]); }
        *(LAS f32x4*)(sh + ((tok * 16 + sub) * 5 + vec) * 4) = f;
    }
    if (lt < 128 * R) *(LAS f32x4*)(buf + RW_VB + (tokv * 32 + r8 * 4) * 4) = h4f(rv);
}
template <int R> __device__ __forceinline__ void rwkv_scan(const Params& p, int item, LAS unsigned char* lds, const int tidx) {
    constexpr int NQ = 4 / R;
    const int b = item / (4 * NQ), h = (item / NQ) & 3, q2 = item % NQ;
    const int tid = tidx, wid = tid >> 6, lane = tid & 63, lt = tid - 256;
    const h16* prep = (const h16*)p.out;
    h16* mix = (h16*)(p.ws + OFF_MIX);
    const int rowbase = h * 64 + q2 * 16 * R, tb = b * SEQ_;
    const bool loader = wid >= 4;
    const int rowl = (wid & 3) * 4 + (lane >> 4), sub = lane & 15;
    LAS float* dump = (LAS float*)(lds + LDS_BYTES - 8192) + tid;
    f32x4 Sa = {0.f, 0.f, 0.f, 0.f}, Sb = {0.f, 0.f, 0.f, 0.f};
    __syncthreads();
    if (loader) rwkv_load<R>(prep, tb, h, rowbase, lds, lt);
    __syncthreads();
#pragma unroll 1
    for (int c = 0; c < SEQ_ / CH; ++c) {
        LAS unsigned char* buf = lds + (c & 1) * RW_STRIDE;
        if (loader) {
            if (c + 1 < SEQ_ / CH) rwkv_load<R>(prep, tb + (c + 1) * CH, h, rowbase, lds + ((c + 1) & 1) * RW_STRIDE, lt);
            if (c > 0) plain_write_y<R>(mix, tb + (c - 1) * CH, rowbase, lds + ((c - 1) & 1) * RW_STRIDE + RW_YB, lt);
        } else {
            const LAS float* sh = (const LAS float*)(buf + RW_SH);
            const LAS float* vb = (const LAS float*)(buf + RW_VB);
            LAS float* yb = (LAS float*)(buf + RW_YB);
            const LAS f32x4* q0 = (const LAS f32x4*)(sh + sub * 20);
            f32x4 nkk = q0[0], nw = q0[1], nbb = q0[2], nk = q0[3], nr = q0[4];
            float nva = vb[rowl], nvb = vb[rowl + 16];
#pragma unroll 4
            for (int s = 0; s < CH; ++s) {
                const f32x4 kk = nkk, w = nw, bb = nbb, k = nk, r = nr;
                const float va = nva, vbb = nvb;
                const LAS f32x4* q = (const LAS f32x4*)(sh + ((s + 1) * 16 + sub) * 20);
                nkk = q[0]; nw = q[1]; nbb = q[2]; nk = q[3]; nr = q[4];
                nva = vb[(s + 1) * 32 + rowl]; if (R == 2) nvb = vb[(s + 1) * 32 + rowl + 16];
                const float da = sum16(dot4(Sa, kk));
                Sa = Sa * w + (k * va - bb * da);
                const float ya = sum16(dot4(Sa, r));
                LAS float* wp = (sub == 0) ? (yb + s * 32 + rowl) : dump;
                wp[0] = ya;
                if (R == 2) {
                    const float db = sum16(dot4(Sb, kk));
                    Sb = Sb * w + (k * vbb - bb * db);
                    wp[16] = sum16(dot4(Sb, r));
                }
            }
        }
        __syncthreads();
    }
    if (loader) plain_write_y<R>(mix, tb + (SEQ_ / CH - 1) * CH, rowbase, lds + ((SEQ_ / CH - 1) & 1) * RW_STRIDE + RW_YB, lt);
}

constexpr int HG_SH = 0, HG_VB = CH * 16 * 12 * 4, HG_YB = HG_VB + CH * 32 * 4, HG_STRIDE = HG_YB + CH * 32 * 4;
template <int R> __device__ __forceinline__ void hgrn_load(const h16* proj, int t0, int h, int rowbase, f32x4 lb, LAS unsigned char* buf, int lt) {
    LAS float* sh = (LAS float*)(buf + HG_SH);
    h16x4 rq[2], rf[2];
#pragma unroll
    for (int i = 0; i < 2; ++i) {
        const int e = i * 256 + lt, tok = e >> 4, sub = e & 15;
        const h16* row = proj + (size_t)(t0 + tok) * NP + h * 64 + sub * 4;
        rq[i] = *(const h16x4*)(row + C_HQ); rf[i] = *(const h16x4*)(row + C_HF);
    }
    const int tokv = lt / (4 * R), r8 = lt & (4 * R - 1);
    h16x4 rv = {(h16)0.f, (h16)0.f, (h16)0.f, (h16)0.f};
    if (lt < 128 * R) rv = *(const h16x4*)(proj + (size_t)(t0 + tokv) * NP + C_HI + rowbase + r8 * 4);
#pragma unroll
    for (int i = 0; i < 2; ++i) {
        const int e = i * 256 + lt, tok = e >> 4, sub = e & 15;
        const f32x4 qv = h4f(rq[i]), fv = h4f(rf[i]);
        f32x4 fo, ko, qo;
#pragma unroll
        for (int j = 0; j < 4; ++j) { const float fg = lb[j] + (1.0f - lb[j]) * sigmoidf_(fv[j]); fo[j] = fg; ko[j] = 1.0f - fg; qo[j] = siluf_(qv[j]); }
        LAS f32x4* d = (LAS f32x4*)(sh + (tok * 16 + sub) * 12);
        d[0] = fo; d[1] = ko; d[2] = qo;
    }
    if (lt < 128 * R) *(LAS f32x4*)(buf + HG_VB + (tokv * 32 + r8 * 4) * 4) = h4f(rv);
}
template <int R> __device__ __forceinline__ void hgrn_scan(const Params& p, int l, int item, LAS unsigned char* lds, const int tidx) {
    constexpr int NQ = 4 / R;
    const int b = item / (4 * NQ), h = (item / NQ) & 3, q2 = item % NQ;
    const int tid = tidx, wid = tid >> 6, lane = tid & 63, lt = tid - 256;
    const h16* proj = (const h16*)(p.ws + OFF_BIG);
    h16* mix = (h16*)(p.ws + OFF_MIX);
    const int rowbase = h * 64 + q2 * 32, tb = b * SEQ_;
    const bool loader = wid >= 4;
    const int rowl = (wid & 3) * 4 + (lane >> 4), sub = lane & 15;
    LAS float* dump = (LAS float*)(lds + LDS_BYTES - 8192) + tid;
    f32x4 lb = {0.f, 0.f, 0.f, 0.f};
    if (l > 0) {
#pragma unroll
        for (int j = 0; j < 4; ++j) { const int ch = h * 64 + (lt & 15) * 4 + j; lb[j] = sigmoidf_(p.in[I_LB][256 + ch] - p.in[I_LB][ch]); }
    }
    f32x4 Sa = {0.f, 0.f, 0.f, 0.f}, Sb = {0.f, 0.f, 0.f, 0.f};
    __syncthreads();
    if (loader) hgrn_load<R>(proj, tb, h, rowbase, lb, lds, lt);
    __syncthreads();
#pragma unroll 1
    for (int c = 0; c < SEQ_ / CH; ++c) {
        LAS unsigned char* buf = lds + (c & 1) * HG_STRIDE;
        if (loader) {
            if (c + 1 < SEQ_ / CH) hgrn_load<R>(proj, tb + (c + 1) * CH, h, rowbase, lb, lds + ((c + 1) & 1) * HG_STRIDE, lt);
            if (c > 0) plain_write_y<R>(mix, tb + (c - 1) * CH, 768 + rowbase, lds + ((c - 1) & 1) * HG_STRIDE + HG_YB, lt);
        } else {
            const LAS float* sh = (const LAS float*)(buf + HG_SH);
            const LAS float* vb = (const LAS float*)(buf + HG_VB);
            LAS float* yb = (LAS float*)(buf + HG_YB);
            const LAS f32x4* q0 = (const LAS f32x4*)(sh + sub * 12);
            f32x4 nf = q0[0], nk = q0[1], nq = q0[2];
            float nva = vb[rowl], nvb = vb[rowl + 16];
#pragma unroll 4
            for (int s = 0; s < CH; ++s) {
                const f32x4 f = nf, k = nk, qq = nq;
                const float va = nva, vbb = nvb;
                const LAS f32x4* q = (const LAS f32x4*)(sh + ((s + 1) * 16 + sub) * 12);
                nf = q[0]; nk = q[1]; nq = q[2];
                nva = vb[(s + 1) * 32 + rowl]; if (R == 2) nvb = vb[(s + 1) * 32 + rowl + 16];
                Sa = Sa * f + k * va;
                const float ya = sum16(dot4(Sa, qq));
                LAS float* wp = (sub == 0) ? (yb + s * 32 + rowl) : dump;
                wp[0] = ya;
                if (R == 2) { Sb = Sb * f + k * vbb; wp[16] = sum16(dot4(Sb, qq)); }
            }
        }
        __syncthreads();
    }
    if (loader) plain_write_y<R>(mix, tb + (SEQ_ / CH - 1) * CH, 768 + rowbase, lds + ((SEQ_ / CH - 1) & 1) * HG_STRIDE + HG_YB, lt);
}

constexpr int SD_SH = 0, SD_XDT = CH * 16 * 20 * 4, SD_XS = SD_XDT + CH * 32 * 4, SD_AB = SD_XS + CH * 32 * 4, SD_YB = SD_AB + CH * 4, SD_STRIDE = SD_YB + CH * 32 * 4;
struct SsdW { f32x4 w[4], b; };
__device__ __forceinline__ SsdW ssd_wload(const Params& p, int l, int ch) {
    SsdW r; const float* cw = p.in[I_CW] + (size_t)l * 4 * 768 + ch;
#pragma unroll
    for (int j = 0; j < 4; ++j) r.w[j] = *(const f32x4*)(cw + j * 768);
    r.b = *(const f32x4*)(p.in[I_CB] + l * 768 + ch);
    return r;
}
__device__ __forceinline__ f32x4 silu4(f32x4 a) { f32x4 o; o[0] = siluf_(a[0]); o[1] = siluf_(a[1]); o[2] = siluf_(a[2]); o[3] = siluf_(a[3]); return o; }
struct SsdRaw { h16x4 rows[11]; h16x4 rx[4]; float dtraw; };
template <int R> __device__ __forceinline__ void ssd_issue(SsdRaw& rw, const h16* proj, int t0, int h, int chbc, int chxs, int lt) {
    const int tq = lt >> 6;
    const int tA = t0 + tq * 8, posA = tA & (SEQ_ - 1);
    const h16x4 hz = {(h16)0.f, (h16)0.f, (h16)0.f, (h16)0.f};
#pragma unroll
    for (int j = 0; j < 11; ++j) rw.rows[j] = (posA - 3 + j >= 0) ? *(const h16x4*)(proj + (size_t)(tA - 3 + j) * NP + C_SX + chbc) : hz;
    const int tokx = (lt / (4 * R)) & 31, tX = t0 + tokx, posX = tX & (SEQ_ - 1);
#pragma unroll
    for (int j = 0; j < 4; ++j) rw.rx[j] = (posX - 3 + j >= 0) ? *(const h16x4*)(proj + (size_t)(tX - 3 + j) * NP + C_SX + chxs) : hz;
    rw.dtraw = (float)proj[(size_t)tX * NP + C_SDT + h];
}
template <int R> __device__ __forceinline__ void ssd_commit(const SsdRaw& rw, const SsdW& wbc, const SsdW& wxs, float dtb, float Ah, LAS unsigned char* buf, int lt) {
    LAS float* sh = (LAS float*)(buf + SD_SH);
    const int gi = lt & 63, tq = lt >> 6, vec = gi >> 5, gj = gi & 31;
    const int tokx = (lt / (4 * R)) & 31, r8 = lt & (4 * R - 1);
#pragma unroll
    for (int j = 0; j < 8; ++j) {
        f32x4 acc = wbc.b;
#pragma unroll
        for (int k = 0; k < 4; ++k) acc += h4f(rw.rows[j + k]) * wbc.w[k];
        *(LAS f32x4*)(sh + ((tq * 8 + j) * 16 + (gj >> 1)) * 20 + vec * 8 + (gj & 1) * 4) = silu4(acc);
    }
    {
        f32x4 acc = wxs.b;
#pragma unroll
        for (int k = 0; k < 4; ++k) acc += h4f(rw.rx[k]) * wxs.w[k];
        const f32x4 xs = silu4(acc);
        const float dt = softplusf_(rw.dtraw + dtb);
        if (lt < 128 * R) {
            *(LAS f32x4*)(buf + SD_XS + (tokx * 32 + r8 * 4) * 4) = xs;
            *(LAS f32x4*)(buf + SD_XDT + (tokx * 32 + r8 * 4) * 4) = xs * dt;
            if (r8 == 0) *(LAS float*)(buf + SD_AB + tokx * 4) = __expf(dt * Ah);
        }
    }
}
template <int R> __device__ __forceinline__ void ssd_write_y(const h16* proj, h16* mix, int t0, int cc0, LAS unsigned char* ybuf, int lt) {
    if (lt >= 128 * R) return;
    const int tok = lt / (4 * R), r8 = lt & (4 * R - 1), cc = cc0 + r8 * 4;
    const f32x4 y = *(const LAS f32x4*)(ybuf + (tok * 32 + r8 * 4) * 4);
    const f32x4 z = h4f(*(const h16x4*)(proj + (size_t)(t0 + tok) * NP + C_SZ + cc));
    *(h16x4*)(mix + (size_t)(t0 + tok) * DM + 512 + cc) = f4h(y * silu4(z));
}
template <int R> __device__ __forceinline__ void ssd_scan(const Params& p, int l, int item, LAS unsigned char* lds, const int tidx) {
    constexpr int NQ = 4 / R;
    const int b = item / (4 * NQ), h = (item / NQ) & 3, q2 = item % NQ;
    const int tid = tidx, wid = tid >> 6, lane = tid & 63, lt = tid - 256;
    const h16* proj = (const h16*)(p.ws + OFF_BIG);
    h16* mix = (h16*)(p.ws + OFF_MIX);
    const int tb = b * SEQ_, cc0 = h * 64 + q2 * 16 * R;
    const bool loader = wid >= 4;
    const int rowl = (wid & 3) * 4 + (lane >> 4), sub = lane & 15;
    LAS float* dump = (LAS float*)(lds + LDS_BYTES - 8192) + tid;
    const float dtb = p.in[I_DTB][l * 4 + h], Ah = -__expf(p.in[I_ALOG][l * 4 + h]), Dh = p.in[I_SD][l * 4 + h];
    const int chbc = 256 + ((lt & 63) >> 5) * 256 + (h >> 1) * 128 + (lt & 31) * 4, chxs = cc0 + (lt & (4 * R - 1)) * 4;
    SsdW wbc, wxs;
    if (loader) { wbc = ssd_wload(p, l, chbc); wxs = ssd_wload(p, l, chxs); }
    f32x4 Sa0 = {0.f, 0.f, 0.f, 0.f}, Sa1 = Sa0, Sb0 = Sa0, Sb1 = Sa0;
    __syncthreads();
    SsdRaw rw;
    if (loader) { ssd_issue<R>(rw, proj, tb, h, chbc, chxs, lt); ssd_commit<R>(rw, wbc, wxs, dtb, Ah, lds, lt); ssd_issue<R>(rw, proj, tb + CH, h, chbc, chxs, lt); }
    __syncthreads();
#pragma unroll 1
    for (int c = 0; c < SEQ_ / CH; ++c) {
        LAS unsigned char* buf = lds + (c & 1) * SD_STRIDE;
        if (loader) {
            if (c + 1 < SEQ_ / CH) ssd_commit<R>(rw, wbc, wxs, dtb, Ah, lds + ((c + 1) & 1) * SD_STRIDE, lt);
            if (c + 2 < SEQ_ / CH) ssd_issue<R>(rw, proj, tb + (c + 2) * CH, h, chbc, chxs, lt);
            if (c > 0) ssd_write_y<R>(proj, mix, tb + (c - 1) * CH, cc0, lds + ((c - 1) & 1) * SD_STRIDE + SD_YB, lt);
        } else {
            const LAS float* sh = (const LAS float*)(buf + SD_SH);
            const LAS float* xdt = (const LAS float*)(buf + SD_XDT);
            const LAS float* xsb = (const LAS float*)(buf + SD_XS);
            const LAS float* ab = (const LAS float*)(buf + SD_AB);
            LAS float* yb = (LAS float*)(buf + SD_YB);
            const LAS f32x4* q0 = (const LAS f32x4*)(sh + sub * 20);
            f32x4 nB0 = q0[0], nB1 = q0[1], nC0 = q0[2], nC1 = q0[3];
            float na = ab[0], nxda = xdt[rowl], nxdb = xdt[rowl + 16], nxsa = xsb[rowl], nxsb = xsb[rowl + 16];
#pragma unroll 4
            for (int s = 0; s < CH; ++s) {
                const f32x4 B0 = nB0, B1 = nB1, C0 = nC0, C1 = nC1;
                const float a = na, xda = nxda, xdb = nxdb, xsa = nxsa, xsb2 = nxsb;
                const LAS f32x4* q = (const LAS f32x4*)(sh + ((s + 1) * 16 + sub) * 20);
                nB0 = q[0]; nB1 = q[1]; nC0 = q[2]; nC1 = q[3];
                na = ab[s + 1]; nxda = xdt[(s + 1) * 32 + rowl]; nxsa = xsb[(s + 1) * 32 + rowl];
                if (R == 2) { nxdb = xdt[(s + 1) * 32 + rowl + 16]; nxsb = xsb[(s + 1) * 32 + rowl + 16]; }
                Sa0 = Sa0 * a + B0 * xda; Sa1 = Sa1 * a + B1 * xda;
                const float ya = sum16(dot4(Sa0, C0) + dot4(Sa1, C1)) + Dh * xsa;
                LAS float* wp = (sub == 0) ? (yb + s * 32 + rowl) : dump;
                wp[0] = ya;
                if (R == 2) {
                    Sb0 = Sb0 * a + B0 * xdb; Sb1 = Sb1 * a + B1 * xdb;
                    wp[16] = sum16(dot4(Sb0, C0) + dot4(Sb1, C1)) + Dh * xsb2;
                }
            }
        }
        __syncthreads();
    }
    if (loader) ssd_write_y<R>(proj, mix, tb + (SEQ_ / CH - 1) * CH, cc0, lds + ((SEQ_ / CH - 1) & 1) * SD_STRIDE + SD_YB, lt);
}

__device__ __forceinline__ void attn_item(const Params& p, int item, int wid, const int tidx) {
    const int b = item / 192, rem = item - b * 192, h = rem / 48, s = rem - h * 48;
    int br, dil, r, n;
    if (s < 16) { br = 0; dil = 1; r = 0; n = s; } else if (s < 32) { br = 1; dil = 4; r = (s - 16) >> 2; n = (s - 16) & 3; } else { br = 2; dil = 16; r = s - 32; n = 0; }
    const int lane = tidx & 63, c16 = lane & 15, g = lane >> 4;
    const h16* base = (const h16*)(p.ws + OFF_BIG) + (size_t)b * SEQ_ * NP;
    const int tq = (n * 128 + 16 * wid + c16) * dil + r;
    h16x8 qf0 = *(const h16x8*)(base + (size_t)tq * NP + C_AQ + h * 64 + g * 8);
    h16x8 qf1 = *(const h16x8*)(base + (size_t)tq * NP + C_AQ + h * 64 + 32 + g * 8);
    f32x4 sc[9];
    h16x8 kf0[9], kf1[9];
    h16x4 vreg[36];
#pragma unroll
    for (int kt = 0; kt < 9; ++kt) {
        int kp = (n - 1) * 128 + 16 * wid + 16 * kt + c16; kp = kp < 0 ? 0 : kp;
        const h16* kr = base + (size_t)(kp * dil + r) * NP + C_AK + h * 64 + g * 8;
        kf0[kt] = *(const h16x8*)kr; kf1[kt] = *(const h16x8*)(kr + 32);
    }
#pragma unroll
    for (int kt = 0; kt < 9; ++kt)
#pragma unroll
        for (int rg = 0; rg < 4; ++rg) {
            int kp = (n - 1) * 128 + 16 * wid + 16 * kt + 4 * g + rg; kp = kp < 0 ? 0 : kp;
            vreg[kt * 4 + rg] = *(const h16x4*)(base + (size_t)(kp * dil + r) * NP + C_AV + h * 64 + 4 * c16);
        }
    __builtin_amdgcn_sched_barrier(0);
#pragma unroll
    for (int kt = 0; kt < 9; ++kt) {
        f32x4 a = {0.f, 0.f, 0.f, 0.f};
        a = __builtin_amdgcn_mfma_f32_16x16x32_f16(kf0[kt], qf0, a, 0, 0, 0);
        a = __builtin_amdgcn_mfma_f32_16x16x32_f16(kf1[kt], qf1, a, 0, 0, 0);
        sc[kt] = a;
    }
    const float slope = exp2f(-2.0f * (float)(h + 1)) * (float)dil;
    float m = -INFINITY;
#pragma unroll
    for (int kt = 0; kt < 9; ++kt)
#pragma unroll
        for (int rg = 0; rg < 4; ++rg) {
            const int jj = 16 * kt + 4 * g + rg, dist = 128 + c16 - jj;
            const bool valid = (dist >= 0) && (dist <= 128) && (n > 0 || (16 * wid + jj) >= 128);
            const float v = valid ? (sc[kt][rg] * 0.125f - slope * (float)dist) : -INFINITY;
            sc[kt][rg] = v; m = fmaxf(m, v);
        }
    m = fmaxf(m, __shfl_xor(m, 16)); m = fmaxf(m, __shfl_xor(m, 32));
    float lsum = 0.f;
#pragma unroll
    for (int kt = 0; kt < 9; ++kt)
#pragma unroll
        for (int rg = 0; rg < 4; ++rg) { const float e = __expf(sc[kt][rg] - m); sc[kt][rg] = e; lsum += e; }
    lsum += __shfl_xor(lsum, 16); lsum += __shfl_xor(lsum, 32);
    f32x4 o[4];
#pragma unroll
    for (int d = 0; d < 4; ++d) o[d] = (f32x4){0.f, 0.f, 0.f, 0.f};
#pragma unroll
    for (int kt = 0; kt < 9; ++kt)
#pragma unroll
        for (int rg = 0; rg < 4; ++rg) {
            const f32x4 v = h4f(vreg[kt * 4 + rg]);
#pragma unroll
            for (int d = 0; d < 4; ++d) o[d] = __builtin_amdgcn_mfma_f32_16x16x4f32(sc[kt][rg], v[d], o[d], 0, 0, 0);
        }
    h16* dst; int ld, co;
    if (br == 0) { dst = (h16*)(p.ws + OFF_MIX); ld = DM; co = 256; } else { dst = (h16*)(p.ws + (br == 1 ? OFF_O2 : OFF_O3)); ld = 256; co = 0; }
    float* lse = (float*)(p.ws + OFF_LSE) + (size_t)br * T_ * 4;
#pragma unroll
    for (int rg = 0; rg < 4; ++rg) {
        const int q = 4 * g + rg;
        const float inv = __builtin_amdgcn_rcpf(__shfl(lsum, q));
        const int t = b * SEQ_ + (n * 128 + 16 * wid + q) * dil + r;
        h16x4 ov; ov[0] = (h16)(o[0][rg] * inv); ov[1] = (h16)(o[1][rg] * inv); ov[2] = (h16)(o[2][rg] * inv); ov[3] = (h16)(o[3][rg] * inv);
        *(h16x4*)(dst + (size_t)t * ld + co + h * 64 + 4 * c16) = ov;
    }
    if (g == 0) lse[(size_t)(b * SEQ_ + tq) * 4 + h] = m + __logf(lsum);
}

__device__ __forceinline__ void mix_phase(const Params& p, int l, int cidx, int imask, LAS unsigned char* lds, const int tidx) {
    unsigned* ctr = (unsigned*)(p.ws + OFF_MISC) + cidx;
    unsigned* actr = (unsigned*)(p.ws + OFF_MISC) + 8 + cidx;
    LAS unsigned* slot = (LAS unsigned*)(lds + LDS_BYTES - 16);
    constexpr int NA = 128 / R_RWKV, NB = 128 / R_SSD, NC = 128 / R_HGRN;
    for (;;) {
        __syncthreads();
        if (tidx == 0) *slot = atomicAdd(ctr, 1u);
        __syncthreads();
        const int it = (int)*slot;
        if (it >= NA + NB + NC) break;
        int t2 = tidx; asm volatile("" : "+v"(t2));
        if (it < NA) { if (imask & 1) rwkv_scan<R_RWKV>(p, it, lds, t2); }
        else if (it < NA + NB) { if (imask & 2) ssd_scan<R_SSD>(p, l, it - NA, lds, t2); }
        else { if (imask & 4) hgrn_scan<R_HGRN>(p, l, it - NA - NB, lds, t2); }
    }
    if (imask & 8) {
        for (;;) {
            unsigned w0 = 0;
            if ((tidx & 63) == 0) w0 = atomicAdd(actr, 4u);
            w0 = (unsigned)__builtin_amdgcn_readfirstlane((int)w0);
            if (w0 >= 1536u * 8u) break;
#pragma unroll 1
            for (unsigned w = w0; w < w0 + 4u; ++w) {
                int t2 = tidx; asm volatile("" : "+v"(t2));
                attn_item(p, (int)(w >> 3), (int)(w & 7u), t2);
            }
        }
    }
}

__device__ __forceinline__ void post_phase(const Params& p, int l, const int tidx) {
    const int wid = tidx >> 6, lane = tidx & 63;
    h16* mix = (h16*)(p.ws + OFF_MIX);
    const h16* prep = (const h16*)p.out;
    const h16* proj = (const h16*)(p.ws + OFF_BIG);
    const h16* o2 = (const h16*)(p.ws + OFF_O2);
    const h16* o3 = (const h16*)(p.ws + OFF_O3);
    const float* lse = (const float*)(p.ws + OFF_LSE);
    const f32x4 snw = *(const f32x4*)(p.in[I_SNW] + l * 256 + 4 * lane);
    const f32x4 hnw = *(const f32x4*)(p.in[I_HNW] + l * 256 + 4 * lane);
    const int hd = lane >> 4;
#pragma unroll 2
    for (int t = blockIdx.x * 8 + wid; t < T_; t += gridDim.x * 8) {
        h16* mr = mix + (size_t)t * DM + 4 * lane;
        {
            const f32x4 y = h4f(*(const h16x4*)mr);
            const float mu = sum16(y[0] + y[1] + y[2] + y[3]) * (1.0f / 64.0f);
            const f32x4 d = y - mu;
            const float var = sum16(d[0] * d[0] + d[1] * d[1] + d[2] * d[2] + d[3] * d[3]) * (1.0f / 64.0f);
            const float rstd = rsqrtf(var + 64e-5f);
            const f32x4 A = h4f(*(const h16x4*)(prep + (size_t)t * 2048 + 1536 + 4 * lane));
            const f32x4 Bc = h4f(*(const h16x4*)(prep + (size_t)t * 2048 + 1792 + 4 * lane));
            *(h16x4*)mr = f4h(d * rstd * A + Bc);
        }
        {
            const f32x4 a1 = h4f(*(const h16x4*)(mr + 256));
            const f32x4 a2 = h4f(*(const h16x4*)(o2 + (size_t)t * 256 + 4 * lane));
            const f32x4 a3 = h4f(*(const h16x4*)(o3 + (size_t)t * 256 + 4 * lane));
            const float l1 = lse[(size_t)t * 4 + hd], l2 = lse[(size_t)(T_ + t) * 4 + hd], l3 = lse[(size_t)(2 * T_ + t) * 4 + hd];
            const float mx = fmaxf(l1, fmaxf(l2, l3));
            const float w1 = __expf(l1 - mx), w2 = __expf(l2 - mx), w3 = __expf(l3 - mx);
            const float inv = __builtin_amdgcn_rcpf(w1 + w2 + w3);
            *(h16x4*)(mr + 256) = f4h((a1 * w1 + a2 * w2 + a3 * w3) * inv);
        }
        {
            const f32x4 u = h4f(*(const h16x4*)(mr + 512));
            float ss = sum16(u[0] * u[0] + u[1] * u[1] + u[2] * u[2] + u[3] * u[3]);
            ss += __shfl_xor(ss, 16);
            const float rstd = rsqrtf(ss * (1.0f / 128.0f) + 1e-5f);
            *(h16x4*)(mr + 512) = f4h(u * rstd * snw);
        }
        {
            const f32x4 u = h4f(*(const h16x4*)(mr + 768));
            const float ss = sum16(u[0] * u[0] + u[1] * u[1] + u[2] * u[2] + u[3] * u[3]);
            const float rstd = rsqrtf(ss * (1.0f / 64.0f) + 1e-5f);
            const f32x4 gz = h4f(*(const h16x4*)(proj + (size_t)t * NP + C_HG + 4 * lane));
            f32x4 gt; gt[0] = siluf_(gz[0]); gt[1] = siluf_(gz[1]); gt[2] = siluf_(gz[2]); gt[3] = siluf_(gz[3]);
            *(h16x4*)(mr + 768) = f4h(u * rstd * hnw * gt);
        }
    }
}

__device__ __forceinline__ void ln_phase(const Params& p, const float* w, const float* bvec, bool final_out, const int tidx) {
    const int wid = tidx >> 6, lane = tidx & 63;
    h16* x16 = (h16*)(p.ws + OFF_X16);
    f32x4 wv[4], bv[4];
#pragma unroll
    for (int q = 0; q < 4; ++q) { wv[q] = *(const f32x4*)(w + lane * 16 + 4 * q); bv[q] = *(const f32x4*)(bvec + lane * 16 + 4 * q); }
#pragma unroll 2
    for (int t = blockIdx.x * 8 + wid; t < T_; t += gridDim.x * 8) {
        h16* row = x16 + (size_t)t * DM + lane * 16;
        const h16x8 v0 = *(const h16x8*)row, v1 = *(const h16x8*)(row + 8);
        float x[16];
#pragma unroll
        for (int j = 0; j < 8; ++j) { x[j] = (float)v0[j]; x[8 + j] = (float)v1[j]; }
        float s = 0.f;
#pragma unroll
        for (int j = 0; j < 16; ++j) s += x[j];
        const float mu = sum64(s) * (1.0f / 1024.0f);
        float q2 = 0.f;
#pragma unroll
        for (int j = 0; j < 16; ++j) { x[j] -= mu; q2 += x[j] * x[j]; }
        const float rstd = rsqrtf(sum64(q2) * (1.0f / 1024.0f) + 1e-5f);
#pragma unroll
        for (int j = 0; j < 16; ++j) x[j] = x[j] * rstd * wv[j >> 2][j & 3] + bv[j >> 2][j & 3];
        if (final_out) {
            float* orow = p.out + (size_t)t * DM + lane * 16;
#pragma unroll
            for (int q = 0; q < 4; ++q) *(f32x4*)(orow + 4 * q) = (f32x4){x[4 * q], x[4 * q + 1], x[4 * q + 2], x[4 * q + 3]};
        } else {
            h16x8 o0, o1;
#pragma unroll
            for (int j = 0; j < 8; ++j) { o0[j] = (h16)x[j]; o1[j] = (h16)x[8 + j]; }
            *(h16x8*)row = o0; *(h16x8*)(row + 8) = o1;
        }
    }
}

constexpr int NPHASE = 19;
__device__ __forceinline__ void run_phase(const Params& p, int ph, LAS unsigned char* lds, const int tidx, const int rep) {
    const int l = (ph == 0) ? 0 : (ph - 1) / 9, s = (ph == 0) ? -1 : (ph - 1) % 9;
    h16* x16 = (h16*)(p.ws + OFF_X16);
    h16* mix = (h16*)(p.ws + OFF_MIX);
    h16* big = (h16*)(p.ws + OFF_BIG);
    if (ph == 0) {
#if !COOP
        if (blockIdx.x == 0) for (int i = tidx; i < 256 + 3456; i += 512) ((unsigned*)(p.ws + OFF_MISC))[i] = 0u;
#endif
        conv_x(p, tidx);
    }
    if (s == 0 || s == 4 || s == 6 || s == 7) {
        const h16* A = (s == 0 || s == 6) ? x16 : (s == 4 ? mix : big);
        const h16* Bt = (const h16*)(p.ws + (s == 0 ? OFF_WIN : s == 4 ? OFF_WOUT : s == 6 ? OFF_WUP : OFF_WDN));
        const int N = (s == 0) ? NP : (s == 6 ? DFF : DM), K = (s == 7) ? DFF : DM;
        h16* O = (s == 0 || s == 6) ? big : x16;
        run_gemm(lds, A, Bt, N, K, O, N, (s == 0) ? 0 : (s == 6 ? 1 : 2), tidx);
    }
    if (s == 1) pre_phase(p, l, lds, tidx);
    if (s == 2) mix_phase(p, l, 2 * rep + l, rep ? DUPITEMS : 15, lds, tidx);
    if (s == 3) post_phase(p, l, tidx);
    if (s == 5 || s == 8) ln_phase(p, p.in[s == 5 ? I_LN1W : I_LN2W] + l * DM, p.in[s == 5 ? I_LN1B : I_LN2B] + l * DM, s == 8 && l == 1, tidx);
    if (ph == 0 || (s == 8 && l == 0)) conv_weights(p, ph == 0 ? 0 : 1, lds, tidx);
}

__global__ void __launch_bounds__(512, 2) k_phase(Params p, int ph) {
    extern __shared__ __attribute__((aligned(16))) unsigned char shm[];
    const int tidx = threadIdx.x;
    run_phase(p, ph, (LAS unsigned char*)shm, tidx, 0);
}

#define XB_TMO      128
#define XB_XCNT(j)  (256  + 64 * (j))
#define XB_XSUB(j)  (1280 + 64 * (j))
#define XB_XGEN(j)  (2304 + 64 * (j))
#define XB_TOP      3328
#define XB_TOPGEN   3392
#define XCD_BAR_WORDS 3456
#define XB_SPIN_CAP (1u << 18)

__device__ __forceinline__ unsigned xb_ld(unsigned* p)              { return __hip_atomic_load(p, __ATOMIC_RELAXED, __HIP_MEMORY_SCOPE_AGENT); }
__device__ __forceinline__ unsigned xb_add(unsigned* p, unsigned v) { return __hip_atomic_fetch_add(p, v, __ATOMIC_RELAXED, __HIP_MEMORY_SCOPE_AGENT); }
__device__ __forceinline__ unsigned xb_xcc_id() { return (unsigned)__builtin_amdgcn_s_getreg((3 << 11) | 20) & 0xFu; }
#define XB_SPIN(cond, bar) do { unsigned _sp = 0; while (cond) { __builtin_amdgcn_s_sleep(1); \
    if ((++_sp & 255u) == 0u) { if (xb_ld(&(bar)[XB_TMO])) break; if (_sp > XB_SPIN_CAP) { atomicAdd(&(bar)[XB_TMO], 1u); break; } } } } while (0)

struct XcdBarrier {
    unsigned* bar; unsigned x;
    volatile LAS unsigned* st;
};

__device__ __forceinline__ XcdBarrier xcd_barrier_post(unsigned* bar, volatile LAS unsigned* st) {
    XcdBarrier b; b.bar = bar; b.x = xb_xcc_id(); b.st = st;
    if (threadIdx.x == 0) (void)xb_add(&bar[XB_XCNT(b.x)], 1u);
    return b;
}
__device__ __forceinline__ void xcd_barrier_complete(unsigned* bar, unsigned x, unsigned& nloc, unsigned& nx) {
    const unsigned G = gridDim.x * gridDim.y * gridDim.z;
    unsigned sum, cnt, mine, sp = 0u;
    for (;;) {
        sum = 0u; cnt = 0u; mine = 0u;
#pragma unroll
        for (unsigned j = 0; j < 16; ++j) { const unsigned c = xb_ld(&bar[XB_XCNT(j)]); sum += c; cnt += (c > 0u) ? 1u : 0u; mine = (j == x) ? c : mine; }
        if (sum == G) break;
        __builtin_amdgcn_s_sleep(1);
        if ((++sp & 255u) == 0u) { if (xb_ld(&bar[XB_TMO])) break; if (sp > XB_SPIN_CAP) { atomicAdd(&bar[XB_TMO], 1u); break; } }
    }
    nloc = mine > 0u ? mine : 1u; nx = cnt > 0u ? cnt : 1u;
}

__device__ __forceinline__ void xcd_barrier(const XcdBarrier& b) {
    asm volatile("s_waitcnt vmcnt(0)" ::: "memory");
    __syncthreads();
    if (threadIdx.x == 0) {
        unsigned* bar = b.bar;
        __builtin_amdgcn_s_waitcnt(0);
        unsigned nloc = b.st[0], nx = b.st[1];
        if (nloc == 0u) { xcd_barrier_complete(bar, b.x, nloc, nx); b.st[0] = nloc; b.st[1] = nx; }
        const unsigned old = xb_add(&bar[XB_XSUB(b.x)], 1u);
        const unsigned gen = old / nloc;
        if (old + 1u == (gen + 1u) * nloc) {
            __builtin_amdgcn_fence(__ATOMIC_RELEASE, "agent");
            asm volatile("s_waitcnt vmcnt(0)" ::: "memory");
            const unsigned og = xb_add(&bar[XB_TOP], 1u);
            const unsigned tg = og / nx;
            if (og + 1u == (tg + 1u) * nx) xb_add(&bar[XB_TOPGEN], 1u);
            else XB_SPIN(xb_ld(&bar[XB_TOPGEN]) == tg, bar);
            __builtin_amdgcn_fence(__ATOMIC_ACQUIRE, "agent");
            xb_add(&bar[XB_XGEN(b.x)], 1u);
            asm volatile("s_waitcnt vmcnt(0)" ::: "memory");
        } else {
            XB_SPIN(xb_ld(&bar[XB_XGEN(b.x)]) == gen, bar);
            __builtin_amdgcn_fence(__ATOMIC_ACQUIRE, "agent");
            asm volatile("s_waitcnt vmcnt(0)" ::: "memory");
        }
    }
    __syncthreads();
}


#ifndef DUPITEMS
#define DUPITEMS 15
#endif
#ifndef DUPMASK
#define DUPMASK 0
#endif
#if COOP
__global__ void __launch_bounds__(512, 2) k_mega(Params p) {
    extern __shared__ __attribute__((aligned(16))) unsigned char shm[];
    cg::grid_group grid = cg::this_grid();
    unsigned* barw = (unsigned*)(p.ws + OFF_MISC + 1024);
    volatile LAS unsigned* xst = (volatile LAS unsigned*)((LAS unsigned char*)shm + LDS_BYTES);
    if (threadIdx.x < 4) xst[threadIdx.x] = 0u;
    __syncthreads();
    XcdBarrier xb = xcd_barrier_post(barw, xst);
    if (p.ws == nullptr) grid.sync();
#pragma unroll 1
    for (int ph = 0; ph < NPHASE; ++ph) {
        const int nrep = ((DUPMASK >> ph) & 1) ? 2 : 1;
#pragma unroll 1
        for (int rep = 0; rep < nrep; ++rep) {
            int tidx = threadIdx.x; asm volatile("" : "+v"(tidx));
            run_phase(p, ph, (LAS unsigned char*)shm, tidx, rep);
            if (ph + 1 < NPHASE) xcd_barrier(xb);
        }
#ifdef EXTRA_SYNCS
        if (ph == 1) for (int i = 0; i < EXTRA_SYNCS; ++i) xcd_barrier(xb);
#endif
    }
}
#endif

extern "C" void kernel_launch(void* const* d_in, const int* in_sizes, int n_in, void* d_out, int out_size, void* d_ws, size_t ws_size, hipStream_t stream) {
    static int grid_blocks = 0;
    if (!grid_blocks) {
        int dev = 0, cus = 0, per_cu = 0;
        hipGetDevice(&dev);
        hipDeviceGetAttribute(&cus, hipDeviceAttributeMultiprocessorCount, dev);
        hipFuncSetAttribute((const void*)k_phase, hipFuncAttributeMaxDynamicSharedMemorySize, LDS_TOTAL);
#if COOP
        hipFuncSetAttribute((const void*)k_mega, hipFuncAttributeMaxDynamicSharedMemorySize, LDS_TOTAL);
        hipOccupancyMaxActiveBlocksPerMultiprocessor(&per_cu, (const void*)k_mega, 512, LDS_TOTAL);
#endif
        if (per_cu < 1) per_cu = 1;
        grid_blocks = cus * 1;
        (void)hipGetLastError();
    }
    Params p{};
    for (int i = 0; i < 32; ++i) p.in[i] = (const float*)d_in[i];
    p.out = (float*)d_out; p.ws = (unsigned char*)d_ws;
#if COOP
    void* args[] = {&p};
    hipMemsetAsync((char*)d_ws + OFF_MISC, 0, 16384, stream);
    hipError_t e = hipLaunchCooperativeKernel((const void*)k_mega, dim3(grid_blocks), dim3(512), args, LDS_TOTAL, stream);
    if (e != hipSuccess) fprintf(stderr, "cooperative launch failed: %s (grid %d)\n", hipGetErrorString(e), grid_blocks);
#else
    for (int ph = 0; ph < NPHASE; ++ph) k_phase<<<dim3(grid_blocks), dim3(512), LDS_TOTAL, stream>>>(p, ph);
#endif
}
```

```cpp
#include <hip/hip_runtime.h>
#include <hip/hip_cooperative_groups.h>
#include <cstdio>
namespace cg = cooperative_groups;

#ifndef COOP
#define COOP 1
#endif
#ifndef DUPITEMS
#define DUPITEMS 15
#endif
#ifndef R_RWKV
#define R_RWKV 2
#endif
#ifndef R_SSD
#define R_SSD 2
#endif
#ifndef R_HGRN
#define R_HGRN 2
#endif

#define LAS __attribute__((address_space(3)))
typedef _Float16 h16;
typedef _Float16 h16x4 __attribute__((ext_vector_type(4)));
typedef _Float16 h16x8 __attribute__((ext_vector_type(8)));
typedef float f32x2 __attribute__((ext_vector_type(2)));
typedef float f32x4 __attribute__((ext_vector_type(4)));

constexpr int T_ = 16384, SEQ_ = 2048, DM = 1024, NP = 3840, DFF = 4096, INC = 3716;
constexpr int C_R = 0, C_K = 256, C_V = 512, C_FW = 768, C_VR = 896, C_AQ = 928, C_AK = 1184, C_AV = 1440;
constexpr int C_SZ = 1696, C_SX = 1952, C_SDT = 2720, C_HQ = 2728, C_HF = 2984, C_HI = 3240, C_HG = 3496;
constexpr float ALPHA_ = 1.41421356237f;
constexpr size_t OFF_WIN = 0, OFF_WOUT = 7864320, OFF_WUP = OFF_WOUT + 2097152, OFF_WDN = OFF_WUP + 8388608;
constexpr size_t OFF_X16 = 26738688, OFF_MIX = OFF_X16 + 33554432, OFF_BIG = OFF_MIX + 33554432;
constexpr size_t OFF_VF = OFF_BIG + 134217728, OFF_O2 = OFF_VF + 8388608, OFF_O3 = OFF_O2 + 8388608, OFF_LSE = OFF_O3 + 8388608;
constexpr size_t OFF_MISC = OFF_LSE + 786432;
constexpr int LDS_BYTES = 131072, LDS_TOTAL = 131072 + 64;

struct Params { const float* in[32]; float* out; unsigned char* ws; };

enum { I_X = 0, I_LB, I_WIN, I_WINV, I_MU, I_MUV, I_W0, I_W2, I_A0, I_A2, I_G2, I_KK, I_KA, I_RK, I_LNW, I_LNB, I_V0, I_V2,
       I_CW, I_CB, I_DTB, I_ALOG, I_SD, I_SNW, I_HNW, I_WOUT, I_LN1W, I_LN1B, I_WUP, I_WDN, I_LN2W, I_LN2B };

template <int CTRL> __device__ __forceinline__ float dpp_f(float x) {
    return __builtin_bit_cast(float, __builtin_amdgcn_update_dpp(0, __builtin_bit_cast(int, x), CTRL, 0xF, 0xF, true));
}
__device__ __forceinline__ float sum16(float x) {
    x += dpp_f<0xB1>(x);
    x += dpp_f<0x4E>(x);
    x += dpp_f<0x141>(x);
    x += dpp_f<0x140>(x);
    return x;
}
__device__ __forceinline__ float sum64(float x) { x = sum16(x); x += __shfl_xor(x, 16); x += __shfl_xor(x, 32); return x; }
__device__ __forceinline__ float sigmoidf_(float x) { return __builtin_amdgcn_rcpf(1.0f + __expf(-x)); }
__device__ __forceinline__ float siluf_(float x) { return x * __builtin_amdgcn_rcpf(1.0f + __expf(-x)); }
__device__ __forceinline__ float softplusf_(float x) { return fmaxf(x, 0.f) + __logf(1.0f + __expf(-fabsf(x))); }
__device__ __forceinline__ f32x4 h4f(h16x4 v) { return (f32x4){(float)v[0], (float)v[1], (float)v[2], (float)v[3]}; }
__device__ __forceinline__ h16x4 f4h(f32x4 v) { return (h16x4){(h16)v[0], (h16)v[1], (h16)v[2], (h16)v[3]}; }

namespace pg8 {
constexpr int BM = 256, BK = 64, HALF = 128, HTB = HALF * BK * 2, STAGE_BYTES = 8 * HTB, NXCD = 8, WGM = 8;
__host__ __device__ __forceinline__ int lds_byte(int r, int c) { const int st = (r >> 4) * 2 + (c >> 5), rr = r & 15, cc = c & 31, ob = rr * 64 + cc * 2; return st * 1024 + (ob ^ (((ob >> 9) & 1) << 5)); }
__host__ __device__ __forceinline__ void stage_rc(int b, int& R, int& C) { const int st = b / 1024, sb = b % 1024, swz = sb ^ (((sb >> 9) & 1) << 5); R = (st >> 1) * 16 + swz / 64; C = (st & 1) * 32 + (swz % 64) / 2; }
__host__ __device__ __forceinline__ int perm32(int rho) { const int n = rho >> 4, i = rho & 15; return 8 * (i >> 2) + 4 * n + (i & 3); }
struct Unit { int pm, pn; };
struct Gemm { const h16* A; const h16* Bt; int M, N, K; };
struct StaticOrder {
    int nM, nN, nwg, G, c;
    __device__ void init(int M, int N, int G_, int c_) { nM = M / BM; nN = N / BM; nwg = nM * nN; G = G_; c = c_; }
    __device__ bool next(int i, Unit& u) const {
        const long L = (long)i * G + c; if (L >= nwg) return false;
        int wgid = (int)L; { const int q = nwg / NXCD, r = nwg % NXCD, xcd = wgid % NXCD, off = wgid / NXCD; wgid = (xcd < r ? xcd * (q + 1) : r * (q + 1) + (xcd - r) * q) + off; }
        const int nig = WGM * nN, gid = wgid / nig, fm = gid * WGM, gsz = (nM - fm) < WGM ? (nM - fm) : WGM;
        u.pm = fm + ((wgid % nig) % gsz); u.pn = (wgid % nig) / gsz; return true;
    }
};
struct EpiH {
    h16* O; int ldc; int MODE;
    __device__ __forceinline__ void operator()(const f32x4 (&acc)[2][2][4][2], const Unit& u, int wr, int wc, int fr, int fq) const {
        const int row0 = u.pm * BM + wr * 64 + fr, col0 = u.pn * BM + wc * 32 + 8 * fq;
#pragma unroll
        for (int ai = 0; ai < 2; ++ai)
#pragma unroll
            for (int m = 0; m < 4; ++m) { h16* rowp = O + (size_t)(row0 + ai * HALF + m * 16) * ldc + col0;
#pragma unroll
                for (int bj = 0; bj < 2; ++bj) { f32x4 v0 = acc[ai][bj][m][0], v1 = acc[ai][bj][m][1];
                    if (MODE == 1) {
#pragma unroll
                        for (int j = 0; j < 4; ++j) { float a = fmaxf(v0[j], 0.f), b = fmaxf(v1[j], 0.f); v0[j] = a * a; v1[j] = b * b; } }
                    if (MODE == 2) { const h16x8 x = *(const h16x8*)(rowp + bj * HALF);
#pragma unroll
                        for (int j = 0; j < 4; ++j) { v0[j] += ALPHA_ * (float)x[j]; v1[j] += ALPHA_ * (float)x[4 + j]; } }
                    h16x8 w;
#pragma unroll
                    for (int j = 0; j < 4; ++j) { w[j] = (h16)v0[j]; w[4 + j] = (h16)v1[j]; }
                    *(h16x8*)(rowp + bj * HALF) = w; } }
    }
};

template <class Epi>
__device__ __forceinline__ void gemm_phase(LAS unsigned char* lds, const Gemm g, const StaticOrder& S, const Epi& E, const int tidx) {
    const int tid = tidx, wid = __builtin_amdgcn_readfirstlane(tid >> 6), lane = tid & 63, wr = wid >> 2, wc = wid & 3, fr = lane & 15, fq = lane >> 4;
    const int K = g.K, nt = K / BK;
    unsigned voffA[2], voffB[2];
#pragma unroll
    for (int i = 0; i < 2; ++i) { int R, C; stage_rc(tid * 16 + i * 8192, R, C); const int Rb = (R & ~31) + perm32(R & 31);
        voffA[i] = (unsigned)(R * K + C) * 2u; voffB[i] = (unsigned)(Rb * K + C) * 2u; }
    const size_t kstep = (size_t)(BK * 2);
    const size_t hstep = (size_t)HALF * K * 2;
    const size_t tstep = 2 * hstep;
    const unsigned ldsw = (unsigned)wid * 1024u;
    const int aoff = lds_byte(wr * 64 + fr, fq * 8), boff = lds_byte(wc * 32 + fr, fq * 8);
#define PG8_SA(b, h) (((b) * 2 + (h)) * HTB)
#define PG8_SB(b, h) ((4 + (b) * 2 + (h)) * HTB)
#define PG8_STAGE(bufoff, gbase, voff) do { _Pragma("unroll") for (int _i = 0; _i < 2; ++_i) \
        __builtin_amdgcn_global_load_lds((const unsigned*)((const char*)(gbase) + (voff)[_i]), (LAS unsigned*)(lds + (bufoff) + ldsw + _i * 8192), 16, 0, 0); } while (0)
#define PG8_LDA(dst, b, h) do { _Pragma("unroll") for (int m = 0; m < 4; ++m) _Pragma("unroll") for (int k = 0; k < 2; ++k) dst[m][k] = *(const LAS h16x8*)(lds + PG8_SA(b, h) + aoff + m * 2048 + k * 1024); } while (0)
#define PG8_LDB(dst, b, h) do { _Pragma("unroll") for (int n = 0; n < 2; ++n) _Pragma("unroll") for (int k = 0; k < 2; ++k) dst[n][k] = *(const LAS h16x8*)(lds + PG8_SB(b, h) + boff + n * 2048 + k * 1024); } while (0)
#define PG8_MMA(ai, bj, At, Bt) do { __builtin_amdgcn_s_setprio(1); _Pragma("unroll") for (int m = 0; m < 4; ++m) _Pragma("unroll") for (int n = 0; n < 2; ++n) _Pragma("unroll") for (int k = 0; k < 2; ++k) \
        acc[ai][bj][m][n] = __builtin_amdgcn_mfma_f32_16x16x32_f16(Bt[n][k], At[m][k], acc[ai][bj][m][n], 0, 0, 0); __builtin_amdgcn_s_setprio(0); } while (0)
#define PG8_WAIT_V(n) asm volatile("s_waitcnt vmcnt(" #n ")" ::: "memory")
#define PG8_WAIT_L(n) asm volatile("s_waitcnt lgkmcnt(" #n ")" ::: "memory")
#define PG8_BAR __builtin_amdgcn_s_barrier()
#define PG8_SCHED __builtin_amdgcn_sched_barrier(0)
    Unit cur, nxt; int ui = 0;
    if (!S.next(0, cur)) return;
    f32x4 acc[2][2][4][2];
#pragma unroll
    for (int a = 0; a < 2; ++a)
#pragma unroll
        for (int b = 0; b < 2; ++b)
#pragma unroll
            for (int m = 0; m < 4; ++m)
#pragma unroll
                for (int n = 0; n < 2; ++n) acc[a][b][m][n] = (f32x4){0.f, 0.f, 0.f, 0.f};
    h16x8 At[4][2], B0[2][2], B1[2][2];
    const char* cA = (const char*)g.A + (size_t)cur.pm * tstep; const char* cB = (const char*)g.Bt + (size_t)cur.pn * tstep;
    PG8_STAGE(PG8_SB(0, 0), cB, voffB); PG8_STAGE(PG8_SA(0, 0), cA, voffA); PG8_STAGE(PG8_SB(0, 1), cB + hstep, voffB); PG8_STAGE(PG8_SA(0, 1), cA + hstep, voffA);
    if (wr == 1) PG8_BAR;
    PG8_WAIT_V(4); PG8_BAR;
    PG8_STAGE(PG8_SB(1, 0), cB + kstep, voffB); PG8_STAGE(PG8_SA(1, 0), cA + kstep, voffA); PG8_STAGE(PG8_SB(1, 1), cB + hstep + kstep, voffB);
    PG8_WAIT_V(6); PG8_BAR;
    for (;;) {
        const bool has_next = S.next(ui + 1, nxt);
        const char* nA = has_next ? (const char*)g.A + (size_t)nxt.pm * tstep : cA; const char* nB = has_next ? (const char*)g.Bt + (size_t)nxt.pn * tstep : cB;
        for (int t = 0; t < nt; t += 2) {
            const bool last = (t == nt - 2);
            const char* a1 = cA + (size_t)(t + 1) * kstep;
            const char* a2 = last ? nA : cA + (size_t)(t + 2) * kstep; const char* b2 = last ? nB : cB + (size_t)(t + 2) * kstep;
            const char* a3 = a2 + kstep; const char* b3 = b2 + kstep;
            PG8_LDB(B0, 0, 0); PG8_SCHED; PG8_LDA(At, 0, 0); PG8_STAGE(PG8_SA(1, 1), a1 + hstep, voffA);
            PG8_WAIT_L(8); PG8_BAR; PG8_WAIT_L(0); PG8_MMA(0, 0, At, B0); PG8_BAR; PG8_SCHED;
            PG8_LDB(B1, 0, 1); PG8_STAGE(PG8_SB(0, 0), b2, voffB);
            PG8_BAR; PG8_WAIT_L(0); PG8_MMA(0, 1, At, B1); PG8_BAR;
            PG8_LDA(At, 0, 1); PG8_STAGE(PG8_SA(0, 0), a2, voffA);
            PG8_BAR; PG8_WAIT_L(0); PG8_MMA(1, 0, At, B0); PG8_BAR; PG8_SCHED;
            PG8_STAGE(PG8_SB(0, 1), b2 + hstep, voffB);
            PG8_WAIT_V(6); PG8_BAR; PG8_MMA(1, 1, At, B1); PG8_BAR;
            PG8_LDB(B0, 1, 0); PG8_SCHED; PG8_LDA(At, 1, 0); PG8_STAGE(PG8_SA(0, 1), a2 + hstep, voffA);
            PG8_WAIT_L(8); PG8_BAR; PG8_WAIT_L(0); PG8_MMA(0, 0, At, B0); PG8_BAR; PG8_SCHED;
            PG8_LDB(B1, 1, 1); PG8_STAGE(PG8_SB(1, 0), b3, voffB);
            PG8_BAR; PG8_WAIT_L(0); PG8_MMA(0, 1, At, B1); PG8_BAR;
            PG8_LDA(At, 1, 1); PG8_STAGE(PG8_SA(1, 0), a3, voffA);
            PG8_BAR; PG8_WAIT_L(0); PG8_MMA(1, 0, At, B0); PG8_BAR; PG8_SCHED;
            PG8_STAGE(PG8_SB(1, 1), b3 + hstep, voffB);
            PG8_WAIT_V(6); PG8_BAR; PG8_MMA(1, 1, At, B1); PG8_BAR;
        }
        E(acc, cur, wr, wc, fr, fq);
        if (!has_next) break;
#pragma unroll
        for (int a = 0; a < 2; ++a)
#pragma unroll
            for (int b = 0; b < 2; ++b)
#pragma unroll
                for (int m = 0; m < 4; ++m)
#pragma unroll
                    for (int n = 0; n < 2; ++n) acc[a][b][m][n] = (f32x4){0.f, 0.f, 0.f, 0.f};
        cur = nxt; cA = nA; cB = nB; ++ui;
    }
    PG8_WAIT_V(0);
    if (wr == 0) PG8_BAR;
    PG8_BAR;
#undef PG8_SA
#undef PG8_SB
#undef PG8_STAGE
#undef PG8_LDA
#undef PG8_LDB
#undef PG8_MMA
#undef PG8_WAIT_V
#undef PG8_WAIT_L
#undef PG8_BAR
#undef PG8_SCHED
}
}

__device__ __forceinline__ void run_gemm(LAS unsigned char* lds, const h16* A, const h16* Bt, int N, int K, h16* O, int ldc, int mode, const int tidx) {
    pg8::Gemm g; g.A = A; g.Bt = Bt; g.M = T_; g.N = N; g.K = K;
    pg8::StaticOrder S; S.init(T_, N, (int)gridDim.x, (int)blockIdx.x);
    pg8::EpiH E; E.O = O; E.ldc = ldc; E.MODE = mode;
    pg8::gemm_phase(lds, g, S, E, tidx);
}

__device__ __forceinline__ void cw_decode(int id, int& mat, int& K, int& n0, int& k0) {
    int tl;
    if (id < 960) { mat = 0; tl = id; } else if (id < 1216) { mat = 1; tl = id - 960; } else if (id < 2240) { mat = 2; tl = id - 1216; } else { mat = 3; tl = id - 2240; }
    K = (mat == 3) ? 4096 : 1024;
    const int nkt = K / 64;
    n0 = (tl / nkt) * 64; k0 = (tl % nkt) * 64;
}
__device__ __forceinline__ void cw_load(const Params& p, int l, int id, LAS float* tile, int tid) {
    int mat, K, n0, k0; cw_decode(id, mat, K, n0, k0);
    const int nj = tid & 63, n = n0 + nj;
    const float* src = nullptr; int sstride = 0;
    if (mat == 0) {
        if (n < 896) { src = p.in[I_WIN] + (size_t)l * DM * INC + n; sstride = INC; }
        else if (n < 928) { if (l > 0) { src = p.in[I_WINV] + (size_t)(l - 1) * DM * 32 + (n - 896); sstride = 32; } }
        else if (n < 2724) { src = p.in[I_WIN] + (size_t)l * DM * INC + (n - 32); sstride = INC; }
        else if (n < 2728) { }
        else if (n < 3752) { src = p.in[I_WIN] + (size_t)l * DM * INC + (n - 36); sstride = INC; }
    } else if (mat == 1) { src = p.in[I_WOUT] + (size_t)l * 1024 * 1024 + n; sstride = 1024; }
    else if (mat == 2) { src = p.in[I_WUP] + (size_t)l * 1024 * 4096 + n; sstride = 4096; }
    else { src = p.in[I_WDN] + (size_t)l * 4096 * 1024 + n; sstride = 1024; }
    float v[8];
#pragma unroll
    for (int i = 0; i < 8; ++i) { const int ki = (tid >> 6) + 8 * i; v[i] = src ? src[(size_t)(k0 + ki) * sstride] : 0.f; }
#pragma unroll
    for (int i = 0; i < 8; ++i) { const int ki = (tid >> 6) + 8 * i; tile[ki * 65 + nj] = v[i]; }
}
__device__ __forceinline__ void cw_store(const Params& p, int id, const LAS float* tile, int tid) {
    int mat, K, n0, k0; cw_decode(id, mat, K, n0, k0);
    h16* dst = (h16*)(p.ws + (mat == 0 ? OFF_WIN : mat == 1 ? OFF_WOUT : mat == 2 ? OFF_WUP : OFF_WDN));
    const int ki = tid & 63;
#pragma unroll
    for (int i = 0; i < 8; ++i) { const int nj = (tid >> 6) + 8 * i; dst[(size_t)(n0 + nj) * K + k0 + ki] = (h16)tile[ki * 65 + nj]; }
}
__device__ __forceinline__ void conv_weights(const Params& p, int l, LAS unsigned char* lds, const int tidx) {
    LAS float* tile = (LAS float*)lds;
    const int tid = tidx;
    for (int id = blockIdx.x * 4; id < 3264; id += gridDim.x * 4) {
        __syncthreads();
#pragma unroll
        for (int u = 0; u < 4; ++u) if (id + u < 3264) cw_load(p, l, id + u, tile + u * 4224, tid);
        __syncthreads();
#pragma unroll
        for (int u = 0; u < 4; ++u) if (id + u < 3264) cw_store(p, id + u, tile + u * 4224, tid);
    }
    __syncthreads();
}

__device__ __forceinline__ void conv_x(const Params& p, const int tidx) {
    const f32x4* src = (const f32x4*)p.in[I_X]; h16x4* dst = (h16x4*)(p.ws + OFF_X16);
    for (size_t i = (size_t)blockIdx.x * 512 + tidx; i < (size_t)T_ * DM / 4; i += (size_t)gridDim.x * 512) dst[i] = f4h(src[i]);
}

__device__ __forceinline__ void pre_phase(const Params& p, int l, LAS unsigned char* lds, const int tidx) {
    constexpr int RS = 168;
    LAS h16* A16 = (LAS h16*)lds;
    LAS h16* W16 = (LAS h16*)(lds + 64 * RS * 2);
    const h16* proj = (const h16*)(p.ws + OFF_BIG);
    h16* prep = (h16*)p.out;
    h16* vfirst = (h16*)(p.ws + OFF_VF);
    const int tid = tidx, wid = tid >> 6, lane = tid & 63, c16 = lane & 15, g = lane >> 4, hh = wid & 3, mh = wid >> 2;
    const int nact = (l == 0) ? 128 : 160;
    __syncthreads();
#pragma unroll 1
    for (int e0 = 0; e0 < nact * 256; e0 += 512 * 16) {
        float wv16[16];
#pragma unroll
        for (int u = 0; u < 16; ++u) {
            const int e = e0 + u * 512 + tid, i = e >> 8, cc = e & 255;
            const float* sp;
            if (i < 32) sp = p.in[I_W2] + (size_t)(l * 32 + i) * 256 + cc;
            else if (i < 64) sp = p.in[I_A2] + (size_t)(l * 32 + i - 32) * 256 + cc;
            else if (i < 128) sp = p.in[I_G2] + (size_t)(l * 64 + i - 64) * 256 + cc;
            else sp = p.in[I_V2] + (size_t)((l - 1) * 32 + i - 128) * 256 + cc;
            wv16[u] = *sp;
        }
#pragma unroll
        for (int u = 0; u < 16; ++u) { const int e = e0 + u * 512 + tid; W16[(e & 255) * RS + (e >> 8)] = (h16)wv16[u]; }
    }
    float mu_r[4], mu_k[4], mu_v[4], w0[4], a0[4], k_k[4], k_a[4], r_k[4], lnw[4], lnb[4], v0[4];
#pragma unroll
    for (int nt = 0; nt < 4; ++nt) {
        const int ch = hh * 64 + nt * 16 + c16;
        mu_r[nt] = p.in[I_MU][l * 896 + ch]; mu_k[nt] = p.in[I_MU][l * 896 + 256 + ch]; mu_v[nt] = p.in[I_MU][l * 896 + 512 + ch];
        w0[nt] = p.in[I_W0][l * 256 + ch]; a0[nt] = p.in[I_A0][l * 256 + ch]; k_k[nt] = p.in[I_KK][l * 256 + ch]; k_a[nt] = p.in[I_KA][l * 256 + ch];
        r_k[nt] = p.in[I_RK][l * 256 + ch]; lnw[nt] = p.in[I_LNW][l * 256 + ch]; lnb[nt] = p.in[I_LNB][l * 256 + ch];
        v0[nt] = (l > 0) ? p.in[I_V0][(l - 1) * 256 + ch] : 0.f;
    }
    for (int tt = blockIdx.x; tt < T_ / 64; tt += gridDim.x) {
        const int t0 = tt * 64;
        __syncthreads();
#pragma unroll 1
        for (int eb = 0; eb < 20; eb += 10) {
            float curv[10], prvv[10];
#pragma unroll
            for (int u = 0; u < 10; ++u) {
                const int e = (eb + u) * 512 + tid, tok = e / 160, i = e - tok * 160, t = t0 + tok;
                curv[u] = 0.f; prvv[u] = 0.f;
                if (i < nact) {
                    curv[u] = (float)proj[(size_t)t * NP + C_FW + i];
                    if (t & (SEQ_ - 1)) prvv[u] = (float)proj[(size_t)(t - 1) * NP + C_FW + i];
                }
            }
#pragma unroll
            for (int u = 0; u < 10; ++u) {
                const int e = (eb + u) * 512 + tid, tok = e / 160, i = e - tok * 160;
                if (i < nact) {
                    const float mu = (i < 128) ? p.in[I_MU][l * 896 + 768 + i] : p.in[I_MUV][(l - 1) * 32 + (i - 128)];
                    const float f = curv[u] + (prvv[u] - curv[u]) * mu;
                    float a = f;
                    if (i < 32) { const float e2 = __expf(-2.0f * fabsf(f)); const float th = (1.0f - e2) * __builtin_amdgcn_rcpf(1.0f + e2); a = f < 0.f ? -th : th; } else if (i >= 64 && i < 128) a = sigmoidf_(f);
                    A16[tok * RS + i] = (h16)a;
                }
            }
        }
        __syncthreads();
#pragma unroll 1
        for (int mt = 0; mt < 2; ++mt) {
            const int tokb = mh * 32 + mt * 16;
            f32x4 aw[4], aa[4], ag[4], av[4];
            {
                const LAS h16* ar = A16 + (tokb + c16) * RS + 8 * g;
                const h16x8 A0 = *(const LAS h16x8*)(ar), A1 = *(const LAS h16x8*)(ar + 32), A2 = *(const LAS h16x8*)(ar + 64), A3 = *(const LAS h16x8*)(ar + 96);
                h16x8 A4 = A0; if (l > 0) A4 = *(const LAS h16x8*)(ar + 128);
#pragma unroll
                for (int nt = 0; nt < 4; ++nt) {
                    const LAS h16* br = W16 + (hh * 64 + nt * 16 + c16) * RS + 8 * g;
                    const f32x4 z = {0.f, 0.f, 0.f, 0.f};
                    aw[nt] = __builtin_amdgcn_mfma_f32_16x16x32_f16(A0, *(const LAS h16x8*)(br), z, 0, 0, 0);
                    aa[nt] = __builtin_amdgcn_mfma_f32_16x16x32_f16(A1, *(const LAS h16x8*)(br + 32), z, 0, 0, 0);
                    ag[nt] = __builtin_amdgcn_mfma_f32_16x16x32_f16(A2, *(const LAS h16x8*)(br + 64), z, 0, 0, 0);
                    ag[nt] = __builtin_amdgcn_mfma_f32_16x16x32_f16(A3, *(const LAS h16x8*)(br + 96), ag[nt], 0, 0, 0);
                    av[nt] = z;
                    if (l > 0) av[nt] = __builtin_amdgcn_mfma_f32_16x16x32_f16(A4, *(const LAS h16x8*)(br + 128), z, 0, 0, 0);
                }
            }
#pragma unroll
            for (int rp = 0; rp < 2; ++rp) {
            h16 lr[8], lk[8], lv[8], lpr[8], lpk[8], lpv[8], lvf[8];
#pragma unroll
            for (int r2 = 0; r2 < 2; ++r2) {
                const int t = t0 + tokb + 4 * g + rp * 2 + r2;
                const h16* row = proj + (size_t)t * NP + hh * 64 + c16;
#pragma unroll
                for (int nt = 0; nt < 4; ++nt) {
                    const int q = r2 * 4 + nt;
                    lr[q] = row[C_R + nt * 16]; lk[q] = row[C_K + nt * 16]; lv[q] = row[C_V + nt * 16];
                    lpr[q] = (h16)0.f; lpk[q] = (h16)0.f; lpv[q] = (h16)0.f; lvf[q] = (h16)0.f;
                    if (t & (SEQ_ - 1)) { lpr[q] = row[C_R + nt * 16 - NP]; lpk[q] = row[C_K + nt * 16 - NP]; lpv[q] = row[C_V + nt * 16 - NP]; }
                    if (l > 0) lvf[q] = vfirst[(size_t)t * 256 + hh * 64 + nt * 16 + c16];
                }
            }
#pragma unroll
            for (int r2 = 0; r2 < 2; ++r2) {
                const int rg = rp * 2 + r2;
                const int t = t0 + tokb + 4 * g + rg;
                float rr[4], kp[4], vv[4], kkr[4], aS[4], ee[4];
                float n2 = 0.f, bn = 0.f;
#pragma unroll
                for (int nt = 0; nt < 4; ++nt) {
                    const int q = r2 * 4 + nt;
                    float r = (float)lr[q], k = (float)lk[q], v = (float)lv[q];
                    r += ((float)lpr[q] - r) * mu_r[nt]; k += ((float)lpk[q] - k) * mu_k[nt]; v += ((float)lpv[q] - v) * mu_v[nt];
                    const float wl = w0[nt] + aw[nt][rg];
                    ee[nt] = __expf(-softplusf_(-wl) - 0.5f);
                    const float a = sigmoidf_(a0[nt] + aa[nt][rg]);
                    if (l == 0) vfirst[(size_t)t * 256 + hh * 64 + nt * 16 + c16] = (h16)v;
                    else v += ((float)lvf[q] - v) * sigmoidf_(v0[nt] + av[nt][rg]);
                    kkr[nt] = k * k_k[nt];
                    kp[nt] = k * (1.0f + (a - 1.0f) * k_a[nt]);
                    rr[nt] = r; vv[nt] = v; aS[nt] = a;
                    n2 += kkr[nt] * kkr[nt]; bn += r * kp[nt] * r_k[nt];
                }
                n2 = sum16(n2); bn = sum16(bn);
                const float rn = __builtin_amdgcn_rsqf(fmaxf(n2, 1e-24f));
#pragma unroll
                for (int nt = 0; nt < 4; ++nt) {
                    const float kk = kkr[nt] * rn, gg = ag[nt][rg];
                    h16* o = prep + (size_t)t * 2048 + hh * 64 + nt * 16 + c16;
                    o[0] = (h16)rr[nt]; o[256] = (h16)ee[nt]; o[512] = (h16)kp[nt]; o[768] = (h16)kk; o[1024] = (h16)(kk * aS[nt]); o[1280] = (h16)vv[nt];
                    o[1536] = (h16)(lnw[nt] * gg); o[1792] = (h16)((lnb[nt] + bn * vv[nt]) * gg);
                }
            }
            }
        }
    }
    __syncthreads();
}

constexpr int CH = 32;

__device__ __forceinline__ float dot4(f32x4 a, f32x4 b) { f32x2 p = (f32x2){a[0], a[1]} * (f32x2){b[0], b[1]}; p = __builtin_elementwise_fma((f32x2){a[2], a[3]}, (f32x2){b[2], b[3]}, p); return p[0] + p[1]; }
template <int R> __device__ __forceinline__ void plain_write_y(h16* mix, int t0, int col, LAS unsigned char* ybuf, int lt) {
    if (lt >= 128 * R) return;
    const int tok = lt / (4 * R), r8 = lt & (4 * R - 1);
    const f32x4 y = *(const LAS f32x4*)(ybuf + (tok * 32 + r8 * 4) * 4);
    *(h16x4*)(mix + (size_t)(t0 + tok) * DM + col + r8 * 4) = f4h(y);
}

constexpr int RW_SH = 0, RW_VB = CH * 16 * 20 * 4, RW_YB = RW_VB + CH * 32 * 4, RW_STRIDE = RW_YB + CH * 32 * 4;
template <int R> __device__ __forceinline__ void rwkv_load(const h16* prep, int t0, int h, int rowbase, LAS unsigned char* buf, int lt) {
    LAS float* sh = (LAS float*)(buf + RW_SH);
    h16x4 raw[10];
#pragma unroll
    for (int i = 0; i < 10; ++i) {
        const int e = i * 256 + lt, tok = e / 80, rem = e - tok * 80, vec = rem >> 4, sub = rem & 15;
        const int pv = (vec == 0) ? 3 : (vec == 1) ? 1 : (vec == 2) ? 4 : (vec == 3) ? 2 : 0;
        raw[i] = *(const h16x4*)(prep + (size_t)(t0 + tok) * 2048 + pv * 256 + h * 64 + sub * 4);
    }
    const int tokv = lt / (4 * R), r8 = lt & (4 * R - 1);
    h16x4 rv = {(h16)0.f, (h16)0.f, (h16)0.f, (h16)0.f};
    if (lt < 128 * R) rv = *(const h16x4*)(prep + (size_t)(t0 + tokv) * 2048 + 5 * 256 + rowbase + r8 * 4);
#pragma unroll
    for (int i = 0; i < 10; ++i) {
        const int e = i * 256 + lt, tok = e / 80, rem = e - tok * 80, vec = rem >> 4, sub = rem & 15;
        f32x4 f = h4f(raw[i]);
        if (vec == 1) { f[0] = __expf(-f[0]); f[1] = __expf(-f[1]); f[2] = __expf(-f[2]); f[3] = __expf(-f[3]); }
        *(LAS f32x4*)(sh + ((tok * 16 + sub) * 5 + vec) * 4) = f;
    }
    if (lt < 128 * R) *(LAS f32x4*)(buf + RW_VB + (tokv * 32 + r8 * 4) * 4) = h4f(rv);
}
template <int R> __device__ __forceinline__ void rwkv_scan(const Params& p, int item, LAS unsigned char* lds, const int tidx) {
    constexpr int NQ = 4 / R;
    const int b = item / (4 * NQ), h = (item / NQ) & 3, q2 = item % NQ;
    const int tid = tidx, wid = tid >> 6, lane = tid & 63, lt = tid - 256;
    const h16* prep = (const h16*)p.out;
    h16* mix = (h16*)(p.ws + OFF_MIX);
    const int rowbase = h * 64 + q2 * 16 * R, tb = b * SEQ_;
    const bool loader = wid >= 4;
    const int rowl = (wid & 3) * 4 + (lane >> 4), sub = lane & 15;
    LAS float* dump = (LAS float*)(lds + LDS_BYTES - 8192) + tid;
    f32x4 Sa = {0.f, 0.f, 0.f, 0.f}, Sb = {0.f, 0.f, 0.f, 0.f};
    __syncthreads();
    if (loader) rwkv_load<R>(prep, tb, h, rowbase, lds, lt);
    __syncthreads();
#pragma unroll 1
    for (int c = 0; c < SEQ_ / CH; ++c) {
        LAS unsigned char* buf = lds + (c & 1) * RW_STRIDE;
        if (loader) {
            if (c + 1 < SEQ_ / CH) rwkv_load<R>(prep, tb + (c + 1) * CH, h, rowbase, lds + ((c + 1) & 1) * RW_STRIDE, lt);
            if (c > 0) plain_write_y<R>(mix, tb + (c - 1) * CH, rowbase, lds + ((c - 1) & 1) * RW_STRIDE + RW_YB, lt);
        } else {
            const LAS float* sh = (const LAS float*)(buf + RW_SH);
            const LAS float* vb = (const LAS float*)(buf + RW_VB);
            LAS float* yb = (LAS float*)(buf + RW_YB);
            const LAS f32x4* q0 = (const LAS f32x4*)(sh + sub * 20);
            f32x4 nkk = q0[0], nw = q0[1], nbb = q0[2], nk = q0[3], nr = q0[4];
            float nva = vb[rowl], nvb = vb[rowl + 16];
#pragma unroll 4
            for (int s = 0; s < CH; ++s) {
                const f32x4 kk = nkk, w = nw, bb = nbb, k = nk, r = nr;
                const float va = nva, vbb = nvb;
                const LAS f32x4* q = (const LAS f32x4*)(sh + ((s + 1) * 16 + sub) * 20);
                nkk = q[0]; nw = q[1]; nbb = q[2]; nk = q[3]; nr = q[4];
                nva = vb[(s + 1) * 32 + rowl]; if (R == 2) nvb = vb[(s + 1) * 32 + rowl + 16];
                const float da = sum16(dot4(Sa, kk));
                Sa = Sa * w + (k * va - bb * da);
                const float ya = sum16(dot4(Sa, r));
                LAS float* wp = (sub == 0) ? (yb + s * 32 + rowl) : dump;
                wp[0] = ya;
                if (R == 2) {
                    const float db = sum16(dot4(Sb, kk));
                    Sb = Sb * w + (k * vbb - bb * db);
                    wp[16] = sum16(dot4(Sb, r));
                }
            }
        }
        __syncthreads();
    }
    if (loader) plain_write_y<R>(mix, tb + (SEQ_ / CH - 1) * CH, rowbase, lds + ((SEQ_ / CH - 1) & 1) * RW_STRIDE + RW_YB, lt);
}

constexpr int HG_SH = 0, HG_VB = CH * 16 * 12 * 4, HG_YB = HG_VB + CH * 32 * 4, HG_STRIDE = HG_YB + CH * 32 * 4;
template <int R> __device__ __forceinline__ void hgrn_load(const h16* proj, int t0, int h, int rowbase, f32x4 lb, LAS unsigned char* buf, int lt) {
    LAS float* sh = (LAS float*)(buf + HG_SH);
    h16x4 rq[2], rf[2];
#pragma unroll
    for (int i = 0; i < 2; ++i) {
        const int e = i * 256 + lt, tok = e >> 4, sub = e & 15;
        const h16* row = proj + (size_t)(t0 + tok) * NP + h * 64 + sub * 4;
        rq[i] = *(const h16x4*)(row + C_HQ); rf[i] = *(const h16x4*)(row + C_HF);
    }
    const int tokv = lt / (4 * R), r8 = lt & (4 * R - 1);
    h16x4 rv = {(h16)0.f, (h16)0.f, (h16)0.f, (h16)0.f};
    if (lt < 128 * R) rv = *(const h16x4*)(proj + (size_t)(t0 + tokv) * NP + C_HI + rowbase + r8 * 4);
#pragma unroll
    for (int i = 0; i < 2; ++i) {
        const int e = i * 256 + lt, tok = e >> 4, sub = e & 15;
        const f32x4 qv = h4f(rq[i]), fv = h4f(rf[i]);
        f32x4 fo, ko, qo;
#pragma unroll
        for (int j = 0; j < 4; ++j) { const float fg = lb[j] + (1.0f - lb[j]) * sigmoidf_(fv[j]); fo[j] = fg; ko[j] = 1.0f - fg; qo[j] = siluf_(qv[j]); }
        LAS f32x4* d = (LAS f32x4*)(sh + (tok * 16 + sub) * 12);
        d[0] = fo; d[1] = ko; d[2] = qo;
    }
    if (lt < 128 * R) *(LAS f32x4*)(buf + HG_VB + (tokv * 32 + r8 * 4) * 4) = h4f(rv);
}
template <int R> __device__ __forceinline__ void hgrn_scan(const Params& p, int l, int item, LAS unsigned char* lds, const int tidx) {
    constexpr int NQ = 4 / R;
    const int b = item / (4 * NQ), h = (item / NQ) & 3, q2 = item % NQ;
    const int tid = tidx, wid = tid >> 6, lane = tid & 63, lt = tid - 256;
    const h16* proj = (const h16*)(p.ws + OFF_BIG);
    h16* mix = (h16*)(p.ws + OFF_MIX);
    const int rowbase = h * 64 + q2 * 32, tb = b * SEQ_;
    const bool loader = wid >= 4;
    const int rowl = (wid & 3) * 4 + (lane >> 4), sub = lane & 15;
    LAS float* dump = (LAS float*)(lds + LDS_BYTES - 8192) + tid;
    f32x4 lb = {0.f, 0.f, 0.f, 0.f};
    if (l > 0) {
#pragma unroll
        for (int j = 0; j < 4; ++j) { const int ch = h * 64 + (lt & 15) * 4 + j; lb[j] = sigmoidf_(p.in[I_LB][256 + ch] - p.in[I_LB][ch]); }
    }
    f32x4 Sa = {0.f, 0.f, 0.f, 0.f}, Sb = {0.f, 0.f, 0.f, 0.f};
    __syncthreads();
    if (loader) hgrn_load<R>(proj, tb, h, rowbase, lb, lds, lt);
    __syncthreads();
#pragma unroll 1
    for (int c = 0; c < SEQ_ / CH; ++c) {
        LAS unsigned char* buf = lds + (c & 1) * HG_STRIDE;
        if (loader) {
            if (c + 1 < SEQ_ / CH) hgrn_load<R>(proj, tb + (c + 1) * CH, h, rowbase, lb, lds + ((c + 1) & 1) * HG_STRIDE, lt);
            if (c > 0) plain_write_y<R>(mix, tb + (c - 1) * CH, 768 + rowbase, lds + ((c - 1) & 1) * HG_STRIDE + HG_YB, lt);
        } else {
            const LAS float* sh = (const LAS float*)(buf + HG_SH);
            const LAS float* vb = (const LAS float*)(buf + HG_VB);
            LAS float* yb = (LAS float*)(buf + HG_YB);
            const LAS f32x4* q0 = (const LAS f32x4*)(sh + sub * 12);
            f32x4 nf = q0[0], nk = q0[1], nq = q0[2];
            float nva = vb[rowl], nvb = vb[rowl + 16];
#pragma unroll 4
            for (int s = 0; s < CH; ++s) {
                const f32x4 f = nf, k = nk, qq = nq;
                const float va = nva, vbb = nvb;
                const LAS f32x4* q = (const LAS f32x4*)(sh + ((s + 1) * 16 + sub) * 12);
                nf = q[0]; nk = q[1]; nq = q[2];
                nva = vb[(s + 1) * 32 + rowl]; if (R == 2) nvb = vb[(s + 1) * 32 + rowl + 16];
                Sa = Sa * f + k * va;
                const float ya = sum16(dot4(Sa, qq));
                LAS float* wp = (sub == 0) ? (yb + s * 32 + rowl) : dump;
                wp[0] = ya;
                if (R == 2) { Sb = Sb * f + k * vbb; wp[16] = sum16(dot4(Sb, qq)); }
            }
        }
        __syncthreads();
    }
    if (loader) plain_write_y<R>(mix, tb + (SEQ_ / CH - 1) * CH, 768 + rowbase, lds + ((SEQ_ / CH - 1) & 1) * HG_STRIDE + HG_YB, lt);
}

constexpr int SD_SH = 0, SD_XDT = CH * 16 * 20 * 4, SD_XS = SD_XDT + CH * 32 * 4, SD_AB = SD_XS + CH * 32 * 4, SD_YB = SD_AB + CH * 4, SD_STRIDE = SD_YB + CH * 32 * 4;
struct SsdW { f32x4 w[4], b; };
__device__ __forceinline__ SsdW ssd_wload(const Params& p, int l, int ch) {
    SsdW r; const float* cw = p.in[I_CW] + (size_t)l * 4 * 768 + ch;
#pragma unroll
    for (int j = 0; j < 4; ++j) r.w[j] = *(const f32x4*)(cw + j * 768);
    r.b = *(const f32x4*)(p.in[I_CB] + l * 768 + ch);
    return r;
}
__device__ __forceinline__ f32x4 silu4(f32x4 a) { f32x4 o; o[0] = siluf_(a[0]); o[1] = siluf_(a[1]); o[2] = siluf_(a[2]); o[3] = siluf_(a[3]); return o; }
struct SsdRaw { h16x4 rows[11]; h16x4 rx[4]; float dtraw; };
template <int R> __device__ __forceinline__ void ssd_issue(SsdRaw& rw, const h16* proj, int t0, int h, int chbc, int chxs, int lt) {
    const int tq = lt >> 6;
    const int tA = t0 + tq * 8, posA = tA & (SEQ_ - 1);
    const h16x4 hz = {(h16)0.f, (h16)0.f, (h16)0.f, (h16)0.f};
#pragma unroll
    for (int j = 0; j < 11; ++j) rw.rows[j] = (posA - 3 + j >= 0) ? *(const h16x4*)(proj + (size_t)(tA - 3 + j) * NP + C_SX + chbc) : hz;
    const int tokx = (lt / (4 * R)) & 31, tX = t0 + tokx, posX = tX & (SEQ_ - 1);
#pragma unroll
    for (int j = 0; j < 4; ++j) rw.rx[j] = (posX - 3 + j >= 0) ? *(const h16x4*)(proj + (size_t)(tX - 3 + j) * NP + C_SX + chxs) : hz;
    rw.dtraw = (float)proj[(size_t)tX * NP + C_SDT + h];
}
template <int R> __device__ __forceinline__ void ssd_commit(const SsdRaw& rw, const SsdW& wbc, const SsdW& wxs, float dtb, float Ah, LAS unsigned char* buf, int lt) {
    LAS float* sh = (LAS float*)(buf + SD_SH);
    const int gi = lt & 63, tq = lt >> 6, vec = gi >> 5, gj = gi & 31;
    const int tokx = (lt / (4 * R)) & 31, r8 = lt & (4 * R - 1);
#pragma unroll
    for (int j = 0; j < 8; ++j) {
        f32x4 acc = wbc.b;
#pragma unroll
        for (int k = 0; k < 4; ++k) acc += h4f(rw.rows[j + k]) * wbc.w[k];
        *(LAS f32x4*)(sh + ((tq * 8 + j) * 16 + (gj >> 1)) * 20 + vec * 8 + (gj & 1) * 4) = silu4(acc);
    }
    {
        f32x4 acc = wxs.b;
#pragma unroll
        for (int k = 0; k < 4; ++k) acc += h4f(rw.rx[k]) * wxs.w[k];
        const f32x4 xs = silu4(acc);
        const float dt = softplusf_(rw.dtraw + dtb);
        if (lt < 128 * R) {
            *(LAS f32x4*)(buf + SD_XS + (tokx * 32 + r8 * 4) * 4) = xs;
            *(LAS f32x4*)(buf + SD_XDT + (tokx * 32 + r8 * 4) * 4) = xs * dt;
            if (r8 == 0) *(LAS float*)(buf + SD_AB + tokx * 4) = __expf(dt * Ah);
        }
    }
}
template <int R> __device__ __forceinline__ void ssd_write_y(const h16* proj, h16* mix, int t0, int cc0, float Dh, LAS unsigned char* buf, int lt) {
    if (lt >= 128 * R) return;
    const int tok = lt / (4 * R), r8 = lt & (4 * R - 1), cc = cc0 + r8 * 4;
    const f32x4 y = *(const LAS f32x4*)(buf + SD_YB + (tok * 32 + r8 * 4) * 4) + *(const LAS f32x4*)(buf + SD_XS + (tok * 32 + r8 * 4) * 4) * Dh;
    const f32x4 z = h4f(*(const h16x4*)(proj + (size_t)(t0 + tok) * NP + C_SZ + cc));
    *(h16x4*)(mix + (size_t)(t0 + tok) * DM + 512 + cc) = f4h(y * silu4(z));
}
template <int R> __device__ __forceinline__ void ssd_scan(const Params& p, int l, int item, LAS unsigned char* lds, const int tidx) {
    constexpr int NQ = 4 / R;
    const int b = item / (4 * NQ), h = (item / NQ) & 3, q2 = item % NQ;
    const int tid = tidx, wid = tid >> 6, lane = tid & 63, lt = tid - 256;
    const h16* proj = (const h16*)(p.ws + OFF_BIG);
    h16* mix = (h16*)(p.ws + OFF_MIX);
    const int tb = b * SEQ_, cc0 = h * 64 + q2 * 16 * R;
    const bool loader = wid >= 4;
    const int rowl = (wid & 3) * 4 + (lane >> 4), sub = lane & 15;
    LAS float* dump = (LAS float*)(lds + LDS_BYTES - 8192) + tid;
    const float dtb = p.in[I_DTB][l * 4 + h], Ah = -__expf(p.in[I_ALOG][l * 4 + h]), Dh = p.in[I_SD][l * 4 + h];
    const int chbc = 256 + ((lt & 63) >> 5) * 256 + (h >> 1) * 128 + (lt & 31) * 4, chxs = cc0 + (lt & (4 * R - 1)) * 4;
    SsdW wbc, wxs;
    if (loader) { wbc = ssd_wload(p, l, chbc); wxs = ssd_wload(p, l, chxs); }
    f32x4 Sa0 = {0.f, 0.f, 0.f, 0.f}, Sa1 = Sa0, Sb0 = Sa0, Sb1 = Sa0;
    __syncthreads();
    SsdRaw rw;
    if (loader) { ssd_issue<R>(rw, proj, tb, h, chbc, chxs, lt); ssd_commit<R>(rw, wbc, wxs, dtb, Ah, lds, lt); ssd_issue<R>(rw, proj, tb + CH, h, chbc, chxs, lt); }
    __syncthreads();
#pragma unroll 1
    for (int c = 0; c < SEQ_ / CH; ++c) {
        LAS unsigned char* buf = lds + (c & 1) * SD_STRIDE;
        if (loader) {
            if (c > 0) ssd_write_y<R>(proj, mix, tb + (c - 1) * CH, cc0, Dh, lds + ((c - 1) & 1) * SD_STRIDE, lt);
            if (c + 1 < SEQ_ / CH) ssd_commit<R>(rw, wbc, wxs, dtb, Ah, lds + ((c + 1) & 1) * SD_STRIDE, lt);
            if (c + 2 < SEQ_ / CH) ssd_issue<R>(rw, proj, tb + (c + 2) * CH, h, chbc, chxs, lt);
        } else {
            const LAS float* sh = (const LAS float*)(buf + SD_SH);
            const LAS float* xdt = (const LAS float*)(buf + SD_XDT);
            const LAS float* xsb = (const LAS float*)(buf + SD_XS);
            const LAS float* ab = (const LAS float*)(buf + SD_AB);
            LAS float* yb = (LAS float*)(buf + SD_YB);
            const LAS f32x4* q0 = (const LAS f32x4*)(sh + sub * 20);
            f32x4 nB0 = q0[0], nB1 = q0[1], nC0 = q0[2], nC1 = q0[3];
            float na = ab[0], nxda = xdt[rowl], nxdb = xdt[rowl + 16];
#pragma unroll 4
            for (int s = 0; s < CH; ++s) {
                const f32x4 B0 = nB0, B1 = nB1, C0 = nC0, C1 = nC1;
                const float a = na, xda = nxda, xdb = nxdb;
                const LAS f32x4* q = (const LAS f32x4*)(sh + ((s + 1) * 16 + sub) * 20);
                nB0 = q[0]; nB1 = q[1]; nC0 = q[2]; nC1 = q[3];
                na = ab[s + 1]; nxda = xdt[(s + 1) * 32 + rowl];
                if (R == 2) nxdb = xdt[(s + 1) * 32 + rowl + 16];
                Sa0 = Sa0 * a + B0 * xda; Sa1 = Sa1 * a + B1 * xda;
                const float ya = sum16(dot4(Sa0, C0) + dot4(Sa1, C1));
                LAS float* wp = (sub == 0) ? (yb + s * 32 + rowl) : dump;
                wp[0] = ya;
                if (R == 2) {
                    Sb0 = Sb0 * a + B0 * xdb; Sb1 = Sb1 * a + B1 * xdb;
                    wp[16] = sum16(dot4(Sb0, C0) + dot4(Sb1, C1));
                }
            }
        }
        __syncthreads();
    }
    if (loader) ssd_write_y<R>(proj, mix, tb + (SEQ_ / CH - 1) * CH, cc0, Dh, lds + ((SEQ_ / CH - 1) & 1) * SD_STRIDE, lt);
}

__device__ __forceinline__ void attn_item(const Params& p, int item, int wid, const int tidx) {
    const int b = item / 192, rem = item - b * 192, h = rem / 48, s = rem - h * 48;
    int br, dil, r, n;
    if (s < 16) { br = 0; dil = 1; r = 0; n = s; } else if (s < 32) { br = 1; dil = 4; r = (s - 16) >> 2; n = (s - 16) & 3; } else { br = 2; dil = 16; r = s - 32; n = 0; }
    const int lane = tidx & 63, c16 = lane & 15, g = lane >> 4;
    const h16* base = (const h16*)(p.ws + OFF_BIG) + (size_t)b * SEQ_ * NP;
    const int tq = (n * 128 + 16 * wid + c16) * dil + r;
    h16x8 qf0 = *(const h16x8*)(base + (size_t)tq * NP + C_AQ + h * 64 + g * 8);
    h16x8 qf1 = *(const h16x8*)(base + (size_t)tq * NP + C_AQ + h * 64 + 32 + g * 8);
    f32x4 sc[9];
    h16x8 kf0[9], kf1[9];
    h16x4 vreg[36];
#pragma unroll
    for (int kt = 0; kt < 9; ++kt) {
        int kp = (n - 1) * 128 + 16 * wid + 16 * kt + c16; kp = kp < 0 ? 0 : kp;
        const h16* kr = base + (size_t)(kp * dil + r) * NP + C_AK + h * 64 + g * 8;
        kf0[kt] = *(const h16x8*)kr; kf1[kt] = *(const h16x8*)(kr + 32);
    }
#pragma unroll
    for (int kt = 0; kt < 9; ++kt)
#pragma unroll
        for (int rg = 0; rg < 4; ++rg) {
            int kp = (n - 1) * 128 + 16 * wid + 16 * kt + 4 * g + rg; kp = kp < 0 ? 0 : kp;
            vreg[kt * 4 + rg] = *(const h16x4*)(base + (size_t)(kp * dil + r) * NP + C_AV + h * 64 + 4 * c16);
        }
    __builtin_amdgcn_sched_barrier(0);
#pragma unroll
    for (int kt = 0; kt < 9; ++kt) {
        f32x4 a = {0.f, 0.f, 0.f, 0.f};
        a = __builtin_amdgcn_mfma_f32_16x16x32_f16(kf0[kt], qf0, a, 0, 0, 0);
        a = __builtin_amdgcn_mfma_f32_16x16x32_f16(kf1[kt], qf1, a, 0, 0, 0);
        sc[kt] = a;
    }
    const float slope = exp2f(-2.0f * (float)(h + 1)) * (float)dil;
    float m = -INFINITY;
#pragma unroll
    for (int kt = 0; kt < 9; ++kt)
#pragma unroll
        for (int rg = 0; rg < 4; ++rg) {
            const int jj = 16 * kt + 4 * g + rg, dist = 128 + c16 - jj;
            const bool valid = (dist >= 0) && (dist <= 128) && (n > 0 || (16 * wid + jj) >= 128);
            const float v = valid ? (sc[kt][rg] * 0.125f - slope * (float)dist) : -INFINITY;
            sc[kt][rg] = v; m = fmaxf(m, v);
        }
    m = fmaxf(m, __shfl_xor(m, 16)); m = fmaxf(m, __shfl_xor(m, 32));
    float lsum = 0.f;
#pragma unroll
    for (int kt = 0; kt < 9; ++kt)
#pragma unroll
        for (int rg = 0; rg < 4; ++rg) { const float e = __expf(sc[kt][rg] - m); sc[kt][rg] = e; lsum += e; }
    lsum += __shfl_xor(lsum, 16); lsum += __shfl_xor(lsum, 32);
    f32x4 o[4];
#pragma unroll
    for (int d = 0; d < 4; ++d) o[d] = (f32x4){0.f, 0.f, 0.f, 0.f};
#pragma unroll
    for (int kt = 0; kt < 9; ++kt)
#pragma unroll
        for (int rg = 0; rg < 4; ++rg) {
            const f32x4 v = h4f(vreg[kt * 4 + rg]);
#pragma unroll
            for (int d = 0; d < 4; ++d) o[d] = __builtin_amdgcn_mfma_f32_16x16x4f32(sc[kt][rg], v[d], o[d], 0, 0, 0);
        }
    h16* dst; int ld, co;
    if (br == 0) { dst = (h16*)(p.ws + OFF_MIX); ld = DM; co = 256; } else { dst = (h16*)(p.ws + (br == 1 ? OFF_O2 : OFF_O3)); ld = 256; co = 0; }
    float* lse = (float*)(p.ws + OFF_LSE) + (size_t)br * T_ * 4;
#pragma unroll
    for (int rg = 0; rg < 4; ++rg) {
        const int q = 4 * g + rg;
        const float inv = __builtin_amdgcn_rcpf(__shfl(lsum, q));
        const int t = b * SEQ_ + (n * 128 + 16 * wid + q) * dil + r;
        h16x4 ov; ov[0] = (h16)(o[0][rg] * inv); ov[1] = (h16)(o[1][rg] * inv); ov[2] = (h16)(o[2][rg] * inv); ov[3] = (h16)(o[3][rg] * inv);
        *(h16x4*)(dst + (size_t)t * ld + co + h * 64 + 4 * c16) = ov;
    }
    if (g == 0) lse[(size_t)(b * SEQ_ + tq) * 4 + h] = m + __logf(lsum);
}

__device__ __forceinline__ void mix_phase(const Params& p, int l, int cidx, int imask, LAS unsigned char* lds, const int tidx) {
    unsigned* ctr = (unsigned*)(p.ws + OFF_MISC) + cidx;
    unsigned* actr = (unsigned*)(p.ws + OFF_MISC) + 8 + cidx;
    LAS unsigned* slot = (LAS unsigned*)(lds + LDS_BYTES - 16);
    constexpr int NA = 128 / R_RWKV, NB = 128 / R_SSD, NC = 128 / R_HGRN;
    for (;;) {
        __syncthreads();
        if (tidx == 0) *slot = atomicAdd(ctr, 1u);
        __syncthreads();
        const int it = (int)*slot;
        if (it >= NA + NB + NC) break;
        int t2 = tidx; asm volatile("" : "+v"(t2));
        if (it < NA) { if (imask & 1) rwkv_scan<R_RWKV>(p, it, lds, t2); }
        else if (it < NA + NB) { if (imask & 2) ssd_scan<R_SSD>(p, l, it - NA, lds, t2); }
        else { if (imask & 4) hgrn_scan<R_HGRN>(p, l, it - NA - NB, lds, t2); }
    }
    if (imask & 8) {
        for (;;) {
            unsigned w0 = 0;
            if ((tidx & 63) == 0) w0 = atomicAdd(actr, 4u);
            w0 = (unsigned)__builtin_amdgcn_readfirstlane((int)w0);
            if (w0 >= 1536u * 8u) break;
#pragma unroll 1
            for (unsigned w = w0; w < w0 + 4u; ++w) {
                int t2 = tidx; asm volatile("" : "+v"(t2));
                attn_item(p, (int)(w >> 3), (int)(w & 7u), t2);
            }
        }
    }
}

__device__ __forceinline__ void post_phase(const Params& p, int l, const int tidx) {
    const int wid = tidx >> 6, lane = tidx & 63;
    h16* mix = (h16*)(p.ws + OFF_MIX);
    const h16* prep = (const h16*)p.out;
    const h16* proj = (const h16*)(p.ws + OFF_BIG);
    const h16* o2 = (const h16*)(p.ws + OFF_O2);
    const h16* o3 = (const h16*)(p.ws + OFF_O3);
    const float* lse = (const float*)(p.ws + OFF_LSE);
    const f32x4 snw = *(const f32x4*)(p.in[I_SNW] + l * 256 + 4 * lane);
    const f32x4 hnw = *(const f32x4*)(p.in[I_HNW] + l * 256 + 4 * lane);
    const int hd = lane >> 4;
#pragma unroll 2
    for (int t = blockIdx.x * 8 + wid; t < T_; t += gridDim.x * 8) {
        h16* mr = mix + (size_t)t * DM + 4 * lane;
        {
            const f32x4 y = h4f(*(const h16x4*)mr);
            const float mu = sum16(y[0] + y[1] + y[2] + y[3]) * (1.0f / 64.0f);
            const f32x4 d = y - mu;
            const float var = sum16(d[0] * d[0] + d[1] * d[1] + d[2] * d[2] + d[3] * d[3]) * (1.0f / 64.0f);
            const float rstd = rsqrtf(var + 64e-5f);
            const f32x4 A = h4f(*(const h16x4*)(prep + (size_t)t * 2048 + 1536 + 4 * lane));
            const f32x4 Bc = h4f(*(const h16x4*)(prep + (size_t)t * 2048 + 1792 + 4 * lane));
            *(h16x4*)mr = f4h(d * rstd * A + Bc);
        }
        {
            const f32x4 a1 = h4f(*(const h16x4*)(mr + 256));
            const f32x4 a2 = h4f(*(const h16x4*)(o2 + (size_t)t * 256 + 4 * lane));
            const f32x4 a3 = h4f(*(const h16x4*)(o3 + (size_t)t * 256 + 4 * lane));
            const float l1 = lse[(size_t)t * 4 + hd], l2 = lse[(size_t)(T_ + t) * 4 + hd], l3 = lse[(size_t)(2 * T_ + t) * 4 + hd];
            const float mx = fmaxf(l1, fmaxf(l2, l3));
            const float w1 = __expf(l1 - mx), w2 = __expf(l2 - mx), w3 = __expf(l3 - mx);
            const float inv = __builtin_amdgcn_rcpf(w1 + w2 + w3);
            *(h16x4*)(mr + 256) = f4h((a1 * w1 + a2 * w2 + a3 * w3) * inv);
        }
        {
            const f32x4 u = h4f(*(const h16x4*)(mr + 512));
            float ss = sum16(u[0] * u[0] + u[1] * u[1] + u[2] * u[2] + u[3] * u[3]);
            ss += __shfl_xor(ss, 16);
            const float rstd = rsqrtf(ss * (1.0f / 128.0f) + 1e-5f);
            *(h16x4*)(mr + 512) = f4h(u * rstd * snw);
        }
        {
            const f32x4 u = h4f(*(const h16x4*)(mr + 768));
            const float ss = sum16(u[0] * u[0] + u[1] * u[1] + u[2] * u[2] + u[3] * u[3]);
            const float rstd = rsqrtf(ss * (1.0f / 64.0f) + 1e-5f);
            const f32x4 gz = h4f(*(const h16x4*)(proj + (size_t)t * NP + C_HG + 4 * lane));
            f32x4 gt; gt[0] = siluf_(gz[0]); gt[1] = siluf_(gz[1]); gt[2] = siluf_(gz[2]); gt[3] = siluf_(gz[3]);
            *(h16x4*)(mr + 768) = f4h(u * rstd * hnw * gt);
        }
    }
}

__device__ __forceinline__ void ln_phase(const Params& p, const float* w, const float* bvec, bool final_out, const int tidx) {
    const int wid = tidx >> 6, lane = tidx & 63;
    h16* x16 = (h16*)(p.ws + OFF_X16);
    f32x4 wv[4], bv[4];
#pragma unroll
    for (int q = 0; q < 4; ++q) { wv[q] = *(const f32x4*)(w + lane * 16 + 4 * q); bv[q] = *(const f32x4*)(bvec + lane * 16 + 4 * q); }
#pragma unroll 2
    for (int t = blockIdx.x * 8 + wid; t < T_; t += gridDim.x * 8) {
        h16* row = x16 + (size_t)t * DM + lane * 16;
        const h16x8 v0 = *(const h16x8*)row, v1 = *(const h16x8*)(row + 8);
        float x[16];
#pragma unroll
        for (int j = 0; j < 8; ++j) { x[j] = (float)v0[j]; x[8 + j] = (float)v1[j]; }
        float s = 0.f;
#pragma unroll
        for (int j = 0; j < 16; ++j) s += x[j];
        const float mu = sum64(s) * (1.0f / 1024.0f);
        float q2 = 0.f;
#pragma unroll
        for (int j = 0; j < 16; ++j) { x[j] -= mu; q2 += x[j] * x[j]; }
        const float rstd = rsqrtf(sum64(q2) * (1.0f / 1024.0f) + 1e-5f);
#pragma unroll
        for (int j = 0; j < 16; ++j) x[j] = x[j] * rstd * wv[j >> 2][j & 3] + bv[j >> 2][j & 3];
        if (final_out) {
            float* orow = p.out + (size_t)t * DM + lane * 16;
#pragma unroll
            for (int q = 0; q < 4; ++q) *(f32x4*)(orow + 4 * q) = (f32x4){x[4 * q], x[4 * q + 1], x[4 * q + 2], x[4 * q + 3]};
        } else {
            h16x8 o0, o1;
#pragma unroll
            for (int j = 0; j < 8; ++j) { o0[j] = (h16)x[j]; o1[j] = (h16)x[8 + j]; }
            *(h16x8*)row = o0; *(h16x8*)(row + 8) = o1;
        }
    }
}

constexpr int NPHASE = 19;
__device__ __forceinline__ void run_phase(const Params& p, int ph, LAS unsigned char* lds, const int tidx, const int rep) {
    const int l = (ph == 0) ? 0 : (ph - 1) / 9, s = (ph == 0) ? -1 : (ph - 1) % 9;
    h16* x16 = (h16*)(p.ws + OFF_X16);
    h16* mix = (h16*)(p.ws + OFF_MIX);
    h16* big = (h16*)(p.ws + OFF_BIG);
    if (ph == 0) {
#if !COOP
        if (blockIdx.x == 0) for (int i = tidx; i < 256 + 3456; i += 512) ((unsigned*)(p.ws + OFF_MISC))[i] = 0u;
#endif
        conv_x(p, tidx);
    }
    if (s == 0 || s == 4 || s == 6 || s == 7) {
        const h16* A = (s == 0 || s == 6) ? x16 : (s == 4 ? mix : big);
        const h16* Bt = (const h16*)(p.ws + (s == 0 ? OFF_WIN : s == 4 ? OFF_WOUT : s == 6 ? OFF_WUP : OFF_WDN));
        const int N = (s == 0) ? NP : (s == 6 ? DFF : DM), K = (s == 7) ? DFF : DM;
        h16* O = (s == 0 || s == 6) ? big : x16;
        run_gemm(lds, A, Bt, N, K, O, N, (s == 0) ? 0 : (s == 6 ? 1 : 2), tidx);
    }
    if (s == 1) pre_phase(p, l, lds, tidx);
    if (s == 2) mix_phase(p, l, 2 * rep + l, rep ? DUPITEMS : 15, lds, tidx);
    if (s == 3) post_phase(p, l, tidx);
    if (s == 5 || s == 8) ln_phase(p, p.in[s == 5 ? I_LN1W : I_LN2W] + l * DM, p.in[s == 5 ? I_LN1B : I_LN2B] + l * DM, s == 8 && l == 1, tidx);
    if (ph == 0 || (s == 8 && l == 0)) conv_weights(p, ph == 0 ? 0 : 1, lds, tidx);
}

__global__ void __launch_bounds__(512, 2) k_phase(Params p, int ph) {
    extern __shared__ __attribute__((aligned(16))) unsigned char shm[];
    const int tidx = threadIdx.x;
    run_phase(p, ph, (LAS unsigned char*)shm, tidx, 0);
}

#define XB_TMO      128
#define XB_XCNT(j)  (256  + 64 * (j))
#define XB_XSUB(j)  (1280 + 64 * (j))
#define XB_XGEN(j)  (2304 + 64 * (j))
#define XB_TOP      3328
#define XB_TOPGEN   3392
#define XCD_BAR_WORDS 3456
#define XB_SPIN_CAP (1u << 18)

__device__ __forceinline__ unsigned xb_ld(unsigned* p)              { return __hip_atomic_load(p, __ATOMIC_RELAXED, __HIP_MEMORY_SCOPE_AGENT); }
__device__ __forceinline__ unsigned xb_add(unsigned* p, unsigned v) { return __hip_atomic_fetch_add(p, v, __ATOMIC_RELAXED, __HIP_MEMORY_SCOPE_AGENT); }
__device__ __forceinline__ unsigned xb_xcc_id() { return (unsigned)__builtin_amdgcn_s_getreg((3 << 11) | 20) & 0xFu; }
#define XB_SPIN(cond, bar) do { unsigned _sp = 0; while (cond) { __builtin_amdgcn_s_sleep(1); \
    if ((++_sp & 255u) == 0u) { if (xb_ld(&(bar)[XB_TMO])) break; if (_sp > XB_SPIN_CAP) { atomicAdd(&(bar)[XB_TMO], 1u); break; } } } } while (0)

struct XcdBarrier {
    unsigned* bar; unsigned x;
    volatile LAS unsigned* st;
};

__device__ __forceinline__ XcdBarrier xcd_barrier_post(unsigned* bar, volatile LAS unsigned* st) {
    XcdBarrier b; b.bar = bar; b.x = xb_xcc_id(); b.st = st;
    if (threadIdx.x == 0) (void)xb_add(&bar[XB_XCNT(b.x)], 1u);
    return b;
}
__device__ __forceinline__ void xcd_barrier_complete(unsigned* bar, unsigned x, unsigned& nloc, unsigned& nx) {
    const unsigned G = gridDim.x * gridDim.y * gridDim.z;
    unsigned sum, cnt, mine, sp = 0u;
    for (;;) {
        sum = 0u; cnt = 0u; mine = 0u;
#pragma unroll
        for (unsigned j = 0; j < 16; ++j) { const unsigned c = xb_ld(&bar[XB_XCNT(j)]); sum += c; cnt += (c > 0u) ? 1u : 0u; mine = (j == x) ? c : mine; }
        if (sum == G) break;
        __builtin_amdgcn_s_sleep(1);
        if ((++sp & 255u) == 0u) { if (xb_ld(&bar[XB_TMO])) break; if (sp > XB_SPIN_CAP) { atomicAdd(&bar[XB_TMO], 1u); break; } }
    }
    nloc = mine > 0u ? mine : 1u; nx = cnt > 0u ? cnt : 1u;
}

__device__ __forceinline__ void xcd_barrier(const XcdBarrier& b) {
    asm volatile("s_waitcnt vmcnt(0)" ::: "memory");
    __syncthreads();
    if (threadIdx.x == 0) {
        unsigned* bar = b.bar;
        __builtin_amdgcn_s_waitcnt(0);
        unsigned nloc = b.st[0], nx = b.st[1];
        if (nloc == 0u) { xcd_barrier_complete(bar, b.x, nloc, nx); b.st[0] = nloc; b.st[1] = nx; }
        const unsigned old = xb_add(&bar[XB_XSUB(b.x)], 1u);
        const unsigned gen = old / nloc;
        if (old + 1u == (gen + 1u) * nloc) {
            __builtin_amdgcn_fence(__ATOMIC_RELEASE, "agent");
            asm volatile("s_waitcnt vmcnt(0)" ::: "memory");
            const unsigned og = xb_add(&bar[XB_TOP], 1u);
            const unsigned tg = og / nx;
            if (og + 1u == (tg + 1u) * nx) xb_add(&bar[XB_TOPGEN], 1u);
            else XB_SPIN(xb_ld(&bar[XB_TOPGEN]) == tg, bar);
            __builtin_amdgcn_fence(__ATOMIC_ACQUIRE, "agent");
            xb_add(&bar[XB_XGEN(b.x)], 1u);
            asm volatile("s_waitcnt vmcnt(0)" ::: "memory");
        } else {
            XB_SPIN(xb_ld(&bar[XB_XGEN(b.x)]) == gen, bar);
            __builtin_amdgcn_fence(__ATOMIC_ACQUIRE, "agent");
            asm volatile("s_waitcnt vmcnt(0)" ::: "memory");
        }
    }
    __syncthreads();
}


#ifndef DUPITEMS
#define DUPITEMS 15
#endif
#ifndef DUPMASK
#define DUPMASK 0
#endif
#if COOP
__global__ void __launch_bounds__(512, 2) k_mega(Params p) {
    extern __shared__ __attribute__((aligned(16))) unsigned char shm[];
    cg::grid_group grid = cg::this_grid();
    unsigned* barw = (unsigned*)(p.ws + OFF_MISC + 1024);
    volatile LAS unsigned* xst = (volatile LAS unsigned*)((LAS unsigned char*)shm + LDS_BYTES);
    if (threadIdx.x < 4) xst[threadIdx.x] = 0u;
    __syncthreads();
    XcdBarrier xb = xcd_barrier_post(barw, xst);
    if (p.ws == nullptr) grid.sync();
#pragma unroll 1
    for (int ph = 0; ph < NPHASE; ++ph) {
        const int nrep = ((DUPMASK >> ph) & 1) ? 2 : 1;
#pragma unroll 1
        for (int rep = 0; rep < nrep; ++rep) {
            int tidx = threadIdx.x; asm volatile("" : "+v"(tidx));
            run_phase(p, ph, (LAS unsigned char*)shm, tidx, rep);
            if (ph + 1 < NPHASE) xcd_barrier(xb);
        }
#ifdef EXTRA_SYNCS
        if (ph == 1) for (int i = 0; i < EXTRA_SYNCS; ++i) xcd_barrier(xb);
#endif
    }
}
#endif

extern "C" void kernel_launch(void* const* d_in, const int* in_sizes, int n_in, void* d_out, int out_size, void* d_ws, size_t ws_size, hipStream_t stream) {
    static int grid_blocks = 0;
    if (!grid_blocks) {
        int dev = 0, cus = 0, per_cu = 0;
        hipGetDevice(&dev);
        hipDeviceGetAttribute(&cus, hipDeviceAttributeMultiprocessorCount, dev);
        hipFuncSetAttribute((const void*)k_phase, hipFuncAttributeMaxDynamicSharedMemorySize, LDS_TOTAL);
#if COOP
        hipFuncSetAttribute((const void*)k_mega, hipFuncAttributeMaxDynamicSharedMemorySize, LDS_TOTAL);
        hipOccupancyMaxActiveBlocksPerMultiprocessor(&per_cu, (const void*)k_mega, 512, LDS_TOTAL);
#endif
        if (per_cu < 1) per_cu = 1;
        grid_blocks = cus * 1;
        (void)hipGetLastError();
    }
    Params p{};
    for (int i = 0; i < 32; ++i) p.in[i] = (const float*)d_in[i];
    p.out = (float*)d_out; p.ws = (unsigned char*)d_ws;
#if COOP
    void* args[] = {&p};
    hipMemsetAsync((char*)d_ws + OFF_MISC, 0, 16384, stream);
    hipError_t e = hipLaunchCooperativeKernel((const void*)k_mega, dim3(grid_blocks), dim3(512), args, LDS_TOTAL, stream);
    if (e != hipSuccess) fprintf(stderr, "cooperative launch failed: %s (grid %d)\n", hipGetErrorString(e), grid_blocks);
#else
    for (int ph = 0; ph < NPHASE; ++ph) k_phase<<<dim3(grid_blocks), dim3(512), LDS_TOTAL, stream>>>(p, ph);
#endif
}
```
